# Optimizing an MI355X kernel written in HIP

```python
import jax
import jax.numpy as jnp
from jax import lax
import numpy as np

D_MODEL = 1024
BATCH = 32
SEQ = 2048
DEPTH = 2

GRID_W = 64
CTX_LEN = 256
HEAD_DIM = 64
LRU_WIDTH = D_MODEL
LRU_BLOCKS = 8
LRU_BW = LRU_WIDTH // LRU_BLOCKS
CONV_W = 4
LRU_C = 8.0
NA_HEADS = D_MODEL // 128
NA_KH_MAX = 8
NA_KW = 16
GQA_HEADS = D_MODEL // 128
GQA_KV_HEADS = 2
GQA_GROUP = GQA_HEADS // GQA_KV_HEADS
Q_BLOCK = 128
ROPE_BASE = 10000.0
N_EXPERTS = 16
EXPERT_FF = D_MODEL
EC_CAPACITY = 2
N_BRANCH = 3
EPS = 1e-6
NEG_INF = -1e30

NA_WIDTH = NA_HEADS * HEAD_DIM
GQA_Q_WIDTH = GQA_HEADS * HEAD_DIM
GQA_KV_WIDTH = GQA_KV_HEADS * HEAD_DIM
IN_SPLITS = (LRU_WIDTH, LRU_WIDTH, NA_WIDTH, NA_WIDTH, NA_WIDTH, GQA_Q_WIDTH, GQA_KV_WIDTH, GQA_KV_WIDTH, N_BRANCH * D_MODEL)
IN_WIDTH = sum(IN_SPLITS)
IN_OFFSETS = tuple(int(o) for o in np.cumsum(IN_SPLITS)[:-1])
CTX_KV_PARTS = (0, 3, 4, 6, 7)

kernel_name = 'hybrid_rglru_natten_gqa_ecmoe_dit'

F32 = jnp.float32


def rmsnorm(x, g):
    xf = x.astype(F32)
    y = xf * lax.rsqrt(jnp.mean(xf * xf, axis=-1, keepdims=True) + EPS)
    return (y * g.astype(F32)).astype(x.dtype)


def adaln(cond, w_mod, b_mod):
    m = jax.nn.silu(cond) @ w_mod + b_mod
    return jnp.split(m[..., None, :], 6, axis=-1)


def modulate(x, g, shift, scale):
    return rmsnorm(x, g) * (1.0 + scale) + shift


def heads(t):
    return t.reshape(t.shape[0], t.shape[1], -1, HEAD_DIM)


def group(q):
    return q.reshape(q.shape[0], q.shape[1], GQA_KV_HEADS, GQA_GROUP, HEAD_DIM)


def attend(q, k, v):
    s = jnp.einsum('bqhgd,bkhd->bhgqk', q, k).astype(F32) * (HEAD_DIM ** -0.5)
    p = jax.nn.softmax(s, axis=-1).astype(v.dtype)
    return jnp.einsum('bhgqk,bkhd->bqhgd', p, v)


def axial_rope(n_tokens):
    t = jnp.arange(n_tokens)
    pos = jnp.stack([t // GRID_W, t % GRID_W], axis=-1).astype(F32)
    n_freq = HEAD_DIM // 4
    inv_freq = ROPE_BASE ** (-jnp.arange(n_freq, dtype=F32) / n_freq)
    ang = (pos[:, :, None] * inv_freq).reshape(n_tokens, 2 * n_freq)
    return jnp.cos(ang)[:, None, :], jnp.sin(ang)[:, None, :]


def apply_rope(x, cos, sin):
    xf = x.astype(F32)
    x1, x2 = jnp.split(xf, 2, axis=-1)
    return jnp.concatenate([x1 * cos - x2 * sin, x1 * sin + x2 * cos], axis=-1).astype(x.dtype)


def dwconv_centred(x, w, b):
    T = x.shape[1]
    left = CONV_W // 2
    xp = jnp.pad(x, ((0, 0), (left, CONV_W - 1 - left), (0, 0)))
    out = b
    for k in range(CONV_W):
        out = out + xp[:, k:k + T] * w[k]
    return out


def rglru_coeffs(u, wa, ba, wx, bx, lam):
    B_, T, _ = u.shape
    ub = u.reshape(B_, T, LRU_BLOCKS, LRU_BW)
    r = jax.nn.sigmoid(jnp.einsum('btnc,ncd->btnd', ub, wa.astype(F32)).reshape(B_, T, LRU_WIDTH) + ba.astype(F32))
    i = jax.nn.sigmoid(jnp.einsum('btnc,ncd->btnd', ub, wx.astype(F32)).reshape(B_, T, LRU_WIDTH) + bx.astype(F32))
    log_a = -LRU_C * r * jax.nn.softplus(-lam.astype(F32))
    a = jnp.exp(log_a)
    b = jnp.sqrt(-jnp.expm1(2.0 * log_a)) * (i * u)
    return a, b


def linear_scan(a, b, h0, reverse):
    if h0 is not None:
        first = a.shape[1] - 1 if reverse else 0
        b = b.at[:, first].add(a[:, first] * h0)

    def comb(left, right):
        a_l, b_l = left
        a_r, b_r = right
        return a_l * a_r, a_r * b_l + b_r

    _, h = lax.associative_scan(comb, (a, b), reverse=reverse, axis=1)
    return h


def rglru_branch(xl, xc, gl, gc, p, need_ctx):
    ul = dwconv_centred(xl, p['conv_w'], p['conv_b']).astype(F32)
    uc = dwconv_centred(xc, p['conv_w'], p['conv_b']).astype(F32)
    hl = 0.0
    hc = 0.0
    for d, rev in enumerate((False, True)):
        dp = (p['lru_wa'][d], p['lru_ba'][d], p['lru_wx'][d], p['lru_bx'][d], p['lru_lam'][d])
        ac, bc = rglru_coeffs(uc, *dp)
        hcd = linear_scan(ac, bc, None, rev)
        h_fin = hcd[:, 0] if rev else hcd[:, -1]
        al, bl = rglru_coeffs(ul, *dp)
        hl = hl + linear_scan(al, bl, h_fin, rev)
        if need_ctx:
            hc = hc + hcd
    yl = (hl * jax.nn.gelu(gl.astype(F32))).astype(xl.dtype)
    yc = (hc * jax.nn.gelu(gc.astype(F32))).astype(xc.dtype) if need_ctx else None
    return yl, yc


def neighbourhood_attention(q, k, v, kc, vc, rpb):
    B_, S, H, dh = q.shape
    rows = S // GRID_W
    kh = min(NA_KH_MAX, rows)
    qg = q.reshape(B_, rows, GRID_W, H, dh)
    kg = k.reshape(B_, rows, GRID_W, H, dh)
    vg = v.reshape(B_, rows, GRID_W, H, dh)
    col = jnp.arange(GRID_W)
    cs = jnp.clip(col - NA_KW // 2, 0, GRID_W - NA_KW)
    col_mask = (col[None, :] >= cs[:, None]) & (col[None, :] < cs[:, None] + NA_KW)
    dcol = jnp.clip(col[None, :] - col[:, None], -(NA_KW - 1), NA_KW - 1) + NA_KW - 1
    n_lat = kh * GRID_W

    def row_fn(args):
        r, qr = args
        rs = jnp.clip(r - kh // 2, 0, rows - kh)
        kb = lax.dynamic_slice_in_dim(kg, rs, kh, axis=1)
        vb = lax.dynamic_slice_in_dim(vg, rs, kh, axis=1)
        drow = jnp.arange(kh) + rs - r + NA_KH_MAX - 1
        bias = rpb[:, drow[None, :, None], dcol[:, None, :]].astype(F32)
        s_lat = jnp.einsum('bqhd,bjkhd->bhqjk', qr, kb).astype(F32) * (dh ** -0.5) + bias
        s_lat = jnp.where(col_mask[:, None, :], s_lat, NEG_INF).reshape(B_, H, GRID_W, n_lat)
        s_ctx = jnp.einsum('bqhd,bchd->bhqc', qr, kc).astype(F32) * (dh ** -0.5)
        pr = jax.nn.softmax(jnp.concatenate([s_lat, s_ctx], axis=-1), axis=-1).astype(v.dtype)
        p_lat = pr[..., :n_lat].reshape(B_, H, GRID_W, kh, GRID_W)
        o = jnp.einsum('bhqjk,bjkhd->bqhd', p_lat, vb)
        return o + jnp.einsum('bhqc,bchd->bqhd', pr[..., n_lat:], vc)

    out = lax.map(row_fn, (jnp.arange(rows), jnp.moveaxis(qg, 1, 0)))
    return jnp.moveaxis(out, 0, 1).reshape(B_, S, H * dh)


def gqa_blocked(q, k, v, kc, vc):
    B_, S = q.shape[:2]
    kall = jnp.concatenate([kc, k], axis=1)
    vall = jnp.concatenate([vc, v], axis=1)
    qb = jnp.moveaxis(q.reshape(B_, S // Q_BLOCK, Q_BLOCK, GQA_KV_HEADS, GQA_GROUP, HEAD_DIM), 1, 0)
    o = lax.map(lambda qi: attend(qi, kall, vall), qb)
    return jnp.moveaxis(o, 0, 1).reshape(B_, S, GQA_Q_WIDTH)


def merge_branches(ya, yb, yc, gate_logits, p):
    ga, gb, gc = jnp.split(jax.nn.sigmoid(gate_logits.astype(F32)).astype(ya.dtype), N_BRANCH, axis=-1)
    m = ga * (ya @ p['w_o_a']) + gb * (yb @ p['w_o_b']) + gc * (yc @ p['w_o_c'])
    return m @ p['w_out']


def parallel_mixer(hl, hc, p, need_ctx):
    lat = jnp.split(hl @ p['w_in'], IN_OFFSETS, axis=-1)
    if need_ctx:
        ctx = jnp.split(hc @ p['w_in'], IN_OFFSETS, axis=-1)
    else:
        w_parts = jnp.split(p['w_in'], IN_OFFSETS, axis=1)
        ctx = [hc @ w if i in CTX_KV_PARTS else None for i, w in enumerate(w_parts)]
    ya_l, ya_c = rglru_branch(lat[0], ctx[0], lat[1], ctx[1], p, need_ctx)
    kb_c, vb_c = heads(ctx[3]), heads(ctx[4])
    yb_l = neighbourhood_attention(heads(lat[2]), heads(lat[3]), heads(lat[4]), kb_c, vb_c, p['na_rpb'])
    cos, sin = axial_rope(hl.shape[1])
    qc_l = apply_rope(rmsnorm(heads(lat[5]), p['qn_g']), cos, sin)
    kc_l = apply_rope(rmsnorm(heads(lat[6]), p['kn_g']), cos, sin)
    kc_c = rmsnorm(heads(ctx[6]), p['kn_g'])
    vc_c = heads(ctx[7])
    yc_l = gqa_blocked(group(qc_l), kc_l, heads(lat[7]), kc_c, vc_c)
    out_l = merge_branches(ya_l, yb_l, yc_l, lat[8], p)
    out_c = None
    if need_ctx:
        B_, L = hc.shape[:2]
        yb_c = attend(heads(ctx[2])[:, :, :, None], kb_c, vb_c).reshape(B_, L, NA_WIDTH)
        yc_c = attend(group(rmsnorm(heads(ctx[5]), p['qn_g'])), kc_c, vc_c).reshape(B_, L, GQA_Q_WIDTH)
        out_c = merge_branches(ya_c, yb_c, yc_c, ctx[8], p)
    return out_l, out_c


def expert_choice_ffn(h, p):
    n, d = h.shape[1], h.shape[2]
    cap = EC_CAPACITY * n // N_EXPERTS
    logits = jnp.einsum('bnd,de->ben', h, p['w_router']).astype(F32)
    aff = jax.nn.softmax(logits, axis=1)
    gate, idx = lax.top_k(aff, cap)
    hs = jax.vmap(lambda hb, ib: hb[ib])(h, idx)
    u = jax.nn.silu(jnp.einsum('becd,edf->becf', hs, p['w_gate'])) * jnp.einsum('becd,edf->becf', hs, p['w_up'])
    y = jnp.einsum('becf,efd->becd', u, p['w_down']) * gate[..., None].astype(h.dtype)
    return jax.vmap(lambda yb, ib: jnp.zeros((n, d), yb.dtype).at[ib.reshape(-1)].add(yb.reshape(-1, d)))(y, idx)


def hybrid_layer(xl, xc, c, c_ctx, p, need_ctx):
    sh1, sc1, g1, sh2, sc2, g2 = adaln(c, p['w_mod'], p['b_mod'])
    csh1, csc1, cg1, csh2, csc2, cg2 = adaln(c_ctx, p['w_mod'], p['b_mod'])
    ng = p['norm_g']
    hl = modulate(xl, ng[0], sh1, sc1)
    hc = modulate(xc, ng[0], csh1, csc1)
    yl, yc = parallel_mixer(hl, hc, p, need_ctx)
    xl = xl + g1 * rmsnorm(yl, ng[1])
    hl = modulate(xl, ng[2], sh2, sc2)
    xl = xl + g2 * rmsnorm(expert_choice_ffn(hl, p), ng[3])
    if need_ctx:
        xc = xc + cg1 * rmsnorm(yc, ng[1])
        hc = modulate(xc, ng[2], csh2, csc2)
        xc = xc + cg2 * rmsnorm(expert_choice_ffn(hc, p), ng[3])
    return xl, xc


def setup_inputs(seed: int = 0) -> dict:
    key = jax.random.key(seed)
    keys = iter(jax.random.split(key, 32))

    def dense(shape, fan_in, mult=1.0):
        return jax.random.normal(next(keys), shape, F32) * (mult * fan_in ** -0.5)

    def gain(shape):
        return 1.0 + 0.05 * jax.random.normal(next(keys), shape, F32)

    def small(shape, s=0.02):
        return s * jax.random.normal(next(keys), shape, F32)

    D = D_MODEL
    a0 = jax.random.uniform(next(keys), (DEPTH, 2, LRU_WIDTH), F32, 0.9, 0.999)
    s0 = a0 ** (1.0 / LRU_C)
    lru_lam = jnp.log(s0) - jnp.log1p(-s0)
    return {
        'x': jax.random.normal(next(keys), (BATCH, SEQ, D), F32),
        'c': jax.random.normal(next(keys), (BATCH, D), F32),
        'ctx': jax.random.normal(next(keys), (BATCH, CTX_LEN, D), F32),
        'c_ctx': jax.random.normal(next(keys), (D,), F32),
        'w_mod': dense((DEPTH, D, 6 * D), D, 0.5),
        'b_mod': small((DEPTH, 6 * D)),
        'norm_g': gain((DEPTH, 4, D)),
        'w_in': dense((DEPTH, D, IN_WIDTH), D),
        'conv_w': dense((DEPTH, CONV_W, LRU_WIDTH), CONV_W),
        'conv_b': small((DEPTH, LRU_WIDTH)),
        'lru_wa': dense((DEPTH, 2, LRU_BLOCKS, LRU_BW, LRU_BW), LRU_BW),
        'lru_ba': small((DEPTH, 2, LRU_WIDTH)),
        'lru_wx': dense((DEPTH, 2, LRU_BLOCKS, LRU_BW, LRU_BW), LRU_BW),
        'lru_bx': small((DEPTH, 2, LRU_WIDTH)),
        'lru_lam': lru_lam,
        'na_rpb': small((DEPTH, NA_HEADS, 2 * NA_KH_MAX - 1, 2 * NA_KW - 1), 0.1),
        'qn_g': gain((DEPTH, HEAD_DIM)),
        'kn_g': gain((DEPTH, HEAD_DIM)),
        'w_o_a': dense((DEPTH, LRU_WIDTH, D), LRU_WIDTH),
        'w_o_b': dense((DEPTH, NA_WIDTH, D), NA_WIDTH),
        'w_o_c': dense((DEPTH, GQA_Q_WIDTH, D), GQA_Q_WIDTH),
        'w_out': dense((DEPTH, D, D), D),
        'w_router': dense((DEPTH, D, N_EXPERTS), D),
        'w_gate': dense((DEPTH, N_EXPERTS, D, EXPERT_FF), D),
        'w_up': dense((DEPTH, N_EXPERTS, D, EXPERT_FF), D),
        'w_down': dense((DEPTH, N_EXPERTS, EXPERT_FF, D), EXPERT_FF),
    }


def reference(x, c, ctx, c_ctx, w_mod, b_mod, norm_g, w_in, conv_w, conv_b, lru_wa, lru_ba, lru_wx, lru_bx, lru_lam, na_rpb, qn_g, kn_g, w_o_a, w_o_b, w_o_c, w_out, w_router, w_gate, w_up, w_down):
    xl, xc = x, ctx
    for l in range(DEPTH):
        p = {
            'w_mod': w_mod[l], 'b_mod': b_mod[l], 'norm_g': norm_g[l], 'w_in': w_in[l],
            'conv_w': conv_w[l], 'conv_b': conv_b[l],
            'lru_wa': lru_wa[l], 'lru_ba': lru_ba[l], 'lru_wx': lru_wx[l], 'lru_bx': lru_bx[l], 'lru_lam': lru_lam[l],
            'na_rpb': na_rpb[l], 'qn_g': qn_g[l], 'kn_g': kn_g[l],
            'w_o_a': w_o_a[l], 'w_o_b': w_o_b[l], 'w_o_c': w_o_c[l], 'w_out': w_out[l],
            'w_router': w_router[l], 'w_gate': w_gate[l], 'w_up': w_up[l], 'w_down': w_down[l],
        }
        xl, xc = hybrid_layer(xl, xc, c, c_ctx, p, l < DEPTH - 1)
    return xl
```

```cpp
#include <hip/hip_runtime.h>
#include <cstdio>
#include <cstdint>
namespace pg8 {
#define PG8_LAS __attribute__((address_space(3)))
typedef unsigned short bf16_t;
typedef short bf16x8 __attribute__((ext_vector_type(8)));
typedef float f32x4 __attribute__((ext_vector_type(4)));
typedef unsigned u32x4 __attribute__((ext_vector_type(4)));
constexpr int BM = 256, BK = 64, HALF = 128, HTB = HALF * BK * 2  , STAGE_BYTES = 8 * HTB, NXCD = 8, WGM = 8;

__host__ __device__ __forceinline__ int lds_byte(int r, int c) { const int st = (r >> 4) * 2 + (c >> 5), rr = r & 15, cc = c & 31, ob = rr * 64 + cc * 2; return st * 1024 + (ob ^ (((ob >> 9) & 1) << 5)); }
__host__ __device__ __forceinline__ void stage_rc(int b, int& R, int& C) { const int st = b / 1024, sb = b % 1024, swz = sb ^ (((sb >> 9) & 1) << 5); R = (st >> 1) * 16 + swz / 64; C = (st & 1) * 32 + (swz % 64) / 2; }
__host__ __device__ __forceinline__ int perm32(int rho) { const int n = rho >> 4, i = rho & 15; return 8 * (i >> 2) + 4 * n + (i & 3); }

struct Unit { int pm, pn; const char* A; const char* B; };
struct Gemm { int lda, ldb, K; };

__device__ __forceinline__ unsigned cvt_pk_bf16(float lo, float hi) { unsigned r; asm volatile("v_cvt_pk_bf16_f32 %0, %1, %2" : "=v"(r) : "v"(lo), "v"(hi)); return r; }
typedef float f32x2 __attribute__((ext_vector_type(2)));
__device__ __forceinline__ f32x2 gelu_pk(f32x2 v) {
    const f32x2 av = __builtin_elementwise_abs(v), d = av * 0.2316418882f + 1.0f;
    f32x2 t; t.x = __builtin_amdgcn_rcpf(d.x); t.y = __builtin_amdgcn_rcpf(d.y);
    f32x2 q = t * 0.5307027145f + (-0.7265760135f); q = q * t + 0.7107068705f; q = q * t + (-0.142248368f); q = q * t + 0.127414796f; q = q * t;
    const f32x2 s = (v * v) * (-0.72134752044f);
    f32x2 e; e.x = __builtin_amdgcn_exp2f(s.x); e.y = __builtin_amdgcn_exp2f(s.y);
    const f32x2 m = v * (q * e), r = v - m;
    f32x2 o; o.x = v.x < 0.f ? m.x : r.x; o.y = v.y < 0.f ? m.y : r.y; return o;
}

template <int ACT  > struct EpiBf16 {
    static constexpr bool PERM = true, AFTER_DRAIN = false; static_assert(ACT == 0 || ACT == 1, "EpiBf16: ACT is 0 (none) or 1 (gelu_pk)");
    bf16_t* O; int ldc; const float* bias; int split_cols; size_t split_stride; float scale0;
    __device__ __forceinline__ void operator()(const f32x4 (&acc)[2][2][4][2], const Unit& u, int wr, int wc, int fr, int fq) const {
        const int row0 = u.pm * BM + wr * 64 + fr; int colt = u.pn * BM; bf16_t* base = O;
        float sc = 1.f; if (split_cols) { const int t = colt / split_cols; base += (size_t)t * split_stride; colt -= t * split_cols; if (t == 0) sc = scale0; }
        const int col0 = colt + wc * 32 + 8 * fq, bcol0 = u.pn * BM + wc * 32 + 8 * fq;
        f32x4 bv[2][2];
#pragma unroll
        for (int bj = 0; bj < 2; ++bj)
#pragma unroll
            for (int n = 0; n < 2; ++n) bv[bj][n] = bias ? *(const f32x4*)(bias + bcol0 + bj * HALF + 4 * n) : (f32x4){0.f, 0.f, 0.f, 0.f};
#pragma unroll
        for (int ai = 0; ai < 2; ++ai)
#pragma unroll
            for (int m = 0; m < 4; ++m) { bf16_t* rowp = base + (size_t)(row0 + ai * HALF + m * 16) * ldc + col0;
#pragma unroll
                for (int bj = 0; bj < 2; ++bj) { f32x4 v0 = acc[ai][bj][m][0] + bv[bj][0], v1 = acc[ai][bj][m][1] + bv[bj][1];
                    if (ACT == 1) { f32x2 a = gelu_pk((f32x2){v0[0], v0[1]}), b = gelu_pk((f32x2){v0[2], v0[3]}), c = gelu_pk((f32x2){v1[0], v1[1]}), d = gelu_pk((f32x2){v1[2], v1[3]});
                        v0 = (f32x4){a.x, a.y, b.x, b.y}; v1 = (f32x4){c.x, c.y, d.x, d.y}; }
                    v0 = v0 * sc; v1 = v1 * sc; u32x4 w; w.x = cvt_pk_bf16(v0[0], v0[1]); w.y = cvt_pk_bf16(v0[2], v0[3]); w.z = cvt_pk_bf16(v1[0], v1[1]); w.w = cvt_pk_bf16(v1[2], v1[3]);
                    *(u32x4*)(rowp + bj * HALF) = w; } }
    }
};

template <class Epi, class Sched, bool ALIGN_EPI = false, bool SP2 = false, bool KHOOK = false>
__device__ __forceinline__ void gemm_phase(PG8_LAS unsigned char* lds, const Gemm g, const Sched& S, const Epi& E) {
    int tid_ = threadIdx.x; asm volatile("" : "+v"(tid_));
    const int tid = tid_, wid = __builtin_amdgcn_readfirstlane(tid >> 6), lane = tid & 63, wr = wid >> 2, wc = wid & 3, fr = lane & 15, fq = lane >> 4;
    const int K = g.K, nt = K / BK;
    unsigned voffA[2], voffB[2];
#pragma unroll
    for (int i = 0; i < 2; ++i) { int R, C; stage_rc(tid * 16 + i * 8192, R, C); const int Rb = Epi::PERM ? ((R & ~31) + perm32(R & 31)) : R;
        voffA[i] = (unsigned)(R * g.lda + C) * 2u; voffB[i] = (unsigned)(Rb * g.ldb + C) * 2u; }
    const size_t kstep = (size_t)(BK * 2);
    const size_t hstepA = (size_t)HALF * g.lda * 2, hstepB = (size_t)HALF * g.ldb * 2;
    const unsigned ldsw = (unsigned)wid * 1024u;
    const int aoff = lds_byte(wr * 64 + fr, fq * 8), boff = lds_byte(wc * 32 + fr, fq * 8);
#define PG8_SA(b, h) (((b) * 2 + (h)) * HTB)
#define PG8_SB(b, h) ((4 + (b) * 2 + (h)) * HTB)
#define PG8_STAGE(bufoff, gbase, voff) do { _Pragma("unroll") for (int _i = 0; _i < 2; ++_i) \
        __builtin_amdgcn_global_load_lds((const unsigned*)((const char*)(gbase) + (voff)[_i]), (PG8_LAS unsigned*)(lds + (bufoff) + ldsw + _i * 8192), 16, 0, 0); } while (0)
#define PG8_LDA(dst, b, h) do { _Pragma("unroll") for (int m = 0; m < 4; ++m) _Pragma("unroll") for (int k = 0; k < 2; ++k) dst[m][k] = *(const PG8_LAS bf16x8*)(lds + PG8_SA(b, h) + aoff + m * 2048 + k * 1024); } while (0)
#define PG8_LDB(dst, b, h) do { _Pragma("unroll") for (int n = 0; n < 2; ++n) _Pragma("unroll") for (int k = 0; k < 2; ++k) dst[n][k] = *(const PG8_LAS bf16x8*)(lds + PG8_SB(b, h) + boff + n * 2048 + k * 1024); } while (0)
#define PG8_MMA(ai, bj, At, Bt) do { __builtin_amdgcn_s_setprio(1); _Pragma("unroll") for (int m = 0; m < 4; ++m) _Pragma("unroll") for (int n = 0; n < 2; ++n) _Pragma("unroll") for (int k = 0; k < 2; ++k) \
        acc[ai][bj][m][n] = __builtin_amdgcn_mfma_f32_16x16x32_bf16(Bt[n][k], At[m][k], acc[ai][bj][m][n], 0, 0, 0); __builtin_amdgcn_s_setprio(0); } while (0)
#define PG8_WAIT_V(n) asm volatile("s_waitcnt vmcnt(" #n ")" ::: "memory")
#define PG8_WAIT_L(n) asm volatile("s_waitcnt lgkmcnt(" #n ")" ::: "memory")
#define PG8_BAR __builtin_amdgcn_s_barrier()
#define PG8_SCHED __builtin_amdgcn_sched_barrier(0)
    Unit cur, nxt; int ui = 0;
    if (!S.next(0, cur)) return;
    f32x4 acc[2][2][4][2];
#pragma unroll
    for (int a = 0; a < 2; ++a)
#pragma unroll
        for (int b = 0; b < 2; ++b)
#pragma unroll
            for (int m = 0; m < 4; ++m)
#pragma unroll
                for (int n = 0; n < 2; ++n) acc[a][b][m][n] = (f32x4){0.f, 0.f, 0.f, 0.f};
    bf16x8 At[4][2], B0[2][2], B1[2][2];
    const char* cA = cur.A; const char* cB = cur.B;
    S.a_ready(cur);
    if constexpr (SP2) {
        PG8_STAGE(PG8_SB(0, 0), cB, voffB); PG8_STAGE(PG8_SB(0, 1), cB + hstepB, voffB); PG8_STAGE(PG8_SA(0, 0), cA, voffA); PG8_STAGE(PG8_SA(0, 1), cA + hstepA, voffA);
        if (wr == 1) PG8_BAR;
        PG8_WAIT_V(2); PG8_BAR;
        PG8_STAGE(PG8_SB(1, 0), cB + kstep, voffB); PG8_STAGE(PG8_SA(1, 0), cA + kstep, voffA); PG8_STAGE(PG8_SB(1, 1), cB + hstepB + kstep, voffB);
        PG8_WAIT_V(6); PG8_BAR;
    } else {
        PG8_STAGE(PG8_SB(0, 0), cB, voffB); PG8_STAGE(PG8_SA(0, 0), cA, voffA); PG8_STAGE(PG8_SB(0, 1), cB + hstepB, voffB); PG8_STAGE(PG8_SA(0, 1), cA + hstepA, voffA);
        if (wr == 1) PG8_BAR;
        PG8_WAIT_V(4); PG8_BAR;
        PG8_STAGE(PG8_SB(1, 0), cB + kstep, voffB); PG8_STAGE(PG8_SA(1, 0), cA + kstep, voffA); PG8_STAGE(PG8_SB(1, 1), cB + hstepB + kstep, voffB);
        PG8_WAIT_V(6); PG8_BAR;
    }
    for (;;) {
        const bool has_next = S.next(ui + 1, nxt);
        const char* nA = has_next ? nxt.A : cA; const char* nB = has_next ? nxt.B : cB;
        for (int t = 0; t < nt; t += 2) {
            const bool last = (t == nt - 2);
            if constexpr (KHOOK) { if (t == Epi::HOOK_T0 || t == Epi::HOOK_T1) E.khook(acc, cur, t, wr, wc, fr, fq); }
            const char* a1 = cA + (size_t)(t + 1) * kstep;
            const char* a2 = last ? nA : cA + (size_t)(t + 2) * kstep; const char* b2 = last ? nB : cB + (size_t)(t + 2) * kstep;
            const char* a3 = a2 + kstep; const char* b3 = b2 + kstep;
            if (last && has_next) S.a_ready(nxt);
            if constexpr (SP2) {
            PG8_LDB(B0, 0, 0); PG8_LDB(B1, 0, 1); PG8_SCHED; PG8_LDA(At, 0, 0); PG8_STAGE(PG8_SA(1, 1), a1 + hstepA, voffA);
            PG8_WAIT_V(8); PG8_WAIT_L(0); PG8_BAR; PG8_MMA(0, 0, At, B0); PG8_MMA(0, 1, At, B1); PG8_BAR; PG8_SCHED;
            PG8_LDA(At, 0, 1); PG8_STAGE(PG8_SB(0, 0), b2, voffB); PG8_STAGE(PG8_SB(0, 1), b2 + hstepB, voffB); PG8_STAGE(PG8_SA(0, 0), a2, voffA);
            PG8_WAIT_V(8); PG8_WAIT_L(0); PG8_BAR; PG8_MMA(1, 0, At, B0); PG8_MMA(1, 1, At, B1); PG8_BAR; PG8_SCHED;
            PG8_LDB(B0, 1, 0); PG8_LDB(B1, 1, 1); PG8_SCHED; PG8_LDA(At, 1, 0); PG8_STAGE(PG8_SA(0, 1), a2 + hstepA, voffA);
            PG8_WAIT_V(8); PG8_WAIT_L(0); PG8_BAR; PG8_MMA(0, 0, At, B0); PG8_MMA(0, 1, At, B1); PG8_BAR; PG8_SCHED;
            PG8_LDA(At, 1, 1); PG8_STAGE(PG8_SB(1, 0), b3, voffB); PG8_STAGE(PG8_SB(1, 1), b3 + hstepB, voffB); PG8_STAGE(PG8_SA(1, 0), a3, voffA);
            PG8_WAIT_V(8); PG8_WAIT_L(0); PG8_BAR; PG8_MMA(1, 0, At, B0); PG8_MMA(1, 1, At, B1); PG8_BAR; PG8_SCHED;
            } else {
            PG8_LDB(B0, 0, 0); PG8_SCHED; PG8_LDA(At, 0, 0); PG8_STAGE(PG8_SA(1, 1), a1 + hstepA, voffA);
            PG8_WAIT_L(8); PG8_BAR; PG8_WAIT_L(0); PG8_MMA(0, 0, At, B0); PG8_BAR; PG8_SCHED;
            PG8_LDB(B1, 0, 1); PG8_STAGE(PG8_SB(0, 0), b2, voffB);
            PG8_BAR; PG8_WAIT_L(0); PG8_MMA(0, 1, At, B1); PG8_BAR;
            PG8_LDA(At, 0, 1); PG8_STAGE(PG8_SA(0, 0), a2, voffA);
            PG8_BAR; PG8_WAIT_L(0); PG8_MMA(1, 0, At, B0); PG8_BAR; PG8_SCHED;
            PG8_STAGE(PG8_SB(0, 1), b2 + hstepB, voffB);
            PG8_WAIT_V(6); PG8_BAR; PG8_MMA(1, 1, At, B1); PG8_BAR;
            PG8_LDB(B0, 1, 0); PG8_SCHED; PG8_LDA(At, 1, 0); PG8_STAGE(PG8_SA(0, 1), a2 + hstepA, voffA);
            PG8_WAIT_L(8); PG8_BAR; PG8_WAIT_L(0); PG8_MMA(0, 0, At, B0); PG8_BAR; PG8_SCHED;
            PG8_LDB(B1, 1, 1); PG8_STAGE(PG8_SB(1, 0), b3, voffB);
            PG8_BAR; PG8_WAIT_L(0); PG8_MMA(0, 1, At, B1); PG8_BAR;
            PG8_LDA(At, 1, 1); PG8_STAGE(PG8_SA(1, 0), a3, voffA);
            PG8_BAR; PG8_WAIT_L(0); PG8_MMA(1, 0, At, B0); PG8_BAR; PG8_SCHED;
            PG8_STAGE(PG8_SB(1, 1), b3 + hstepB, voffB);
            PG8_WAIT_V(6); PG8_BAR; PG8_MMA(1, 1, At, B1); PG8_BAR;
            }
        }
        if constexpr (ALIGN_EPI) { if (wr == 0) PG8_BAR; }
        if constexpr (!Epi::AFTER_DRAIN) { E(acc, cur, wr, wc, fr, fq); S.done(cur); }
        if (!has_next) break;
#pragma unroll
        for (int a = 0; a < 2; ++a)
#pragma unroll
            for (int b = 0; b < 2; ++b)
#pragma unroll
                for (int m = 0; m < 4; ++m)
#pragma unroll
                    for (int n = 0; n < 2; ++n) acc[a][b][m][n] = (f32x4){0.f, 0.f, 0.f, 0.f};
        cur = nxt; cA = nA; cB = nB; ++ui;
        if constexpr (ALIGN_EPI) { if (wr == 1) PG8_BAR; }
    }
    PG8_WAIT_V(0);
    if constexpr (!ALIGN_EPI) { if (wr == 0) PG8_BAR; }
    PG8_BAR;
    if constexpr (Epi::AFTER_DRAIN) { E.fused(acc, cur, wr, wc, fr, fq, lds, wid, lane); S.done(cur); }
#undef PG8_SA
#undef PG8_SB
#undef PG8_STAGE
#undef PG8_LDA
#undef PG8_LDB
#undef PG8_MMA
#undef PG8_WAIT_V
#undef PG8_WAIT_L
#undef PG8_BAR
#undef PG8_SCHED
}
}
#include <hip/hip_bf16.h>
#include <cmath>
namespace attn_body {
using bf16=__hip_bfloat16;
using bf16x8=__attribute__((ext_vector_type(8)))short;
using s16x4=__attribute__((ext_vector_type(4)))short;
using f32x16=__attribute__((ext_vector_type(16)))float;
using u32x4=__attribute__((ext_vector_type(4)))unsigned;
constexpr int D=64,DM=7424;
constexpr int NW=8,QBLK=32,QB=QBLK*NW,KVBLK=64;
constexpr int ATTN_PITCH=DM, ATTN_UNIT_ROWS=QB;
__device__ __forceinline__ int crow(int r,int hi){return (r&3)+8*(r>>2)+4*hi;}
#define SBAR() __builtin_amdgcn_sched_barrier(0)
constexpr int NSLOT=3, SLOTB=8192;
constexpr int LDS_K=0, LDS_V=NSLOT*SLOTB, LDS_WS=2*NSLOT*SLOTB, LDS_OST=LDS_WS+NW*64*4, LDS_BYTES=LDS_OST+NW*4096, LDS_NATAB=LDS_BYTES, NATAB_BYTES=15*128*4;
constexpr float C2=0.125f*1.4426950408889634f;
__device__ __forceinline__ void glds16(const void*gsrc,unsigned lds_dst){unsigned keep;
  asm volatile("s_mov_b32 %0, m0\n\ts_mov_b32 m0, %2\n\ts_nop 0\n\tglobal_load_lds_dwordx4 %1, off\n\ts_mov_b32 m0, %0":"=&s"(keep):"v"(gsrc),"s"(lds_dst):"memory");}
__device__ __forceinline__ float max3f(float a,float b,float c){float r;asm("v_max3_f32 %0, %1, %2, %3":"=v"(r):"v"(a),"v"(b),"v"(c));return r;}
__device__ __forceinline__ float max2f(float a,float b){float r;asm("v_max_f32_e32 %0, %1, %2":"=v"(r):"v"(a),"v"(b));return r;}
__device__ __forceinline__ float fadd_s(float a,float b){float r;asm("v_add_f32_e32 %0, %1, %2":"=v"(r):"v"(a),"v"(b));return r;}
__device__ __forceinline__ float fsub_s(float a,float b){float r;asm("v_sub_f32_e32 %0, %1, %2":"=v"(r):"v"(a),"v"(b));return r;}
typedef float f32x2_t __attribute__((ext_vector_type(2))); typedef __bf16 bf16x2_t __attribute__((ext_vector_type(2)));
__device__ __forceinline__ unsigned cvtpk_s(float lo,float hi){f32x2_t v={lo,hi};bf16x2_t b=__builtin_convertvector(v,bf16x2_t);return __builtin_bit_cast(unsigned,b);}
#define WAIT_BAR(N) asm volatile("s_waitcnt vmcnt(" #N ") lgkmcnt(0)\n\ts_barrier":::"memory")

__device__ __forceinline__ void qkt(f32x16&p0,f32x16&p1,const char*Kslot,const bf16x8*qr,const f32x16&negm,int r32,int hi){
  const char*kb=Kslot+hi*1024+r32*16;
  #pragma unroll
  for(int d0=0;d0<4;++d0){
    const bf16x8 b0=*reinterpret_cast<const bf16x8*>(kb+d0*2048);
    const bf16x8 b1=*reinterpret_cast<const bf16x8*>(kb+d0*2048+512);
    if(d0==0){p0=__builtin_amdgcn_mfma_f32_32x32x16_bf16(b0,qr[0],negm,0,0,0);p1=__builtin_amdgcn_mfma_f32_32x32x16_bf16(b1,qr[0],negm,0,0,0);}
    else{p0=__builtin_amdgcn_mfma_f32_32x32x16_bf16(b0,qr[d0],p0,0,0,0);p1=__builtin_amdgcn_mfma_f32_32x32x16_bf16(b1,qr[d0],p1,0,0,0);}}
}
typedef __attribute__((address_space(3))) const char* lds_cptr;
typedef short v4i16_t __attribute__((ext_vector_type(4)));
__device__ __forceinline__ void kload8(bf16x8*kf,lds_cptr kp){
  kf[0]=*(const __attribute__((address_space(3))) bf16x8*)(kp);      kf[1]=*(const __attribute__((address_space(3))) bf16x8*)(kp+512);
  kf[2]=*(const __attribute__((address_space(3))) bf16x8*)(kp+2048); kf[3]=*(const __attribute__((address_space(3))) bf16x8*)(kp+2560);
  kf[4]=*(const __attribute__((address_space(3))) bf16x8*)(kp+4096); kf[5]=*(const __attribute__((address_space(3))) bf16x8*)(kp+4608);
  kf[6]=*(const __attribute__((address_space(3))) bf16x8*)(kp+6144); kf[7]=*(const __attribute__((address_space(3))) bf16x8*)(kp+6656);
}
__device__ __forceinline__ void kload2(bf16x8*kf,lds_cptr kp,int j){ kf[2*j]=*(const __attribute__((address_space(3))) bf16x8*)(kp+j*2048); kf[2*j+1]=*(const __attribute__((address_space(3))) bf16x8*)(kp+j*2048+512); }
__device__ __forceinline__ s16x4 vtr(lds_cptr p){ return __builtin_bit_cast(s16x4,__builtin_amdgcn_ds_read_tr16_b64_v4i16((__attribute__((address_space(3))) v4i16_t*)p)); }
__device__ __forceinline__ float rowmax(const f32x16&p0,const f32x16&p1){
  float a=max3f(p0[0],p0[1],p1[0]),b=max3f(p0[2],p0[3],p1[1]);a=max3f(a,p1[2],p1[3]);
  #pragma unroll
  for(int r=4;r<16;r+=4){a=max3f(a,p0[r],p0[r+1]);b=max3f(b,p0[r+2],p0[r+3]);a=max3f(a,p1[r],p1[r+1]);b=max3f(b,p1[r+2],p1[r+3]);}
  const float m=max2f(a,b);
  auto rr=__builtin_amdgcn_permlane32_swap(__float_as_uint(m),__float_as_uint(m),false,false);
  return max2f(__uint_as_float(rr[0]),__uint_as_float(rr[1]));
}
__device__ __forceinline__ void pv(f32x16*o,int vb,bf16x8 pa0,bf16x8 pa1,bf16x8 pa2,bf16x8 pa3){
  #pragma unroll
  for(int d0=0;d0<2;++d0){s16x4 lo[4],hi[4];
    #pragma unroll
    for(int ks=0;ks<4;++ks){
      asm volatile("ds_read_b64_tr_b16 %0,%1 offset:%c2":"=&v"(lo[ks]):"v"(vb),"i"(d0*4096+ks*1024):"memory");
      asm volatile("ds_read_b64_tr_b16 %0,%1 offset:%c2":"=&v"(hi[ks]):"v"(vb),"i"(d0*4096+ks*1024+512):"memory");}
    asm volatile("s_waitcnt lgkmcnt(0)":::"memory");SBAR();
    #define PK(k) (bf16x8){lo[k][0],lo[k][1],lo[k][2],lo[k][3],hi[k][0],hi[k][1],hi[k][2],hi[k][3]}
    o[d0]=__builtin_amdgcn_mfma_f32_32x32x16_bf16(pa0,PK(0),o[d0],0,0,0);
    o[d0]=__builtin_amdgcn_mfma_f32_32x32x16_bf16(pa1,PK(1),o[d0],0,0,0);
    o[d0]=__builtin_amdgcn_mfma_f32_32x32x16_bf16(pa2,PK(2),o[d0],0,0,0);
    o[d0]=__builtin_amdgcn_mfma_f32_32x32x16_bf16(pa3,PK(3),o[d0],0,0,0);
    #undef PK
  }
}

#ifndef ATTN_STORE16
#define ATTN_STORE16(p,v) (*(u32x4*)(p)=(v))
#endif
template<int THRL,int MODE> __device__ __forceinline__ void attn_unit(const bf16*Q0,const bf16*__restrict__ Kh,const bf16*__restrict__ Vh,bf16*O0,const int NT,const int R0w,const int nar0,const float*rpbh,char*shm){
  int tid_=threadIdx.x; asm volatile("":"+v"(tid_));
  const int tid=tid_,lane=tid&63,r32=lane&31,hi=lane>>5; const int wid=__builtin_amdgcn_readfirstlane(tid>>6);
  const bf16*Qw=Q0+(long)wid*QBLK*DM;
  const unsigned lds0=(unsigned)(uintptr_t)shm;
  float*wsf=(float*)(shm+LDS_WS)+wid*64;
  const bf16*ksrc=Kh+(long)lane*DM+wid*8;
  const bf16*vsrc=Vh+(long)(16*(wid&3)+(lane>>2))*DM+(wid>>2)*32+(lane&3)*8;
  const unsigned kdst=lds0+LDS_K+wid*1024, vdst=lds0+LDS_V+wid*1024;
  #define DMA_K(t,slot) glds16(ksrc+(long)TILE(t)*KVBLK*DM,(unsigned)__builtin_amdgcn_readfirstlane(kdst+(slot)))
  #define DMA_V(t,slot) glds16(vsrc+(long)TILE(t)*KVBLK*DM,(unsigned)__builtin_amdgcn_readfirstlane(vdst+(slot)))
  const int vb0=(int)(lds0+LDS_V)+((lane>>4)&1)*32+(lane&3)*8+(4*hi+((lane&15)>>2))*64;
  const char*Kbase=shm+LDS_K; bf16x8 kf[8];
  const lds_cptr shm3=(lds_cptr)shm; const lds_cptr kp0=shm3+LDS_K+hi*1024+r32*16; const lds_cptr vp0=shm3+LDS_V+((lane>>4)&1)*32+(lane&3)*8+(4*hi+((lane&15)>>2))*64;
  #define TILE(t) ((t)+(((t)>=4)?R0w:0))
  const int nr=nar0+(wid>>1), nc=32*(wid&1)+r32; const int nrs=min(max(nr-4,0),24), ncs=min(max(nc-8,0),48);
  const __attribute__((address_space(3))) float* ntab=(const __attribute__((address_space(3))) float*)((lds_cptr)shm+LDS_NATAB)+63-nc+4*hi;
  if(MODE==1){ __attribute__((address_space(3))) float* tw=(__attribute__((address_space(3))) float*)((__attribute__((address_space(3))) char*)shm+LDS_NATAB);
    for(int i=tid;i<15*128;i+=NW*64){ const int dr=i>>7, j=(i&127)-63; tw[i]=(j>=-15&&j<=15)?rpbh[dr*31+j+15]*1.4426950408889634f:0.f; } }
  DMA_K(0,0);DMA_V(0,0);DMA_K(1,SLOTB);
  bf16x8 qr[4];
  #pragma unroll
  for(int d0=0;d0<4;++d0)qr[d0]=*reinterpret_cast<const bf16x8*>(&Qw[(long)r32*DM+d0*16+hi*8]);
  float mhat=0.f,l_reg=0.f;f32x16 o[2];o[0]=f32x16{};o[1]=f32x16{};f32x16 negm=f32x16{}; if(MODE==0)asm volatile("":"+v"(negm));
  #define CMASK(P0,P1,t) do{ if(MODE==1){ if((t)<4){ _Pragma("unroll") for(int r=0;r<16;++r){P0[r]-=mhat;P1[r]-=mhat;} } else { const int kr_=R0w+(t)-4; \
      if((unsigned)(kr_-nrs)>=8u){ _Pragma("unroll") for(int r=0;r<16;++r){P0[r]=-INFINITY;P1[r]=-INFINITY;} } \
      else{ const __attribute__((address_space(3))) float* br_=ntab+(kr_-nr+7)*128; \
        _Pragma("unroll") for(int r=0;r<16;++r){ const int ko_=(r&3)+8*(r>>2); const int kc_=ko_+4*hi; \
          P0[r]=((unsigned)(kc_-ncs)<16u)?P0[r]+(br_[ko_]-mhat):-INFINITY; P1[r]=((unsigned)(kc_+32-ncs)<16u)?P1[r]+(br_[ko_+32]-mhat):-INFINITY; \
          if((r&3)==3){ asm volatile("":"+v"(P0),"+v"(P1)); SBAR(); } } } } } }while(0)
  bool resc=false;
  #define NEGMC (MODE==1?f32x16{}:negm)
  #define START(P0,P1) do{ const float rm=rowmax(P0,P1); resc=false; \
    { const float dl=rm; mhat=fadd_s(mhat,dl); \
      _Pragma("unroll") for(int r=0;r<16;++r){P0[r]=fsub_s(P0[r],dl);P1[r]=fsub_s(P1[r],dl);} \
      if(MODE==0){ _Pragma("unroll") for(int r=0;r<16;++r)negm[r]=-mhat; asm volatile("":"+v"(negm)); } } \
    _Pragma("unroll") for(int r=0;r<16;++r)P0[r]=__builtin_amdgcn_exp2f(P0[r]); }while(0)
  #define RESC() do{ if(resc){ asm volatile("s_waitcnt lgkmcnt(0)":::"memory"); \
      _Pragma("unroll") for(int d_=0;d_<2;++d_) _Pragma("unroll") for(int r=0;r<16;++r)o[d_][r]*=wsf[crow(r,hi)]; } }while(0)
  f32x16 pA0,pA1,pB0,pB1;
  int sl_prev=0,sl_cur=0,sl_next=SLOTB;
  #define ROT() do{sl_prev=sl_cur;sl_cur=sl_next;sl_next=(sl_next==(NSLOT-1)*SLOTB)?0:sl_next+SLOTB;}while(0)
  DMA_K(2,2*SLOTB);
  WAIT_BAR(3);
  qkt(pA0,pA1,Kbase,qr,negm,r32,hi);asm volatile("s_nop 15\n\ts_nop 7":"+v"(pA0),"+v"(pA1));CMASK(pA0,pA1,0);
  START(pA0,pA1);
  _Pragma("unroll") for(int r=0;r<16;++r)pA1[r]=__builtin_amdgcn_exp2f(pA1[r]);
  WAIT_BAR(0);
  DMA_K(3,0);DMA_V(1,SLOTB);
  ROT();
  kload8(kf,kp0+sl_cur);
  WAIT_BAR(2);
  s16x4 vlo[8],vhi[8]; u32x4 pw0,pw1,pw2,pw3;
  #define PKW(P,B) cvtpk_s(P[B],P[B+1])
  #define PAF(k) __builtin_bit_cast(bf16x8,pw##k)
  #define VFR(i) (bf16x8){vlo[i][0],vlo[i][1],vlo[i][2],vlo[i][3],vhi[i][0],vhi[i][1],vhi[i][2],vhi[i][3]}
  #define PIN(x) asm volatile("":"+v"(x))
  #define MX3(a,b,c) __builtin_fmaxf(__builtin_fmaxf((a),(b)),(c))
  #define GAPA(MF,A0,A1,A2,A3,W0,W1,PW) do{ MF; sacc+=A0; sacc+=A1; sacc+=A2; sacc+=A3; PIN(sacc); W0; W1; PIN(PW); SBAR(); }while(0)
  #define EX(v) __builtin_amdgcn_exp2f(v)
  #define GAPB(MF,X,B) do{ MF; X[B]=EX(X[B]); X[B+1]=EX(X[B+1]); X[B+2]=EX(X[B+2]); X[B+3]=EX(X[B+3]); PIN(X); SBAR(); }while(0)
  #define VRD(i) do{ vlo[i]=vtr(vp_+(((i)>>2)*4096+((i)&3)*1024)); vhi[i]=vtr(vp_+(((i)>>2)*4096+((i)&3)*1024+512)); }while(0)
  #define KRD(G,j) do{ if(G){ kload2(kf,kp0+sl_next,j); SBAR(); } }while(0)
  #define STEP(C0,C1,P0,P1,t,GK,GV,GL) do{ SBAR(); \
    const lds_cptr vp_=vp0+sl_prev; \
    VRD(0); SBAR(); float sacc=(P0[0]+P0[1]); \
    GAPA(C0=__builtin_amdgcn_mfma_f32_32x32x16_bf16(kf[0],qr[0],NEGMC,0,0,0), P0[2],P0[3],P0[4],P0[5],     pw0[0]=PKW(P0,0), pw0[1]=PKW(P0,2), pw0); \
    VRD(4); SBAR(); GAPA(C1=__builtin_amdgcn_mfma_f32_32x32x16_bf16(kf[1],qr[0],NEGMC,0,0,0), P0[6],P0[7],P0[8],P0[9],     pw0[2]=PKW(P0,4), pw0[3]=PKW(P0,6), pw0); \
    VRD(1); SBAR(); GAPA(C0=__builtin_amdgcn_mfma_f32_32x32x16_bf16(kf[2],qr[1],C0,0,0,0),   P0[10],P0[11],P0[12],P0[13], pw1[0]=PKW(P0,8), pw1[1]=PKW(P0,10), pw1); \
    VRD(5); SBAR(); GAPA(C1=__builtin_amdgcn_mfma_f32_32x32x16_bf16(kf[3],qr[1],C1,0,0,0),   P0[14],P0[15],P1[0],P1[1],   pw1[2]=PKW(P0,12),pw1[3]=PKW(P0,14), pw1); \
    VRD(2); SBAR(); GAPA(C0=__builtin_amdgcn_mfma_f32_32x32x16_bf16(kf[4],qr[2],C0,0,0,0),   P1[2],P1[3],P1[4],P1[5],     pw2[0]=PKW(P1,0), pw2[1]=PKW(P1,2), pw2); \
    VRD(6); SBAR(); GAPA(C1=__builtin_amdgcn_mfma_f32_32x32x16_bf16(kf[5],qr[2],C1,0,0,0),   P1[6],P1[7],P1[8],P1[9],     pw2[2]=PKW(P1,4), pw2[3]=PKW(P1,6), pw2); \
    VRD(3); SBAR(); GAPA(C0=__builtin_amdgcn_mfma_f32_32x32x16_bf16(kf[6],qr[3],C0,0,0,0),   P1[10],P1[11],P1[12],P1[13], pw3[0]=PKW(P1,8), pw3[1]=PKW(P1,10), pw3); \
    VRD(7); SBAR(); GAPA(C1=__builtin_amdgcn_mfma_f32_32x32x16_bf16(kf[7],qr[3],C1,0,0,0),   P1[14],P1[15],0.f,0.f,       pw3[2]=PKW(P1,12),pw3[3]=PKW(P1,14), pw3); \
    l_reg+=sacc; \
    if(GK){DMA_K((t)+3,sl_cur);} if(GV){DMA_V((t)+1,sl_next);} \
    CMASK(C0,C1,t); \
    { float a=MX3(C0[0],C0[1],C1[0]),b=MX3(C0[2],C0[3],C1[1]); a=MX3(a,C1[2],C1[3]); \
      _Pragma("unroll") for(int r=4;r<16;r+=4){a=MX3(a,C0[r],C0[r+1]);b=MX3(b,C0[r+2],C0[r+3]);a=MX3(a,C1[r],C1[r+1]);b=MX3(b,C1[r+2],C1[r+3]);} \
      float rm=__builtin_fmaxf(a,b); { auto rr=__builtin_amdgcn_permlane32_swap(__float_as_uint(rm),__float_as_uint(rm),false,false); rm=__builtin_fmaxf(__uint_as_float(rr[0]),__uint_as_float(rr[1])); } \
      resc=false; \
      if(__builtin_expect(__any(rm>(float)THRL),0)){ const float dl=__builtin_fmaxf(rm,0.f); mhat+=dl; \
        _Pragma("unroll") for(int r=0;r<16;++r){C0[r]-=dl;C1[r]-=dl;} \
        if(MODE==0){ _Pragma("unroll") for(int r=0;r<16;++r)negm[r]=-mhat; asm volatile("":"+v"(negm)); } \
        const float f=__builtin_amdgcn_exp2f(-dl); l_reg*=f; if(hi==0)wsf[r32]=f; resc=true; } } \
    SBAR(); \
    GAPB(o[0]=__builtin_amdgcn_mfma_f32_32x32x16_bf16(PAF(0),VFR(0),o[0],0,0,0), C0,0); \
    GAPB(o[1]=__builtin_amdgcn_mfma_f32_32x32x16_bf16(PAF(0),VFR(4),o[1],0,0,0), C0,4); \
    KRD(GL,0); GAPB(o[0]=__builtin_amdgcn_mfma_f32_32x32x16_bf16(PAF(1),VFR(1),o[0],0,0,0), C0,8); \
    KRD(GL,1); GAPB(o[1]=__builtin_amdgcn_mfma_f32_32x32x16_bf16(PAF(1),VFR(5),o[1],0,0,0), C0,12); \
    KRD(GL,2); GAPB(o[0]=__builtin_amdgcn_mfma_f32_32x32x16_bf16(PAF(2),VFR(2),o[0],0,0,0), C1,0); \
    KRD(GL,3); GAPB(o[1]=__builtin_amdgcn_mfma_f32_32x32x16_bf16(PAF(2),VFR(6),o[1],0,0,0), C1,4); \
    GAPB(o[0]=__builtin_amdgcn_mfma_f32_32x32x16_bf16(PAF(3),VFR(3),o[0],0,0,0), C1,8); \
    GAPB(o[1]=__builtin_amdgcn_mfma_f32_32x32x16_bf16(PAF(3),VFR(7),o[1],0,0,0), C1,12); \
    }while(0)
  int t=1;
  for(;t+5<NT;t+=2){
    STEP(pB0,pB1,pA0,pA1,t,true,true,true);     WAIT_BAR(2); RESC(); ROT();
    STEP(pA0,pA1,pB0,pB1,t+1,true,true,true);   WAIT_BAR(2); RESC(); ROT();
  }
  #define ENDW(tt) do{ if((tt)+3<NT){WAIT_BAR(2);} else if((tt)+2<NT){WAIT_BAR(1);} else {WAIT_BAR(0);} }while(0)
  for(;t+1<NT;t+=2){
    STEP(pB0,pB1,pA0,pA1,t,(t+3<NT),(t+1<NT),(t+1<NT));       ENDW(t);   RESC(); ROT();
    STEP(pA0,pA1,pB0,pB1,t+1,(t+4<NT),(t+2<NT),(t+2<NT));     ENDW(t+1); RESC(); ROT();
  }
  STEP(pB0,pB1,pA0,pA1,NT-1,false,false,false); RESC();
  { float sacc=pB0[0]+pB0[1]; _Pragma("unroll") for(int r=2;r<16;++r)sacc+=pB0[r]; _Pragma("unroll") for(int r=0;r<16;++r)sacc+=pB1[r]; l_reg+=sacc;
    pw0=(u32x4){PKW(pB0,0),PKW(pB0,2),PKW(pB0,4),PKW(pB0,6)};pw1=(u32x4){PKW(pB0,8),PKW(pB0,10),PKW(pB0,12),PKW(pB0,14)};pw2=(u32x4){PKW(pB1,0),PKW(pB1,2),PKW(pB1,4),PKW(pB1,6)};pw3=(u32x4){PKW(pB1,8),PKW(pB1,10),PKW(pB1,12),PKW(pB1,14)};
    SBAR(); pv(o,vb0+sl_cur,PAF(0),PAF(1),PAF(2),PAF(3)); }
  #undef PKW
  #undef PAF
  #undef VFR
  #undef PIN
  #undef MX3
  #undef GAPA
  #undef GAPB
  #undef EX
  #undef VRD
  #undef KRD
  #undef STEP
  #undef ENDW
  {auto rr=__builtin_amdgcn_permlane32_swap(__float_as_uint(l_reg),__float_as_uint(l_reg),false,false);l_reg=__uint_as_float(rr[0])+__uint_as_float(rr[1]);}
  if(hi==0)wsf[32+r32]=l_reg;asm volatile("s_waitcnt lgkmcnt(0)":::"memory");
  float rli[16];
  #pragma unroll
  for(int r=0;r<16;++r)rli[r]=__builtin_amdgcn_rcpf(wsf[32+crow(r,hi)]);
  bf16*Ow=O0+(long)wid*QBLK*DM;
  { bf16*stg=(bf16*)(shm+LDS_OST)+wid*2048;
    #pragma unroll
    for(int r=0;r<16;++r){const int orow=crow(r,hi);
      #pragma unroll
      for(int d0=0;d0<2;++d0)stg[orow*64+d0*32+r32]=__float2bfloat16(o[d0][r]*rli[r]);}
    asm volatile("s_waitcnt lgkmcnt(0)":::"memory");
    #pragma unroll
    for(int i=0;i<4;++i){const int row=i*8+(lane>>3),ch=lane&7; const u32x4 v=*(const u32x4*)(stg+row*64+ch*8); ATTN_STORE16(Ow+(long)row*DM+ch*8,v);} }
  asm volatile("s_waitcnt lgkmcnt(0)\n\ts_barrier":::"memory");
  #undef TILE
  #undef DMA_K
  #undef DMA_V
  #undef CMASK
  #undef NEGMC
  #undef START
  #undef RESC
  #undef ROT
}
constexpr int ATTN_LDS_BYTES=LDS_BYTES+NATAB_BYTES;
#undef SBAR
#undef WAIT_BAR
}
#define GAS __attribute__((address_space(1)))
#define LAS __attribute__((address_space(3)))
typedef unsigned short bf16;
typedef unsigned v4u __attribute__((ext_vector_type(4)));
typedef float f32x4 __attribute__((ext_vector_type(4)));
typedef short bf16x8 __attribute__((ext_vector_type(8)));
typedef GAS unsigned gu32;
typedef GAS unsigned long long gu64;
#define RLX_AGENT __ATOMIC_RELAXED, __HIP_MEMORY_SCOPE_AGENT
#define LDS_WAIT() asm volatile("s_waitcnt lgkmcnt(0)" ::: "memory")
#define VM_WAIT() asm volatile("s_waitcnt vmcnt(0)" ::: "memory")
__device__ __forceinline__ unsigned long long rt() { return __builtin_amdgcn_s_memrealtime(); }
__device__ __forceinline__ unsigned f2bf(float f) { unsigned u = __builtin_bit_cast(unsigned, f); return (u + 0x7fffu + ((u >> 16) & 1u)) >> 16; }
__device__ __forceinline__ unsigned pk2(float lo, float hi) { return f2bf(lo) | (f2bf(hi) << 16); }

#define XB_TMO      128
#define XB_XCNT(j)  (256  + 64 * (j))
#define XB_XSUB(j)  (1280 + 64 * (j))
#define XB_XGEN(j)  (2304 + 64 * (j))
#define XB_TOP      3328
#define XB_TOPGEN   3392
#define XCD_BAR_WORDS 3456
#define XB_SPIN_CAP (1u << 18)

__device__ __forceinline__ unsigned xb_ld(unsigned* p)              { return __hip_atomic_load(p, __ATOMIC_RELAXED, __HIP_MEMORY_SCOPE_AGENT); }
__device__ __forceinline__ unsigned xb_add(unsigned* p, unsigned v) { return __hip_atomic_fetch_add(p, v, __ATOMIC_RELAXED, __HIP_MEMORY_SCOPE_AGENT); }
__device__ __forceinline__ unsigned xb_xcc_id() { return (unsigned)__builtin_amdgcn_s_getreg((3 << 11) | 20) & 0xFu; }
#define XB_SPIN(cond, bar) do { unsigned _sp = 0; while (cond) { __builtin_amdgcn_s_sleep(1); \
    if ((++_sp & 255u) == 0u) { if (xb_ld(&(bar)[XB_TMO])) break; if (_sp > XB_SPIN_CAP) { atomicAdd(&(bar)[XB_TMO], 1u); break; } } } } while (0)

struct XcdBarrier {
    unsigned* bar; unsigned x;
    volatile LAS unsigned* st;
};

__device__ __forceinline__ XcdBarrier xcd_barrier_post(unsigned* bar, volatile LAS unsigned* st) {
    XcdBarrier b; b.bar = bar; b.x = xb_xcc_id(); b.st = st;
    if (threadIdx.x == 0) (void)xb_add(&bar[XB_XCNT(b.x)], 1u);
    return b;
}
__device__ __forceinline__ void xcd_barrier_complete(unsigned* bar, unsigned x, unsigned& nloc, unsigned& nx) {
    const unsigned G = gridDim.x * gridDim.y * gridDim.z;
    unsigned sum, cnt, mine, sp = 0u;
    for (;;) {
        sum = 0u; cnt = 0u; mine = 0u;
#pragma unroll
        for (unsigned j = 0; j < 16; ++j) { const unsigned c = xb_ld(&bar[XB_XCNT(j)]); sum += c; cnt += (c > 0u) ? 1u : 0u; mine = (j == x) ? c : mine; }
        if (sum == G) break;
        __builtin_amdgcn_s_sleep(1);
        if ((++sp & 255u) == 0u) { if (xb_ld(&bar[XB_TMO])) break; if (sp > XB_SPIN_CAP) { atomicAdd(&bar[XB_TMO], 1u); break; } }
    }
    nloc = mine > 0u ? mine : 1u; nx = cnt > 0u ? cnt : 1u;
}

__device__ __forceinline__ void xcd_barrier(const XcdBarrier& b) {
    asm volatile("s_waitcnt vmcnt(0)" ::: "memory");
    __syncthreads();
    if (threadIdx.x == 0) {
        unsigned* bar = b.bar;
        __builtin_amdgcn_s_waitcnt(0);
        unsigned nloc = b.st[0], nx = b.st[1];
        if (nloc == 0u) { xcd_barrier_complete(bar, b.x, nloc, nx); b.st[0] = nloc; b.st[1] = nx; }
        const unsigned old = xb_add(&bar[XB_XSUB(b.x)], 1u);
        const unsigned gen = old / nloc;
        if (old + 1u == (gen + 1u) * nloc) {
            __builtin_amdgcn_fence(__ATOMIC_RELEASE, "agent");
            asm volatile("s_waitcnt vmcnt(0)" ::: "memory");
            const unsigned og = xb_add(&bar[XB_TOP], 1u);
            const unsigned tg = og / nx;
            if (og + 1u == (tg + 1u) * nx) xb_add(&bar[XB_TOPGEN], 1u);
            else XB_SPIN(xb_ld(&bar[XB_TOPGEN]) == tg, bar);
            __builtin_amdgcn_fence(__ATOMIC_ACQUIRE, "agent");
            xb_add(&bar[XB_XGEN(b.x)], 1u);
            asm volatile("s_waitcnt vmcnt(0)" ::: "memory");
        } else {
            XB_SPIN(xb_ld(&bar[XB_XGEN(b.x)]) == gen, bar);
            __builtin_amdgcn_fence(__ATOMIC_ACQUIRE, "agent");
            asm volatile("s_waitcnt vmcnt(0)" ::: "memory");
        }
    }
    __syncthreads();
}
constexpr int DMODEL = 1024, NB = 32, SEQ = 2048, CTXL = 256, SB = SEQ + CTXL  , DEPTH = 2, NE = 16;
#ifndef MK_NCHUNK
#define MK_NCHUNK 2
#endif
constexpr int NCHUNK = MK_NCHUNK, BC = NB / NCHUNK, MC = BC * SB;
constexpr int PW = 7424;
constexpr int C_LX = 0, C_LG = 1024, C_NQ = 2048, C_GQ = 2560, C_NK = 3072, C_NV = 3584, C_GK = 4096, C_GV = 4224, C_GA = 4352, C_GB = 5376, C_GC = 6400;
constexpr float EPS = 1e-6f;
constexpr float QSCALE = 0.125f * 1.4426950408889634f;
constexpr int NMOD = 6 * DMODEL;

enum { I_X = 0, I_C, I_CTX, I_CCTX, I_WMOD, I_BMOD, I_NORMG, I_WIN, I_CONVW, I_CONVB, I_LWA, I_LBA, I_LWX, I_LBX, I_LLAM, I_RPB, I_QNG, I_KNG, I_WOA, I_WOB, I_WOC, I_WOUT, I_WR, I_WG, I_WU, I_WD, N_IN };

struct Args { const float* in[N_IN]; float* out; unsigned char* ws; int ph_lo, ph_hi; };
constexpr size_t MiB = 1u << 20;
constexpr size_t WS_CTL = 0, CTL_ZERO_BYTES = 3 * MiB;
constexpr size_t CTL_MOD_OFF = 1 * MiB;
constexpr int CW_TMO = 0, CW_BAR = 4096;
constexpr size_t WS_W = 4 * MiB, LW = 118 * MiB;
constexpr size_t W_P = 0, W_O = 15 * MiB, W_OUT = 19 * MiB, W_LRU = 21 * MiB, W_GU = 22 * MiB, W_D = 86 * MiB;
constexpr size_t WS_XC = 240 * MiB;
constexpr size_t WS_H = 272 * MiB;
constexpr size_t WS_HT = 344 * MiB;
constexpr size_t WS_AFFEN = 416 * MiB, WS_AFFNE = 419 * MiB, WS_SLOT = 422 * MiB;
constexpr size_t WS_P = 426 * MiB;
constexpr size_t WS_O1 = WS_P, WS_HS = WS_P + 72 * MiB, WS_ACT = WS_P + 216 * MiB;
constexpr size_t WS_END = WS_P + (size_t)MC * PW * 2;
static_assert(NCHUNK == 2, "the workspace map below is laid out for two chunks");
static_assert(WS_END <= 1024 * MiB && (size_t)MC * 1024 * 2 <= 72 * MiB && WS_ACT + 144 * MiB <= WS_END, "d_ws map");
static_assert(CTL_MOD_OFF + (size_t)DEPTH * 33 * NMOD * 4 <= CTL_ZERO_BYTES, "mod accumulators inside the memset region");

constexpr int RING_BYTES = 131072, LDSCTL_OFF = RING_BYTES, MISC_OFF = LDSCTL_OFF + 320, LDS_BYTES = 147456;

__device__ __forceinline__ float bf2f(unsigned v) { return __uint_as_float(v << 16); }
__device__ __forceinline__ float shfl_idx(float v, int src) { return __builtin_bit_cast(float, __builtin_amdgcn_ds_bpermute(src << 2, __builtin_bit_cast(int, v))); }
__device__ __forceinline__ float shx(float v, int m, int lane) { return shfl_idx(v, lane ^ m); }
__device__ __forceinline__ float wave_sum(float v, int lane) {
#pragma unroll
    for (int o = 1; o < 64; o <<= 1) v += shx(v, o, lane);
    return v;
}
#define PH_IDS int tid_ = threadIdx.x; asm volatile("" : "+v"(tid_)); const int tid = tid_, lane = tid & 63, wid = __builtin_amdgcn_readfirstlane(tid >> 6); \
    int vcu_ = F.vcu; asm volatile("" : "+s"(vcu_)); const int vcu = vcu_; (void)vcu; (void)wid; (void)lane;
__device__ __forceinline__ float fast_rcp(float x) { return __builtin_amdgcn_rcpf(x); }
__device__ __forceinline__ float sigmoidf_(float x) { return fast_rcp(1.f + __expf(-x)); }

struct Frame {
    LAS unsigned char* lds;
    int vcu, G;
    float* out; unsigned char* ws;
};

__device__ __forceinline__ void tr_item(const float* W, int ldw, bf16* WT, int ldt, int k0, int n0, int drow0, int dk0, float scale, LAS float* scr, int lane) {
#pragma unroll 8
    for (int i = 0; i < 32; ++i) { const int kk = 2 * i + (lane >> 5); scr[kk * 33 + (lane & 31)] = W[(size_t)(k0 + kk) * ldw + n0 + (lane & 31)] * scale; }
    LDS_WAIT(); asm volatile("" ::: "memory");
    const int c = lane & 7;
#pragma unroll
    for (int j = 0; j < 4; ++j) { const int n = (lane >> 3) + 8 * j; const LAS float* s = scr + (8 * c) * 33 + n;
        v4u o; o.x = pk2(s[0 * 33], s[1 * 33]); o.y = pk2(s[2 * 33], s[3 * 33]); o.z = pk2(s[4 * 33], s[5 * 33]); o.w = pk2(s[6 * 33], s[7 * 33]);
        *(GAS v4u*)(WT + (size_t)(drow0 + n) * ldt + dk0 + 8 * c) = o; }
    LDS_WAIT(); asm volatile("" ::: "memory");
}

constexpr int IT_WIN = 16 * 232, IT_WOA = 512, IT_WOB = 256, IT_WOC = 256, IT_WOUT = 512, IT_LRU = 256, IT_GU = 16 * 1024, IT_D = 16 * 512;
constexpr int IT_LAYER = IT_WIN + IT_WOA + IT_WOB + IT_WOC + IT_WOUT + IT_LRU + IT_GU + IT_D;
__device__ __forceinline__ void ph_prologue(const Args& A_, Frame& F) {
    PH_IDS
    float* mod = (float*)(F.ws + CTL_MOD_OFF);
    for (int q = vcu + F.G * wid; q < DEPTH * 96 * 3; q += F.G * 8) {
        const int l = q / 288, rem = q % 288, g = rem / 3, r0 = (rem % 3) * 11;
        const float* W = A_.in[I_WMOD] + (size_t)l * DMODEL * NMOD + g * 64 + lane;
        float acc[11];
#pragma unroll
        for (int i = 0; i < 11; ++i) acc[i] = 0.f;
        for (int kb = 0; kb < 16; ++kb) {
            float sv[11];
#pragma unroll
            for (int i = 0; i < 11; ++i) { const int r = r0 + i; const float c = (r < 32) ? A_.in[I_C][r * DMODEL + kb * 64 + lane] : A_.in[I_CCTX][kb * 64 + lane]; sv[i] = c * sigmoidf_(c); }
            const float* Wk = W + (size_t)(kb * 64) * NMOD;
#pragma unroll 4
            for (int kk = 0; kk < 64; ++kk) { const float w = Wk[(size_t)kk * NMOD];
#pragma unroll
                for (int i = 0; i < 11; ++i) acc[i] += __builtin_bit_cast(float, __builtin_amdgcn_readlane(__builtin_bit_cast(int, sv[i]), kk)) * w; }
        }
        const float bm = A_.in[I_BMOD][l * NMOD + g * 64 + lane];
#pragma unroll
        for (int i = 0; i < 11; ++i) mod[(size_t)(l * 33 + r0 + i) * NMOD + g * 64 + lane] = acc[i] + bm;
    }
    LAS float* scr = (LAS float*)(F.lds + 32768 + wid * 8704);
    const int gw = vcu * 8 + wid, NGW = F.G * 8;
    for (int it = gw; it < DEPTH * IT_LAYER; it += NGW) {
        const int l = it / IT_LAYER; int r = it - l * IT_LAYER;
        unsigned char* wl = F.ws + WS_W + (size_t)l * LW;
        if (r < IT_WIN) { const int k0 = 64 * (r / 232), n0 = 32 * (r % 232);
            const int dr = (n0 < 2560) ? n0 : (n0 < 3584) ? n0 + 512 : (n0 < 4096) ? n0 - 1024 : n0;
            const float sc = (n0 >= 2048 && n0 < 2560) ? QSCALE : 1.f;
            tr_item(A_.in[I_WIN] + (size_t)l * DMODEL * PW, PW, (bf16*)(wl + W_P), 1024, k0, n0, dr, k0, sc, scr, lane); continue; } r -= IT_WIN;
        if (r < IT_WOA) { const int k0 = 64 * (r / 32), n0 = 32 * (r % 32); tr_item(A_.in[I_WOA] + (size_t)l * 1024 * 1024, 1024, (bf16*)(wl + W_O), 2048, k0, n0, n0, k0, 1.f, scr, lane); continue; } r -= IT_WOA;
        if (r < IT_WOB) { const int k0 = 64 * (r / 32), n0 = 32 * (r % 32); tr_item(A_.in[I_WOB] + (size_t)l * 512 * 1024, 1024, (bf16*)(wl + W_O), 2048, k0, n0, n0, 1024 + k0, 1.f, scr, lane); continue; } r -= IT_WOB;
        if (r < IT_WOC) { const int k0 = 64 * (r / 32), n0 = 32 * (r % 32); tr_item(A_.in[I_WOC] + (size_t)l * 512 * 1024, 1024, (bf16*)(wl + W_O), 2048, k0, n0, n0, 1536 + k0, 1.f, scr, lane); continue; } r -= IT_WOC;
        if (r < IT_WOUT) { const int k0 = 64 * (r / 32), n0 = 32 * (r % 32); tr_item(A_.in[I_WOUT] + (size_t)l * 1024 * 1024, 1024, (bf16*)(wl + W_OUT), 1024, k0, n0, n0, k0, 1.f, scr, lane); continue; } r -= IT_WOUT;
        if (r < IT_LRU) { const int mi = r >> 3, sub = r & 7, dir = mi >> 4, mat = (mi >> 3) & 1, blk = mi & 7, k0 = 64 * (sub >> 2), n0 = 32 * (sub & 3);
            const float* src = (mat ? A_.in[I_LWX] : A_.in[I_LWA]) + (size_t)((l * 2 + dir) * 8 + blk) * 128 * 128;
            tr_item(src, 128, (bf16*)(wl + W_LRU) + (size_t)((dir * 2 + mat) * 8 + blk) * 128 * 128, 128, k0, n0, n0, k0, 1.f, scr, lane); continue; } r -= IT_LRU;
        if (r < IT_GU) { const int e = r >> 10, rr = r & 1023, mat = rr >> 9, q = rr & 511, k0 = 64 * (q / 32), n0 = 32 * (q % 32);
            const float* src = (mat ? A_.in[I_WU] : A_.in[I_WG]) + (size_t)(l * NE + e) * 1024 * 1024;
            tr_item(src, 1024, (bf16*)(wl + W_GU) + (size_t)e * 2048 * 1024, 1024, k0, n0, (n0 >> 7) * 256 + mat * 128 + (n0 & 127), k0, 1.f, scr, lane); continue; } r -= IT_GU;
        { const int e = r >> 9, q = r & 511, k0 = 64 * (q / 32), n0 = 32 * (q % 32);
            tr_item(A_.in[I_WD] + (size_t)(l * NE + e) * 1024 * 1024, 1024, (bf16*)(wl + W_D) + (size_t)e * 1024 * 1024, 1024, k0, n0, n0, k0, 1.f, scr, lane); }
    }
}

__device__ __forceinline__ void row_load(const float* p, int lane, f32x4 (&v)[4]) {
#pragma unroll
    for (int j = 0; j < 4; ++j) v[j] = ((const f32x4*)p)[lane + 64 * j];
}
__device__ __forceinline__ float row_rstd(const f32x4 (&v)[4], int lane) {
    float s = 0.f;
#pragma unroll
    for (int j = 0; j < 4; ++j) s += (v[j].x * v[j].x + v[j].y * v[j].y) + (v[j].z * v[j].z + v[j].w * v[j].w);
    return rsqrtf(wave_sum(s, lane) * (1.f / DMODEL) + EPS);
}
__device__ __forceinline__ void row_store_bf16(bf16* p, int lane, const f32x4 (&v)[4]) {
#pragma unroll
    for (int j = 0; j < 4; ++j) ((unsigned long long*)p)[lane + 64 * j] = (unsigned long long)pk2(v[j].x, v[j].y) | ((unsigned long long)pk2(v[j].z, v[j].w) << 32);
}
__device__ __forceinline__ void row_load_bf16(const bf16* p, int lane, f32x4 (&v)[4]) {
#pragma unroll
    for (int j = 0; j < 4; ++j) { const unsigned long long w = ((const unsigned long long*)p)[lane + 64 * j];
        v[j].x = bf2f((unsigned)w & 0xffffu); v[j].y = bf2f(((unsigned)w >> 16)); v[j].z = bf2f((unsigned)(w >> 32) & 0xffffu); v[j].w = bf2f((unsigned)(w >> 48)); }
}
__device__ __forceinline__ const float* res_src(const Args& A_, const Frame& F, int l, int b, int s) {
    if (s < CTXL) return (l == 0 ? A_.in[I_CTX] : (const float*)(F.ws + WS_XC)) + ((size_t)b * CTXL + s) * DMODEL;
    return (l == 0 ? A_.in[I_X] : (const float*)F.out) + ((size_t)b * SEQ + (s - CTXL)) * DMODEL;
}
__device__ __forceinline__ float* res_dst(const Args& A_, const Frame& F, int b, int s) {
    if (s < CTXL) return (float*)(F.ws + WS_XC) + ((size_t)b * CTXL + s) * DMODEL;
    return F.out + ((size_t)b * SEQ + (s - CTXL)) * DMODEL;
}
__device__ __forceinline__ const float* mod_row(const Args& A_, const Frame& F, int l, int b, int s) { return (const float*)(F.ws + CTL_MOD_OFF) + (size_t)(l * 33 + (s < CTXL ? 32 : b)) * NMOD; }

__device__ __forceinline__ void ph_norm1(const Args& A_, Frame& F, int l, int ch) {
    PH_IDS
    const int gw = vcu * 8 + wid, NGW = F.G * 8;
    const float* ng = A_.in[I_NORMG] + (size_t)(l * 4 + 0) * DMODEL;
    bf16* H = (bf16*)(F.ws + WS_H);
    for (int row = gw; row < MC; row += NGW) {
        const int bl = row / SB, s = row - bl * SB, b = ch * BC + bl;
        f32x4 v[4]; row_load(res_src(A_, F, l, b, s), lane, v);
        const float rstd = row_rstd(v, lane);
        const float* mr = mod_row(A_, F, l, b, s);
#pragma unroll
        for (int j = 0; j < 4; ++j) { const f32x4 g = ((const f32x4*)ng)[lane + 64 * j], sh = ((const f32x4*)mr)[lane + 64 * j], sc = ((const f32x4*)(mr + DMODEL))[lane + 64 * j];
            v[j] = (v[j] * rstd) * g * (sc + 1.f) + sh; }
        row_store_bf16(H + (size_t)row * DMODEL, lane, v);
    }
}

__device__ __forceinline__ void ph_prep(const Args& A_, Frame& F, int l) {
    PH_IDS
    const int gw = vcu * 8 + wid, NGW = F.G * 8;
    bf16* P = (bf16*)(F.ws + WS_P);
    const float gq = A_.in[I_QNG][l * 64 + lane], gk = A_.in[I_KNG][l * 64 + lane];
    const int i = lane & 31, jf = i & 15;
    const float invf = exp2f(-(float)jf * (13.287712379549449f / 16.f)) * 0.15915494309189535f;
    for (int row = gw; row < MC; row += NGW) {
        const int s = row % SB; const bool lat = s >= CTXL; const int t = s - CTXL;
        float cs = 1.f, sn = 0.f;
        if (lat) { const float rev = (float)((i < 16) ? (t >> 6) : (t & 63)) * invf; const float fr = __builtin_amdgcn_fractf(rev); cs = __builtin_amdgcn_cosf(fr); sn = __builtin_amdgcn_sinf(fr); }
        bf16* pr = P + (size_t)row * PW;
        float v[10];
#pragma unroll
        for (int hh = 0; hh < 10; ++hh) v[hh] = bf2f(pr[(hh < 8 ? C_GQ + hh * 64 : C_GK + (hh - 8) * 64) + lane]);
#pragma unroll
        for (int hh = 0; hh < 10; ++hh) {
            const float ss = wave_sum(v[hh] * v[hh], lane);
            float y = v[hh] * rsqrtf(ss * (1.f / 64.f) + EPS) * (hh < 8 ? gq : gk);
            const float o = shx(y, 32, lane);
            y = (lane < 32) ? (y * cs - o * sn) : (o * sn + y * cs);
            if (hh < 8) y *= QSCALE;
            pr[(hh < 8 ? C_GQ + hh * 64 : C_GK + (hh - 8) * 64) + lane] = (bf16)f2bf(y);
        }
    }
}
constexpr int LRU_UP = 136;
constexpr int LRU_U0 = 0, LRU_UB = 64 * LRU_UP * 2, LRU_AGG = 2 * LRU_UB, LRU_CW = LRU_AGG + 8 * 16 * 8;
__device__ __forceinline__ float gelu_tanh(float g) { const float z = 0.7978845608028654f * (g + 0.044715f * g * g * g); return g * (1.f - fast_rcp(1.f + __expf(2.f * z))); }
__device__ __forceinline__ void ph_lru(const Args& A_, Frame& F, int l) {
    PH_IDS
    const int fr = lane & 15, fq = lane >> 4, nt = wid & 3, mh = wid >> 2;
    bf16* P = (bf16*)(F.ws + WS_P); bf16* HT = (bf16*)(F.ws + WS_HT);
    const bf16* WL = (const bf16*)(F.ws + WS_W + (size_t)l * LW + W_LRU);
    LAS unsigned char* lds = F.lds;
    LAS float* AGG = (LAS float*)(lds + LRU_AGG); LAS float* CW = (LAS float*)(lds + LRU_CW);
    for (int item = blockIdx.x; item < BC * 16; item += F.G) {
        const int bl = item >> 4, cb = item & 15, blk = cb >> 1, half = cb & 1;
        __syncthreads();
        for (int i = tid; i < 640; i += 512) CW[i] = (i < 512) ? A_.in[I_CONVW][(size_t)(l * 4 + (i >> 7)) * 1024 + blk * 128 + (i & 127)] : A_.in[I_CONVB][l * 1024 + blk * 128 + (i - 512)];
        __syncthreads();
        const int rho_c = tid >> 3, cg = tid & 7;
        const int chl = half * 64 + nt * 16 + fr, chan = blk * 128 + chl;
        for (int d = 0; d < 2; ++d) {
            bf16x8 Bf[2][4];
#pragma unroll
            for (int mat = 0; mat < 2; ++mat)
#pragma unroll
                for (int ks = 0; ks < 4; ++ks) Bf[mat][ks] = *(const bf16x8*)(WL + ((size_t)((d * 2 + mat) * 8 + blk) * 128 + chl) * 128 + ks * 32 + fq * 8);
            const float ba = A_.in[I_LBA][(l * 2 + d) * 1024 + chan], bx = A_.in[I_LBX][(l * 2 + d) * 1024 + chan];
            const float lamc = -8.f * log1pf(__expf(-A_.in[I_LLAM][(l * 2 + d) * 1024 + chan])) * 1.4426950408889634f;
            float hprev = 0.f;
            bf16x8 xr[4][2];
#define LRU_LOADX(st) do { const int tc_ = (d == 0) ? (st) : ((st) < 4 ? 3 - (st) : 39 - (st)); const int seg0_ = (tc_ < 4) ? 0 : CTXL, segl_ = (tc_ < 4) ? CTXL : SEQ, tcl_ = (tc_ < 4) ? tc_ : tc_ - 4; \
                const int tok_ = (d == 0) ? rho_c : 63 - rho_c; \
                _Pragma("unroll") for (int k_ = 0; k_ < 4; ++k_) { const int st_ = 64 * tcl_ + tok_ + k_ - 2; \
                    if (st_ >= 0 && st_ < segl_) { const bf16* p_ = P + (size_t)(bl * SB + seg0_ + st_) * PW + C_LX + blk * 128 + cg * 16; xr[k_][0] = *(const bf16x8*)p_; xr[k_][1] = *(const bf16x8*)(p_ + 8); } \
                    else { xr[k_][0] = (bf16x8){0, 0, 0, 0, 0, 0, 0, 0}; xr[k_][1] = (bf16x8){0, 0, 0, 0, 0, 0, 0, 0}; } } } while (0)
            LRU_LOADX(0);
            for (int step = 0; step < 36; ++step) {
                const int tc = (d == 0) ? step : (step < 4 ? 3 - step : 39 - step);
                LAS unsigned char* U = lds + LRU_U0 + (step & 1) * LRU_UB;
                {
                    unsigned pk[8];
#pragma unroll
                    for (int c2 = 0; c2 < 8; ++c2) { float u2[2];
#pragma unroll
                        for (int e = 0; e < 2; ++e) { const int c = 2 * c2 + e; float a = CW[512 + cg * 16 + c];
#pragma unroll
                            for (int k = 0; k < 4; ++k) a += CW[k * 128 + cg * 16 + c] * bf2f((unsigned short)xr[k][c >> 3][c & 7]);
                            u2[e] = a; }
                        pk[c2] = pk2(u2[0], u2[1]); }
                    *(LAS v4u*)(U + rho_c * (LRU_UP * 2) + cg * 32) = (v4u){pk[0], pk[1], pk[2], pk[3]};
                    *(LAS v4u*)(U + rho_c * (LRU_UP * 2) + cg * 32 + 16) = (v4u){pk[4], pk[5], pk[6], pk[7]};
                }
                if (step + 1 < 36) LRU_LOADX(step + 1);
                __syncthreads();
                f32x4 acc[2][2];
#pragma unroll
                for (int m = 0; m < 2; ++m) { acc[m][0] = (f32x4){0.f, 0.f, 0.f, 0.f}; acc[m][1] = (f32x4){0.f, 0.f, 0.f, 0.f};
#pragma unroll
                    for (int ks = 0; ks < 4; ++ks) { const bf16x8 Af = *(const LAS bf16x8*)(U + (32 * mh + 16 * m + fr) * (LRU_UP * 2) + (ks * 32 + fq * 8) * 2);
                        acc[m][0] = __builtin_amdgcn_mfma_f32_16x16x32_bf16(Af, Bf[0][ks], acc[m][0], 0, 0, 0);
                        acc[m][1] = __builtin_amdgcn_mfma_f32_16x16x32_bf16(Af, Bf[1][ks], acc[m][1], 0, 0, 0); } }
                float Pa[2][4], Pb[2][4];
#pragma unroll
                for (int m = 0; m < 2; ++m) { float A = 1.f, Bv = 0.f;
#pragma unroll
                    for (int j = 0; j < 4; ++j) { const int rho = 32 * mh + 16 * m + 4 * fq + j;
                        const float u = bf2f(*(const LAS unsigned short*)(U + rho * (LRU_UP * 2) + chl * 2));
                        const float r = sigmoidf_(acc[m][0][j] + ba), ig = sigmoidf_(acc[m][1][j] + bx);
                        const float a = exp2f(lamc * r); const float b = sqrtf(fmaxf(1.f - a * a, 0.f)) * (ig * u);
                        Bv = a * Bv + b; A *= a; Pa[m][j] = A; Pb[m][j] = Bv; } }
                float EA[2], EB[2], TA[2], TB[2];
#pragma unroll
                for (int m = 0; m < 2; ++m) { float IA = Pa[m][3], IB = Pb[m][3];
                    { const float pa = shfl_idx(IA, (lane - 16) & 63), pb = shfl_idx(IB, (lane - 16) & 63); if (fq >= 1) { IB = IA * pb + IB; IA = IA * pa; } }
                    { const float pa = shfl_idx(IA, (lane - 32) & 63), pb = shfl_idx(IB, (lane - 32) & 63); if (fq >= 2) { IB = IA * pb + IB; IA = IA * pa; } }
                    const float ea = shfl_idx(IA, (lane - 16) & 63), eb = shfl_idx(IB, (lane - 16) & 63); EA[m] = (fq == 0) ? 1.f : ea; EB[m] = (fq == 0) ? 0.f : eb;
                    TA[m] = shfl_idx(IA, 48 + fr); TB[m] = shfl_idx(IB, 48 + fr); }
                EB[1] = EA[1] * TB[0] + EB[1]; EA[1] = EA[1] * TA[0];
                const float WA = TA[0] * TA[1], WB = TA[1] * TB[0] + TB[1];
                if (fq == 0) { AGG[(wid * 16 + fr) * 2] = WA; AGG[(wid * 16 + fr) * 2 + 1] = WB; }
                __syncthreads();
                const float OA = AGG[((wid ^ 4) * 16 + fr) * 2], OB = AGG[((wid ^ 4) * 16 + fr) * 2 + 1];
                float hin, hnext;
                if (mh == 0) { hin = hprev; hnext = OA * (WA * hprev + WB) + OB; } else { hin = OA * hprev + OB; hnext = WA * hin + WB; }
                hprev = hnext;
#pragma unroll
                for (int m = 0; m < 2; ++m) { const float hg = EB[m] + EA[m] * hin;
#pragma unroll
                    for (int j = 0; j < 4; ++j) { const int rho = 32 * mh + 16 * m + 4 * fq + j; const int tok = (d == 0) ? rho : 63 - rho;
                        const size_t row = (size_t)(bl * SB + 64 * tc + tok);
                        const float h = Pb[m][j] + Pa[m][j] * hg;
                        if (d == 0) HT[row * DMODEL + chan] = (bf16)f2bf(h);
                        else { bf16* yp = P + row * PW + C_LG + chan; const float hf = bf2f(HT[row * DMODEL + chan]); *yp = (bf16)f2bf((hf + h) * gelu_tanh(bf2f(*yp))); } } }
            }
            VM_WAIT(); __syncthreads();
        }
#undef LRU_LOADX
    }
}

__device__ __forceinline__ void ph_attn(const Args& A_, Frame& F, int l, char* lds_generic) {
    PH_IDS
    using abf = attn_body::bf16;
    abf* P = (abf*)(F.ws + WS_P);
#ifndef MK_ATT_SKIP_DENSE
    for (int k = 0; k < 5; ++k) {
        const abf *Q0, *Kh, *Vh; int NT;
        if (k < 4) { const int u = vcu + F.G * k; if (u >= BC * 64) continue;
            const int qb = ((u & 7) + 2 * (u >> 8)) & 7, rest = ((u >> 3) & 31) + 32 * (u >> 8), bl = rest >> 3, h = rest & 7;
            Q0 = P + (size_t)(bl * SB + CTXL + 256 * qb) * PW + C_GQ + h * 64; Kh = P + (size_t)(bl * SB) * PW + C_GK + (h >> 2) * 64; Vh = Kh + (C_GV - C_GK); NT = SB / 64; }
        else { if (l != 0) continue; const int u = vcu; if (u >= BC * 16) continue; const int kind = u / (BC * 8), idx = u % (BC * 8), bl = idx >> 3, h = idx & 7;
            if (kind == 0) { Q0 = P + (size_t)(bl * SB) * PW + C_GQ + h * 64; Kh = P + (size_t)(bl * SB) * PW + C_GK + (h >> 2) * 64; Vh = Kh + (C_GV - C_GK); }
            else { Q0 = P + (size_t)(bl * SB) * PW + C_NQ + h * 64; Kh = P + (size_t)(bl * SB) * PW + C_NK + h * 64; Vh = Kh + (C_NV - C_NK); }
            NT = CTXL / 64; }
        attn_body::attn_unit<8, 0>(Q0, Kh, Vh, (abf*)Q0, NT, 0, 0, nullptr, lds_generic);
    }
#endif
#ifndef MK_ATT_SKIP_NA
    for (int k = 0; k < 4; ++k) {
        const int u = vcu + F.G * k; if (u >= BC * 64) continue;
        const int qb = ((u & 7) + 2 * (u >> 8)) & 7, rest = ((u >> 3) & 31) + 32 * (u >> 8), bl = rest >> 3, h = rest & 7;
        const abf* Q0 = P + (size_t)(bl * SB + CTXL + 256 * qb) * PW + C_NQ + h * 64; const abf* Kh = P + (size_t)(bl * SB) * PW + C_NK + h * 64; const abf* Vh = Kh + (C_NV - C_NK);
        const int NT = 4 + ((qb == 0 || qb == 7) ? 8 : 12), R0w = (qb == 0) ? 0 : 4 * qb - 4;
        attn_body::attn_unit<8, 1>(Q0, Kh, Vh, (abf*)Q0, NT, R0w, 4 * qb, A_.in[I_RPB] + (size_t)(l * 8 + h) * 15 * 31, lds_generic);
    }
#endif
}

struct TileMap {
    int nM, nN, nwg, G, c;
    __device__ __forceinline__ void init(int nM_, int nN_, int G_, int c_) { nM = nM_; nN = nN_; nwg = nM_ * nN_; G = G_; c = c_; }
    __device__ __forceinline__ bool get(int i, int& pm, int& pn) const {
        const long L = (long)i * G + c; if (L >= nwg) return false;
        int wgid = (int)L; { const int q = nwg / 8, r = nwg % 8, xcd = wgid % 8, off = wgid / 8; wgid = (xcd < r ? xcd * (q + 1) : r * (q + 1) + (xcd - r) * q) + off; }
        const int nig = 8 * nN, gid = wgid / nig, fm = gid * 8, gsz = (nM - fm) < 8 ? (nM - fm) : 8;
        pm = fm + ((wgid % nig) % gsz); pn = (wgid % nig) / gsz; return true;
    }
};
struct SchedPlain {
    TileMap T; const char* A; const char* B; size_t astep, bstep; bool skipctx;
    __device__ __forceinline__ bool next(int i, pg8::Unit& u) const { int pm, pn; if (!T.get(i, pm, pn)) return false; if (skipctx) pm = (pm >> 3) * 9 + 1 + (pm & 7);
        u.pm = pm; u.pn = pn; u.A = A + (size_t)pm * astep; u.B = B + (size_t)pn * bstep; return true; }
    __device__ __forceinline__ void a_ready(const pg8::Unit&) const {}
    __device__ __forceinline__ void done(const pg8::Unit&) const {}
};
struct SchedMoe {
    TileMap T; const char* A; const char* B; size_t astep, bstep, estep;
    __device__ __forceinline__ bool next(int i, pg8::Unit& u) const { int pm, pn; if (!T.get(i, pm, pn)) return false;
        const int e = (pm < NE * BC) ? pm / BC : (pm - NE * BC) / (BC / 8);
        u.pm = pm; u.pn = pn; u.A = A + (size_t)pm * astep; u.B = B + (size_t)e * estep + (size_t)pn * bstep; return true; }
    __device__ __forceinline__ void a_ready(const pg8::Unit&) const {}
    __device__ __forceinline__ void done(const pg8::Unit&) const {}
};
struct EpiMerge {
    static constexpr bool PERM = true, AFTER_DRAIN = false; static constexpr int HOOK_T0 = 16, HOOK_T1 = 24;
    const bf16* Pg; bf16* O;
    __device__ __forceinline__ void khook(pg8::f32x4 (&acc)[2][2][4][2], const pg8::Unit& u, int t, int wr, int wc, int fr, int fq) const {
        const int cn = (t == HOOK_T0) ? C_GA : C_GB, cd = cn + 1024;
        int row0 = u.pm * 256 + wr * 64 + fr, col0 = u.pn * 256 + wc * 32 + 8 * fq;
        asm volatile("" : "+v"(row0), "+v"(col0));
#pragma unroll
        for (int ai = 0; ai < 2; ++ai)
#pragma unroll
            for (int m = 0; m < 4; ++m) { const bf16* rp = Pg + (size_t)(row0 + ai * 128 + m * 16) * PW + col0;
#pragma unroll
                for (int bj = 0; bj < 2; ++bj) { const v4u gn = *(const v4u*)(rp + cn + bj * 128), gd = *(const v4u*)(rp + cd + bj * 128);
#pragma unroll
                    for (int e = 0; e < 8; ++e) { const unsigned wn = gn[e >> 1], wd = gd[e >> 1]; const float ln = bf2f((e & 1) ? (wn >> 16) : (wn & 0xffffu)), ld = bf2f((e & 1) ? (wd >> 16) : (wd & 0xffffu));
                        acc[ai][bj][m][e >> 2][e & 3] *= (1.f + __expf(-ld)) * fast_rcp(1.f + __expf(-ln)); } }
                asm volatile("" : "+v"(acc[ai][0][m][0]), "+v"(acc[ai][0][m][1]), "+v"(acc[ai][1][m][0]), "+v"(acc[ai][1][m][1]) :: "memory"); }
    }
    __device__ __forceinline__ void operator()(const pg8::f32x4 (&acc)[2][2][4][2], const pg8::Unit& u, int wr, int wc, int fr, int fq) const {
        const int row0 = u.pm * 256 + wr * 64 + fr, col0 = u.pn * 256 + wc * 32 + 8 * fq;
#pragma unroll
        for (int ai = 0; ai < 2; ++ai)
#pragma unroll
            for (int m = 0; m < 4; ++m) { const size_t r = (size_t)(row0 + ai * 128 + m * 16);
#pragma unroll
                for (int bj = 0; bj < 2; ++bj) { const v4u gc = *(const v4u*)(Pg + r * PW + C_GC + col0 + bj * 128); float o[8];
#pragma unroll
                    for (int e = 0; e < 8; ++e) { const unsigned w = gc[e >> 1]; const float lc = bf2f((e & 1) ? (w >> 16) : (w & 0xffffu)); o[e] = acc[ai][bj][m][e >> 2][e & 3] * sigmoidf_(lc); }
                    *(v4u*)(O + r * DMODEL + col0 + bj * 128) = (v4u){pk2(o[0], o[1]), pk2(o[2], o[3]), pk2(o[4], o[5]), pk2(o[6], o[7])}; }
                asm volatile("" ::: "memory"); }
    }
};
struct EpiSwiglu {
    static constexpr bool PERM = true, AFTER_DRAIN = false;
    bf16* O;
    __device__ __forceinline__ void operator()(const pg8::f32x4 (&acc)[2][2][4][2], const pg8::Unit& u, int wr, int wc, int fr, int fq) const {
        const int row0 = u.pm * 256 + wr * 64 + fr, col0 = u.pn * 128 + wc * 32 + 8 * fq;
#pragma unroll
        for (int ai = 0; ai < 2; ++ai)
#pragma unroll
            for (int m = 0; m < 4; ++m) { float o[8];
#pragma unroll
                for (int e = 0; e < 8; ++e) { const float g = acc[ai][0][m][e >> 2][e & 3], up = acc[ai][1][m][e >> 2][e & 3]; o[e] = g * sigmoidf_(g) * up; }
                *(v4u*)(O + (size_t)(row0 + ai * 128 + m * 16) * DMODEL + col0) = (v4u){pk2(o[0], o[1]), pk2(o[2], o[3]), pk2(o[4], o[5]), pk2(o[6], o[7])}; }
    }
};

__device__ __forceinline__ void ph_norm2(const Args& A_, Frame& F, int l, int ch) {
    PH_IDS
    const int gw = vcu * 8 + wid, NGW = F.G * 8;
    LAS f32x4* WR = (LAS f32x4*)F.lds;
    __syncthreads();
    for (int i = tid; i < 4096; i += 512) { const int k = i >> 2, q = i & 3; const int slot = ((k >> 2) & 63) + 64 * ((k & 3) + 4 * (k >> 8));
        WR[q * 1024 + slot] = *(const f32x4*)(A_.in[I_WR] + (size_t)l * DMODEL * NE + k * NE + q * 4); }
    __syncthreads();
    const float* ng1 = A_.in[I_NORMG] + (size_t)(l * 4 + 1) * DMODEL; const float* ng2 = A_.in[I_NORMG] + (size_t)(l * 4 + 2) * DMODEL;
    const bf16* O1 = (const bf16*)(F.ws + WS_O1); bf16* H = (bf16*)(F.ws + WS_H);
    float* affen = (float*)(F.ws + WS_AFFEN); float* affne = (float*)(F.ws + WS_AFFNE);
    for (int row = gw; row < MC; row += NGW) {
        const int bl = row / SB, s = row - bl * SB, b = ch * BC + bl;
        if (l != 0 && s < CTXL) continue;
        f32x4 o[4], x[4]; row_load_bf16(O1 + (size_t)row * DMODEL, lane, o); row_load(res_src(A_, F, l, b, s), lane, x);
        const float* mr = mod_row(A_, F, l, b, s);
        const float rs1 = row_rstd(o, lane);
#pragma unroll
        for (int j = 0; j < 4; ++j) { const f32x4 g = ((const f32x4*)ng1)[lane + 64 * j], g1 = ((const f32x4*)(mr + 2 * DMODEL))[lane + 64 * j]; x[j] = x[j] + g1 * ((o[j] * rs1) * g); }
        float* xd = res_dst(A_, F, b, s);
#pragma unroll
        for (int j = 0; j < 4; ++j) ((f32x4*)xd)[lane + 64 * j] = x[j];
        const float rs2 = row_rstd(x, lane);
#pragma unroll
        for (int j = 0; j < 4; ++j) { const f32x4 g = ((const f32x4*)ng2)[lane + 64 * j], sh = ((const f32x4*)(mr + 3 * DMODEL))[lane + 64 * j], sc = ((const f32x4*)(mr + 4 * DMODEL))[lane + 64 * j];
            x[j] = (x[j] * rs2) * g * (sc + 1.f) + sh; }
        row_store_bf16(H + (size_t)row * DMODEL, lane, x);
        float v[16];
#pragma unroll
        for (int e = 0; e < 16; ++e) v[e] = 0.f;
#pragma unroll
        for (int j = 0; j < 4; ++j)
#pragma unroll
            for (int i = 0; i < 4; ++i) { const float xv = x[j][i]; const int slot = lane + 64 * (i + 4 * j);
#pragma unroll
                for (int q = 0; q < 4; ++q) { const f32x4 w = WR[q * 1024 + slot]; v[4 * q] += xv * w.x; v[4 * q + 1] += xv * w.y; v[4 * q + 2] += xv * w.z; v[4 * q + 3] += xv * w.w; } }
#pragma unroll
        for (int e = 0; e < 8; ++e) { const bool up = (lane & 32) != 0; const float snd = up ? v[e] : v[e + 8], kp = up ? v[e + 8] : v[e]; v[e] = kp + shx(snd, 32, lane); }
#pragma unroll
        for (int e = 0; e < 4; ++e) { const bool up = (lane & 16) != 0; const float snd = up ? v[e] : v[e + 4], kp = up ? v[e + 4] : v[e]; v[e] = kp + shx(snd, 16, lane); }
#pragma unroll
        for (int e = 0; e < 2; ++e) { const bool up = (lane & 8) != 0; const float snd = up ? v[e] : v[e + 2], kp = up ? v[e + 2] : v[e]; v[e] = kp + shx(snd, 8, lane); }
        { const bool up = (lane & 4) != 0; const float snd = up ? v[0] : v[1], kp = up ? v[1] : v[0]; v[0] = kp + shx(snd, 4, lane); }
        float lg = v[0]; lg += shx(lg, 2, lane); lg += shx(lg, 1, lane);
        const int e = ((lane >> 5) & 1) * 8 + ((lane >> 4) & 1) * 4 + ((lane >> 3) & 1) * 2 + ((lane >> 2) & 1);
        float mx = lg;
#pragma unroll
        for (int o2 = 4; o2 < 64; o2 <<= 1) mx = fmaxf(mx, shx(mx, o2, lane));
        const float ex = __expf(lg - mx); float sm = ex;
#pragma unroll
        for (int o2 = 4; o2 < 64; o2 <<= 1) sm += shx(sm, o2, lane);
        const float aff = ex / sm;
        if ((lane & 3) == 0) { affen[(size_t)(bl * NE + e) * SB + s] = aff; affne[(size_t)row * NE + e] = aff; }
    }
}

__device__ __forceinline__ void ph_topk(const Args& A_, Frame& F, int l) {
    PH_IDS
    LAS unsigned long long* KEY = (LAS unsigned long long*)F.lds;
    LAS int* TOK = (LAS int*)(F.lds + 16384);
    const float* affen = (const float*)(F.ws + WS_AFFEN); int* slot_of = (int*)(F.ws + WS_SLOT);
    const bf16* H = (const bf16*)(F.ws + WS_H); bf16* HS = (bf16*)(F.ws + WS_HS);
    const int nitems = (l == 0) ? 2 * BC * NE : BC * NE;
    for (int item = blockIdx.x; item < nitems; item += F.G) {
        const int set = item / (BC * NE), ie = item % (BC * NE), bl = ie / NE, e = ie % NE;
        const int n = set ? CTXL : SEQ, cap = n / 8, seg0 = set ? 0 : CTXL;
        __syncthreads();
        for (int i = tid; i < n; i += 512) KEY[i] = ((unsigned long long)__float_as_uint(affen[(size_t)(bl * NE + e) * SB + seg0 + i]) << 32) | (unsigned long long)(0xFFFFFFFFu - (unsigned)i);
        __syncthreads();
        for (int k = 2; k <= n; k <<= 1)
            for (int j = k >> 1; j > 0; j >>= 1) {
                for (int t = tid; t < (n >> 1); t += 512) { const int i = ((t & ~(j - 1)) << 1) | (t & (j - 1)), p = i | j; const unsigned long long a = KEY[i], b = KEY[p];
                    const bool sw = ((i & k) == 0) ? (a < b) : (a > b); if (sw) { KEY[i] = b; KEY[p] = a; } }
                __syncthreads();
            }
        const int dst0 = set ? (NE * BC) * 256 + (e * BC + bl) * 32 : (e * BC + bl) * 256;
        for (int p = tid; p < n; p += 512) { const int idx = (int)(0xFFFFFFFFu - (unsigned)KEY[p]); const int row = bl * SB + seg0 + idx;
            slot_of[(size_t)row * NE + e] = (p < cap) ? dst0 + p : -1; if (p < cap) TOK[p] = row; }
        __syncthreads();
        for (int p = wid; p < cap; p += 8) { const v4u* src = (const v4u*)(H + (size_t)TOK[p] * DMODEL); v4u* dst = (v4u*)(HS + (size_t)(dst0 + p) * DMODEL);
            dst[lane] = src[lane]; dst[lane + 64] = src[lane + 64]; }
    }
}

__device__ __forceinline__ void ph_combine(const Args& A_, Frame& F, int l, int ch) {
    PH_IDS
    const int gw = vcu * 8 + wid, NGW = F.G * 8;
    const float* ng3 = A_.in[I_NORMG] + (size_t)(l * 4 + 3) * DMODEL;
    const bf16* Y = (const bf16*)(F.ws + WS_HS); const float* affne = (const float*)(F.ws + WS_AFFNE); const int* slot_of = (const int*)(F.ws + WS_SLOT);
    for (int row = gw; row < MC; row += NGW) {
        const int bl = row / SB, s = row - bl * SB, b = ch * BC + bl;
        if (l != 0 && s < CTXL) continue;
        const int sl = slot_of[(size_t)row * NE + (lane & 15)]; const float af = affne[(size_t)row * NE + (lane & 15)];
        f32x4 acc[4];
#pragma unroll
        for (int j = 0; j < 4; ++j) acc[j] = (f32x4){0.f, 0.f, 0.f, 0.f};
#pragma unroll
        for (int e = 0; e < NE; ++e) { const int se = __builtin_amdgcn_readlane(sl, e); const float ae = __builtin_bit_cast(float, __builtin_amdgcn_readlane(__builtin_bit_cast(int, af), e));
            if (se >= 0) { f32x4 y[4]; row_load_bf16(Y + (size_t)se * DMODEL, lane, y);
#pragma unroll
                for (int j = 0; j < 4; ++j) acc[j] = acc[j] + y[j] * ae; } }
        float* xd = res_dst(A_, F, b, s);
        f32x4 x[4]; row_load(xd, lane, x);
        const float rs = row_rstd(acc, lane); const float* mr = mod_row(A_, F, l, b, s);
#pragma unroll
        for (int j = 0; j < 4; ++j) { const f32x4 g = ((const f32x4*)ng3)[lane + 64 * j], g2 = ((const f32x4*)(mr + 5 * DMODEL))[lane + 64 * j]; ((f32x4*)xd)[lane + 64 * j] = x[j] + g2 * ((acc[j] * rs) * g); }
    }
}
constexpr int NPH = 12, NPHASES = 1 + DEPTH * NCHUNK * NPH;
__global__ void __launch_bounds__(512, 2) mk_fwd(Args A_) {
    extern __shared__ __attribute__((aligned(16))) unsigned char lds[];
    Frame F0;
    F0.lds = (LAS unsigned char*)lds;
    F0.G = gridDim.x; { const int bx = blockIdx.x; F0.vcu = (F0.G % 8 == 0) ? (bx % 8) * (F0.G / 8) + bx / 8 : bx; }
    F0.out = A_.out; F0.ws = A_.ws;
    volatile LAS unsigned* MISC = (volatile LAS unsigned*)(F0.lds + MISC_OFF);
    for (int u = threadIdx.x; u < (LDS_BYTES - LDSCTL_OFF) / 4; u += 512) ((LAS unsigned*)(F0.lds + LDSCTL_OFF))[u] = 0u;
    __syncthreads();
    const int lo = A_.ph_lo, hi = A_.ph_hi;
    const bool fused = (hi - lo) > 1;
    XcdBarrier bar; bar.bar = (unsigned*)(F0.ws + WS_CTL) + CW_BAR; bar.x = 0; bar.st = nullptr;
    if (fused) bar = xcd_barrier_post((unsigned*)(F0.ws + WS_CTL) + CW_BAR, MISC + 8);
#ifndef MK_PHMASK
#define MK_PHMASK 0x1fff
#endif
#define PHON(j) (((MK_PHMASK) >> (j)) & 1)
#define IN(k) (lo <= (k) && (k) < hi)
#define SEAM(k) do { if (IN(k) && IN((k) + 1)) xcd_barrier(bar); } while (0)

    if (PHON(12) && IN(0)) { ph_prologue(A_, F0); SEAM(0); }

    for (int l = 0; l < DEPTH; ++l)
        for (int ch = 0; ch < NCHUNK; ++ch) {
            const int p0 = 1 + (l * NCHUNK + ch) * NPH;
            Frame F = F0; asm volatile("" : "+s"(F.vcu), "+s"(F.G), "+s"(F.ws), "+s"(F.out));
            unsigned char* wl = F.ws + WS_W + (size_t)l * LW;
            if (PHON(0) && IN(p0 + 0)) { ph_norm1(A_, F, l, ch); SEAM(p0 + 0); }
            if (PHON(1) && IN(p0 + 1)) {
                pg8::Gemm g{1024, 1024, 1024}; SchedPlain S; S.T.init(MC / 256, PW / 256, F.G, (int)blockIdx.x);
                S.A = (const char*)(F.ws + WS_H); S.B = (const char*)(wl + W_P); S.astep = (size_t)256 * 1024 * 2; S.bstep = (size_t)256 * 1024 * 2; S.skipctx = false;
                pg8::EpiBf16<0> E{(pg8::bf16_t*)(F.ws + WS_P), PW, nullptr, 0, 0, 1.f};
                pg8::gemm_phase<pg8::EpiBf16<0>, SchedPlain, true, true>(F.lds, g, S, E);
                SEAM(p0 + 1);
            }
            if (PHON(2) && IN(p0 + 2)) { ph_prep(A_, F, l); SEAM(p0 + 2); }
            if (PHON(3) && IN(p0 + 3)) { ph_lru(A_, F, l); SEAM(p0 + 3); }
            if (PHON(4) && IN(p0 + 4)) { ph_attn(A_, F, l, (char*)lds); SEAM(p0 + 4); }
            if (PHON(5) && IN(p0 + 5)) {
                pg8::Gemm g{PW, 2048, 2048}; SchedPlain S; S.skipctx = (l != 0); S.T.init(S.skipctx ? BC * 8 : MC / 256, 4, F.G, (int)blockIdx.x);
                S.A = (const char*)(F.ws + WS_P) + (size_t)C_LG * 2; S.B = (const char*)(wl + W_O); S.astep = (size_t)256 * PW * 2; S.bstep = (size_t)256 * 2048 * 2;
                EpiMerge E{(const bf16*)(F.ws + WS_P), (bf16*)(F.ws + WS_H)};
                pg8::gemm_phase<EpiMerge, SchedPlain, true, true, true>(F.lds, g, S, E);
                SEAM(p0 + 5);
            }
            if (PHON(6) && IN(p0 + 6)) {
                pg8::Gemm g{1024, 1024, 1024}; SchedPlain S; S.skipctx = (l != 0); S.T.init(S.skipctx ? BC * 8 : MC / 256, 4, F.G, (int)blockIdx.x);
                S.A = (const char*)(F.ws + WS_H); S.B = (const char*)(wl + W_OUT); S.astep = (size_t)256 * 1024 * 2; S.bstep = (size_t)256 * 1024 * 2;
                pg8::EpiBf16<0> E{(pg8::bf16_t*)(F.ws + WS_O1), 1024, nullptr, 0, 0, 1.f};
                pg8::gemm_phase<pg8::EpiBf16<0>, SchedPlain, true, true>(F.lds, g, S, E);
                SEAM(p0 + 6);
            }
            if (PHON(7) && IN(p0 + 7)) { ph_norm2(A_, F, l, ch); SEAM(p0 + 7); }
            if (PHON(8) && IN(p0 + 8)) { ph_topk(A_, F, l); SEAM(p0 + 8); }
            if (PHON(9) && IN(p0 + 9)) {
                pg8::Gemm g{1024, 1024, 1024}; SchedMoe S; S.T.init(l == 0 ? NE * BC + NE * BC / 8 : NE * BC, 8, F.G, (int)blockIdx.x);
                S.A = (const char*)(F.ws + WS_HS); S.B = (const char*)(wl + W_GU); S.astep = (size_t)256 * 1024 * 2; S.bstep = (size_t)256 * 1024 * 2; S.estep = (size_t)2048 * 1024 * 2;
                EpiSwiglu E{(bf16*)(F.ws + WS_ACT)};
                pg8::gemm_phase<EpiSwiglu, SchedMoe, true, true>(F.lds, g, S, E);
                SEAM(p0 + 9);
            }
            if (PHON(10) && IN(p0 + 10)) {
                pg8::Gemm g{1024, 1024, 1024}; SchedMoe S; S.T.init(l == 0 ? NE * BC + NE * BC / 8 : NE * BC, 4, F.G, (int)blockIdx.x);
                S.A = (const char*)(F.ws + WS_ACT); S.B = (const char*)(wl + W_D); S.astep = (size_t)256 * 1024 * 2; S.bstep = (size_t)256 * 1024 * 2; S.estep = (size_t)1024 * 1024 * 2;
                pg8::EpiBf16<0> E{(pg8::bf16_t*)(F.ws + WS_HS), 1024, nullptr, 0, 0, 1.f};
                pg8::gemm_phase<pg8::EpiBf16<0>, SchedMoe, true, true>(F.lds, g, S, E);
                SEAM(p0 + 10);
            }
            if (PHON(11) && IN(p0 + 11)) { ph_combine(A_, F, l, ch); SEAM(p0 + 11); }
        }
#undef IN
#undef SEAM
}

#ifndef MK_N_LAUNCHES
#define MK_N_LAUNCHES 0
#endif
extern "C" void kernel_launch(void* const* d_in, const int* in_sizes, int n_in, void* d_out, int out_size, void* d_ws, size_t ws_size, hipStream_t stream) {
    static int grid = 0;
    if (grid == 0) {
        if (n_in != N_IN || in_sizes[0] != NB * SEQ * DMODEL || out_size != NB * SEQ * DMODEL || ws_size < WS_END) { fprintf(stderr, "kernel_launch: unexpected shapes / workspace (%d inputs, ws %zu, need %zu)\n", n_in, ws_size, (size_t)WS_END); grid = -1; return; }
        int dev = 0, cus = 0, per_cu = 0;
        if (hipGetDevice(&dev) != hipSuccess || hipDeviceGetAttribute(&cus, hipDeviceAttributeMultiprocessorCount, dev) != hipSuccess) { grid = -1; return; }
        if (hipFuncSetAttribute((const void*)mk_fwd, hipFuncAttributeMaxDynamicSharedMemorySize, LDS_BYTES) != hipSuccess) { fprintf(stderr, "kernel_launch: hipFuncSetAttribute failed\n"); grid = -1; return; }
        if (hipOccupancyMaxActiveBlocksPerMultiprocessor(&per_cu, (const void*)mk_fwd, 512, LDS_BYTES) != hipSuccess || per_cu < 1) { fprintf(stderr, "kernel_launch: occupancy query says %d blocks per CU\n", per_cu); (void)hipGetLastError(); grid = -1; return; }
        grid = cus;
        if (grid != 256) fprintf(stderr, "kernel_launch: %d CUs (built and tuned for 256)\n", grid);
    }
    if (grid < 0) return;
    if (hipMemsetAsync((char*)d_ws + WS_CTL, 0, CTL_ZERO_BYTES, stream) != hipSuccess) return;
    Args a{};
    for (int i = 0; i < N_IN; ++i) a.in[i] = (const float*)d_in[i];
    a.out = (float*)d_out; a.ws = (unsigned char*)d_ws;
#if MK_N_LAUNCHES == 1
    a.ph_lo = 0; a.ph_hi = NPHASES;
    hipLaunchKernelGGL(mk_fwd, dim3(grid), dim3(512), LDS_BYTES, stream, a);
#else
    for (int p = 0; p < NPHASES; ++p) { a.ph_lo = p; a.ph_hi = p + 1; hipLaunchKernelGGL(mk_fwd, dim3(grid), dim3(512), LDS_BYTES, stream, a); }
#endif
}
```

```cpp
#include <hip/hip_runtime.h>
#include <cstdio>
#include <cstdint>
namespace pg8 {
#define PG8_LAS __attribute__((address_space(3)))
typedef unsigned short bf16_t;
typedef short bf16x8 __attribute__((ext_vector_type(8)));
typedef float f32x4 __attribute__((ext_vector_type(4)));
typedef unsigned u32x4 __attribute__((ext_vector_type(4)));
constexpr int BM = 256, BK = 64, HALF = 128, HTB = HALF * BK * 2  , STAGE_BYTES = 8 * HTB, NXCD = 8, WGM = 8;

__host__ __device__ __forceinline__ int lds_byte(int r, int c) { const int st = (r >> 4) * 2 + (c >> 5), rr = r & 15, cc = c & 31, ob = rr * 64 + cc * 2; return st * 1024 + (ob ^ (((ob >> 9) & 1) << 5)); }
__host__ __device__ __forceinline__ void stage_rc(int b, int& R, int& C) { const int st = b / 1024, sb = b % 1024, swz = sb ^ (((sb >> 9) & 1) << 5); R = (st >> 1) * 16 + swz / 64; C = (st & 1) * 32 + (swz % 64) / 2; }
__host__ __device__ __forceinline__ int perm32(int rho) { const int n = rho >> 4, i = rho & 15; return 8 * (i >> 2) + 4 * n + (i & 3); }

struct Unit { int pm, pn; const char* A; const char* B; const int* gidx; };
struct Gemm { int lda, ldb, K; int sca = 0x7f7f7f7f, scw = 0x79797979; };

__device__ __forceinline__ unsigned cvt_pk_bf16(float lo, float hi) { unsigned r; asm volatile("v_cvt_pk_bf16_f32 %0, %1, %2" : "=v"(r) : "v"(lo), "v"(hi)); return r; }
typedef float f32x2 __attribute__((ext_vector_type(2)));
__device__ __forceinline__ f32x2 gelu_pk(f32x2 v) {
    const f32x2 av = __builtin_elementwise_abs(v), d = av * 0.2316418882f + 1.0f;
    f32x2 t; t.x = __builtin_amdgcn_rcpf(d.x); t.y = __builtin_amdgcn_rcpf(d.y);
    f32x2 q = t * 0.5307027145f + (-0.7265760135f); q = q * t + 0.7107068705f; q = q * t + (-0.142248368f); q = q * t + 0.127414796f; q = q * t;
    const f32x2 s = (v * v) * (-0.72134752044f);
    f32x2 e; e.x = __builtin_amdgcn_exp2f(s.x); e.y = __builtin_amdgcn_exp2f(s.y);
    const f32x2 m = v * (q * e), r = v - m;
    f32x2 o; o.x = v.x < 0.f ? m.x : r.x; o.y = v.y < 0.f ? m.y : r.y; return o;
}

template <int ACT  > struct EpiBf16 {
    static constexpr bool PERM = true, AFTER_DRAIN = false; static_assert(ACT == 0 || ACT == 1, "EpiBf16: ACT is 0 (none) or 1 (gelu_pk)");
    bf16_t* O; int ldc; const float* bias; int split_cols; size_t split_stride; float scale0;
    __device__ __forceinline__ void operator()(const f32x4 (&acc)[2][2][4][2], const Unit& u, int wr, int wc, int fr, int fq) const {
        int row0 = u.pm * BM + wr * 64 + fr; asm volatile("" : "+v"(row0));
        int colt = u.pn * BM; bf16_t* base = O;
        float sc = 1.f; if (split_cols) { const int t = colt / split_cols; base += (size_t)t * split_stride; colt -= t * split_cols; if (t == 0) sc = scale0; }
        const int col0 = colt + wc * 32 + 8 * fq, bcol0 = u.pn * BM + wc * 32 + 8 * fq;
        f32x4 bv[2][2];
#pragma unroll
        for (int bj = 0; bj < 2; ++bj)
#pragma unroll
            for (int n = 0; n < 2; ++n) bv[bj][n] = bias ? *(const f32x4*)(bias + bcol0 + bj * HALF + 4 * n) : (f32x4){0.f, 0.f, 0.f, 0.f};
#pragma unroll
        for (int ai = 0; ai < 2; ++ai)
#pragma unroll
            for (int m = 0; m < 4; ++m) { bf16_t* rowp = base + (size_t)(row0 + ai * HALF + m * 16) * ldc + col0;
#pragma unroll
                for (int bj = 0; bj < 2; ++bj) { f32x4 v0 = acc[ai][bj][m][0] + bv[bj][0], v1 = acc[ai][bj][m][1] + bv[bj][1];
                    if (ACT == 1) { f32x2 a = gelu_pk((f32x2){v0[0], v0[1]}), b = gelu_pk((f32x2){v0[2], v0[3]}), c = gelu_pk((f32x2){v1[0], v1[1]}), d = gelu_pk((f32x2){v1[2], v1[3]});
                        v0 = (f32x4){a.x, a.y, b.x, b.y}; v1 = (f32x4){c.x, c.y, d.x, d.y}; }
                    v0 = v0 * sc; v1 = v1 * sc; u32x4 w; w.x = cvt_pk_bf16(v0[0], v0[1]); w.y = cvt_pk_bf16(v0[2], v0[3]); w.z = cvt_pk_bf16(v1[0], v1[1]); w.w = cvt_pk_bf16(v1[2], v1[3]);
                    *(u32x4*)(rowp + bj * HALF) = w; } }
    }
};

typedef int v8i32 __attribute__((ext_vector_type(8))); typedef int v4i32 __attribute__((ext_vector_type(4)));
__device__ __forceinline__ v8i32 cat8(bf16x8 lo, bf16x8 hi) { return __builtin_shufflevector(__builtin_bit_cast(v4i32, lo), __builtin_bit_cast(v4i32, hi), 0, 1, 2, 3, 4, 5, 6, 7); }
template <class Epi, class Sched, bool ALIGN_EPI = false, bool SP2 = false, bool KHOOK = false, bool FP8 = false, bool GATHER = false>
__device__ __forceinline__ void gemm_phase(PG8_LAS unsigned char* lds, const Gemm g, const Sched& S, const Epi& E) {
    int tid_ = threadIdx.x; asm volatile("" : "+v"(tid_));
    const int tid = tid_, wid = __builtin_amdgcn_readfirstlane(tid >> 6), lane = tid & 63, wr = wid >> 2, wc = wid & 3, fr = lane & 15, fq = lane >> 4;
    const int K = g.K, nt = K / BK;
    unsigned voffA[2], voffB[2];
#pragma unroll
    for (int i = 0; i < 2; ++i) { int R, C; stage_rc(tid * 16 + i * 8192, R, C); const int Rb = Epi::PERM ? ((R & ~31) + perm32(R & 31)) : R;
        voffA[i] = (unsigned)(R * g.lda + C) * 2u; voffB[i] = (unsigned)(Rb * g.ldb + C) * 2u; }
    static_assert(!GATHER || SP2, "GATHER is written for the SP2 loop");
    unsigned vg[2][2], nvg[2][2];
#define PG8_GLOAD(dst, U) do { _Pragma("unroll") for (int h_ = 0; h_ < 2; ++h_) _Pragma("unroll") for (int i_ = 0; i_ < 2; ++i_) { int R_, C_; stage_rc(tid * 16 + i_ * 8192, R_, C_); \
        dst[h_][i_] = (unsigned)(U).gidx[h_ * HALF + R_] * (unsigned)(g.lda * 2) + (unsigned)(C_ * 2); } } while (0)
#define PG8_STAGEA(bufoff, kbase, half, nx) do { if constexpr (GATHER) { const bool un_ = (nx); unsigned vs_[2] = {un_ ? nvg[half][0] : vg[half][0], un_ ? nvg[half][1] : vg[half][1]}; PG8_STAGE(bufoff, kbase, vs_); } \
        else { PG8_STAGE(bufoff, (kbase) + ((half) ? hstepA : (size_t)0), voffA); } } while (0)
    const size_t kstep = (size_t)(BK * 2);
    const size_t hstepA = (size_t)HALF * g.lda * 2, hstepB = (size_t)HALF * g.ldb * 2;
    const unsigned ldsw = (unsigned)wid * 1024u;
    const int aoff = lds_byte(wr * 64 + fr, fq * 8), boff = lds_byte(wc * 32 + fr, fq * 8);
#define PG8_SA(b, h) (((b) * 2 + (h)) * HTB)
#define PG8_SB(b, h) ((4 + (b) * 2 + (h)) * HTB)
#define PG8_STAGE(bufoff, gbase, voff) do { _Pragma("unroll") for (int _i = 0; _i < 2; ++_i) \
        __builtin_amdgcn_global_load_lds((const unsigned*)((const char*)(gbase) + (voff)[_i]), (PG8_LAS unsigned*)(lds + (bufoff) + ldsw + _i * 8192), 16, 0, 0); } while (0)
#define PG8_LDA(dst, b, h) do { _Pragma("unroll") for (int m = 0; m < 4; ++m) dst[m] = cat8(*(const PG8_LAS bf16x8*)(lds + PG8_SA(b, h) + aoff + m * 2048), *(const PG8_LAS bf16x8*)(lds + PG8_SA(b, h) + aoff + m * 2048 + 1024)); } while (0)
#define PG8_LDB(dst, b, h) do { _Pragma("unroll") for (int n = 0; n < 2; ++n) dst[n] = cat8(*(const PG8_LAS bf16x8*)(lds + PG8_SB(b, h) + boff + n * 2048), *(const PG8_LAS bf16x8*)(lds + PG8_SB(b, h) + boff + n * 2048 + 1024)); } while (0)
#define PG8_LO(x) __builtin_bit_cast(bf16x8, __builtin_shufflevector((x), (x), 0, 1, 2, 3))
#define PG8_HI(x) __builtin_bit_cast(bf16x8, __builtin_shufflevector((x), (x), 4, 5, 6, 7))
#define PG8_MMA(ai, bj, At, Bt) do { __builtin_amdgcn_s_setprio(1); _Pragma("unroll") for (int m = 0; m < 4; ++m) _Pragma("unroll") for (int n = 0; n < 2; ++n) { \
        if constexpr (FP8) asm volatile("v_mfma_scale_f32_16x16x128_f8f6f4 %0, %1, %2, %0, %3, %4 op_sel_hi:[0,0,0]" : "+v"(acc[ai][bj][m][n]) : "v"(Bt[n]), "v"(At[m]), "v"(fp8_scw), "v"(fp8_sca));   \
        else { acc[ai][bj][m][n] = __builtin_amdgcn_mfma_f32_16x16x32_bf16(PG8_LO(Bt[n]), PG8_LO(At[m]), acc[ai][bj][m][n], 0, 0, 0); \
               acc[ai][bj][m][n] = __builtin_amdgcn_mfma_f32_16x16x32_bf16(PG8_HI(Bt[n]), PG8_HI(At[m]), acc[ai][bj][m][n], 0, 0, 0); } } __builtin_amdgcn_s_setprio(0); } while (0)
#define PG8_WAIT_V(n) asm volatile("s_waitcnt vmcnt(" #n ")" ::: "memory")
#define PG8_WAIT_L(n) asm volatile("s_waitcnt lgkmcnt(" #n ")" ::: "memory")
#define PG8_BAR __builtin_amdgcn_s_barrier()
#define PG8_SCHED __builtin_amdgcn_sched_barrier(0)
    const int fp8_scw = g.scw, fp8_sca = g.sca;
    unsigned long long gsec_acc = 0;
    Unit cur, nxt; int ui = 0;
    if (!S.next(0, cur)) return;
    f32x4 acc[2][2][4][2];
#pragma unroll
    for (int a = 0; a < 2; ++a)
#pragma unroll
        for (int b = 0; b < 2; ++b)
#pragma unroll
            for (int m = 0; m < 4; ++m)
#pragma unroll
                for (int n = 0; n < 2; ++n) acc[a][b][m][n] = (f32x4){0.f, 0.f, 0.f, 0.f};
    v8i32 At[4], B0[2], B1[2];
    const char* cA = cur.A; const char* cB = cur.B;
    S.a_ready(cur);
    if constexpr (GATHER) PG8_GLOAD(vg, cur);
    if constexpr (SP2) {
        PG8_STAGE(PG8_SB(0, 0), cB, voffB); PG8_STAGE(PG8_SB(0, 1), cB + hstepB, voffB); PG8_STAGEA(PG8_SA(0, 0), cA, 0, false); PG8_STAGEA(PG8_SA(0, 1), cA, 1, false);
        if (wr == 1) PG8_BAR;
        PG8_WAIT_V(2); PG8_BAR;
        PG8_STAGE(PG8_SB(1, 0), cB + kstep, voffB); PG8_STAGEA(PG8_SA(1, 0), cA + kstep, 0, false); PG8_STAGE(PG8_SB(1, 1), cB + hstepB + kstep, voffB);
        PG8_WAIT_V(6); PG8_BAR;
    } else {
        PG8_STAGE(PG8_SB(0, 0), cB, voffB); PG8_STAGE(PG8_SA(0, 0), cA, voffA); PG8_STAGE(PG8_SB(0, 1), cB + hstepB, voffB); PG8_STAGE(PG8_SA(0, 1), cA + hstepA, voffA);
        if (wr == 1) PG8_BAR;
        PG8_WAIT_V(4); PG8_BAR;
        PG8_STAGE(PG8_SB(1, 0), cB + kstep, voffB); PG8_STAGE(PG8_SA(1, 0), cA + kstep, voffA); PG8_STAGE(PG8_SB(1, 1), cB + hstepB + kstep, voffB);
        PG8_WAIT_V(6); PG8_BAR;
    }
    for (;;) {
        const bool has_next = S.next(ui + 1, nxt);
        const char* nA = has_next ? nxt.A : cA; const char* nB = has_next ? nxt.B : cB;
        if constexpr (GATHER) { if (has_next) PG8_GLOAD(nvg, nxt); }
#pragma unroll 1
        for (int t = 0; t < nt; t += 2) {
            const bool last = (t == nt - 2);
            if constexpr (KHOOK) { if (t == Epi::HOOK_T0 || t == Epi::HOOK_T1) { if constexpr (ALIGN_EPI) { if (wr == 0) PG8_BAR; }
                if constexpr (FP8) asm volatile("s_nop 15\n\ts_nop 15" ::: "memory"); E.khook(acc, cur, t, wr, wc, fr, fq); if constexpr (ALIGN_EPI) { if (wr == 1) PG8_BAR; } } }
            const char* a1 = cA + (size_t)(t + 1) * kstep;
            const char* a2 = last ? nA : cA + (size_t)(t + 2) * kstep; const char* b2 = last ? nB : cB + (size_t)(t + 2) * kstep;
            const char* a3 = a2 + kstep; const char* b3 = b2 + kstep;
            if (last && has_next) S.a_ready(nxt);
            if constexpr (SP2) {
            PG8_LDB(B0, 0, 0); PG8_LDB(B1, 0, 1); PG8_SCHED; PG8_LDA(At, 0, 0); PG8_STAGEA(PG8_SA(1, 1), a1, 1, false);
            PG8_WAIT_V(8); PG8_WAIT_L(0); PG8_BAR; PG8_MMA(0, 0, At, B0); PG8_MMA(0, 1, At, B1); PG8_BAR; PG8_SCHED;
            PG8_LDA(At, 0, 1); PG8_STAGE(PG8_SB(0, 0), b2, voffB); PG8_STAGE(PG8_SB(0, 1), b2 + hstepB, voffB); PG8_STAGEA(PG8_SA(0, 0), a2, 0, last && has_next);
            PG8_WAIT_V(8); PG8_WAIT_L(0); PG8_BAR; PG8_MMA(1, 0, At, B0); PG8_MMA(1, 1, At, B1); PG8_BAR; PG8_SCHED;
            PG8_LDB(B0, 1, 0); PG8_LDB(B1, 1, 1); PG8_SCHED; PG8_LDA(At, 1, 0); PG8_STAGEA(PG8_SA(0, 1), a2, 1, last && has_next);
            PG8_WAIT_V(8); PG8_WAIT_L(0); PG8_BAR; PG8_MMA(0, 0, At, B0); PG8_MMA(0, 1, At, B1); PG8_BAR; PG8_SCHED;
            PG8_LDA(At, 1, 1); PG8_STAGE(PG8_SB(1, 0), b3, voffB); PG8_STAGE(PG8_SB(1, 1), b3 + hstepB, voffB); PG8_STAGEA(PG8_SA(1, 0), a3, 0, last && has_next);
            PG8_WAIT_V(8); PG8_WAIT_L(0); PG8_BAR; PG8_MMA(1, 0, At, B0); PG8_MMA(1, 1, At, B1); PG8_BAR; PG8_SCHED;
            } else {
            PG8_LDB(B0, 0, 0); PG8_SCHED; PG8_LDA(At, 0, 0); PG8_STAGE(PG8_SA(1, 1), a1 + hstepA, voffA);
            PG8_WAIT_L(8); PG8_BAR; PG8_WAIT_L(0); PG8_MMA(0, 0, At, B0); PG8_BAR; PG8_SCHED;
            PG8_LDB(B1, 0, 1); PG8_STAGE(PG8_SB(0, 0), b2, voffB);
            PG8_BAR; PG8_WAIT_L(0); PG8_MMA(0, 1, At, B1); PG8_BAR;
            PG8_LDA(At, 0, 1); PG8_STAGE(PG8_SA(0, 0), a2, voffA);
            PG8_BAR; PG8_WAIT_L(0); PG8_MMA(1, 0, At, B0); PG8_BAR; PG8_SCHED;
            PG8_STAGE(PG8_SB(0, 1), b2 + hstepB, voffB);
            PG8_WAIT_V(6); PG8_BAR; PG8_MMA(1, 1, At, B1); PG8_BAR;
            PG8_LDB(B0, 1, 0); PG8_SCHED; PG8_LDA(At, 1, 0); PG8_STAGE(PG8_SA(0, 1), a2 + hstepA, voffA);
            PG8_WAIT_L(8); PG8_BAR; PG8_WAIT_L(0); PG8_MMA(0, 0, At, B0); PG8_BAR; PG8_SCHED;
            PG8_LDB(B1, 1, 1); PG8_STAGE(PG8_SB(1, 0), b3, voffB);
            PG8_BAR; PG8_WAIT_L(0); PG8_MMA(0, 1, At, B1); PG8_BAR;
            PG8_LDA(At, 1, 1); PG8_STAGE(PG8_SA(1, 0), a3, voffA);
            PG8_BAR; PG8_WAIT_L(0); PG8_MMA(1, 0, At, B0); PG8_BAR; PG8_SCHED;
            PG8_STAGE(PG8_SB(1, 1), b3 + hstepB, voffB);
            PG8_WAIT_V(6); PG8_BAR; PG8_MMA(1, 1, At, B1); PG8_BAR;
            }
        }
        if constexpr (FP8) asm volatile("s_nop 15\n\ts_nop 15" ::: "memory");
        if constexpr (ALIGN_EPI) { if (wr == 0) PG8_BAR; }
#ifndef MK_GEMM_SEC
#define MK_GEMM_SEC 0
#endif
        unsigned long long gsec_t0 = 0; if (MK_GEMM_SEC == 1) gsec_t0 = __builtin_amdgcn_s_memrealtime();
        if constexpr (!Epi::AFTER_DRAIN) { E(acc, cur, wr, wc, fr, fq); S.done(cur); }
        if (MK_GEMM_SEC == 1) gsec_acc += __builtin_amdgcn_s_memrealtime() - gsec_t0;
        if (!has_next) break;
#pragma unroll
        for (int a = 0; a < 2; ++a)
#pragma unroll
            for (int b = 0; b < 2; ++b)
#pragma unroll
                for (int m = 0; m < 4; ++m)
#pragma unroll
                    for (int n = 0; n < 2; ++n) acc[a][b][m][n] = (f32x4){0.f, 0.f, 0.f, 0.f};
        cur = nxt; cA = nA; cB = nB; ++ui;
        if constexpr (GATHER) { vg[0][0] = nvg[0][0]; vg[0][1] = nvg[0][1]; vg[1][0] = nvg[1][0]; vg[1][1] = nvg[1][1]; }
        if constexpr (ALIGN_EPI) { if (wr == 1) PG8_BAR; }
    }
    PG8_WAIT_V(0);
    if constexpr (!ALIGN_EPI) { if (wr == 0) PG8_BAR; }
    PG8_BAR;
    if constexpr (Epi::AFTER_DRAIN) { E.fused(acc, cur, wr, wc, fr, fq, lds, wid, lane); S.done(cur); }
    if (MK_GEMM_SEC != 0) { const unsigned long long te_ = __builtin_amdgcn_s_memrealtime() + 3ull * gsec_acc; while (__builtin_amdgcn_s_memrealtime() < te_) __builtin_amdgcn_s_sleep(8); }
#undef PG8_SA
#undef PG8_SB
#undef PG8_STAGE
#undef PG8_STAGEA
#undef PG8_GLOAD
#undef PG8_LDA
#undef PG8_LDB
#undef PG8_MMA
#undef PG8_LO
#undef PG8_HI
#undef PG8_WAIT_V
#undef PG8_WAIT_L
#undef PG8_BAR
#undef PG8_SCHED
}
}
#include <hip/hip_bf16.h>
#include <cmath>
namespace attn_body {
using bf16=__hip_bfloat16;
using bf16x8=__attribute__((ext_vector_type(8)))short;
using s16x4=__attribute__((ext_vector_type(4)))short;
using f32x16=__attribute__((ext_vector_type(16)))float;
using u32x4=__attribute__((ext_vector_type(4)))unsigned;
constexpr int D=64,DM=4352;
constexpr int NW=8,QBLK=32,QB=QBLK*NW,KVBLK=64;
constexpr int ATTN_PITCH=DM, ATTN_UNIT_ROWS=QB;
constexpr int ATTN_OPITCH=2048; constexpr float ATTN_OSCALE=32.f;
__device__ __forceinline__ int crow(int r,int hi){return (r&3)+8*(r>>2)+4*hi;}
#define SBAR() __builtin_amdgcn_sched_barrier(0)
constexpr int NSLOT=3, SLOTB=8192;
constexpr int LDS_K=0, LDS_V=NSLOT*SLOTB, LDS_WS=2*NSLOT*SLOTB, LDS_OST=LDS_WS+NW*64*4, LDS_BYTES=LDS_OST+NW*4096, LDS_NATAB=LDS_BYTES, NATAB_BYTES=15*128*4;
constexpr float C2=0.125f*1.4426950408889634f;
__device__ __forceinline__ void glds16(const void*gsrc,unsigned lds_dst){unsigned keep;
  asm volatile("s_mov_b32 %0, m0\n\ts_mov_b32 m0, %2\n\ts_nop 0\n\tglobal_load_lds_dwordx4 %1, off\n\ts_mov_b32 m0, %0":"=&s"(keep):"v"(gsrc),"s"(lds_dst):"memory");}
__device__ __forceinline__ void glds4(const void*gsrc,unsigned lds_dst){unsigned keep;
  asm volatile("s_mov_b32 %0, m0\n\ts_mov_b32 m0, %2\n\ts_nop 0\n\tglobal_load_lds_dword %1, off\n\ts_mov_b32 m0, %0":"=&s"(keep):"v"(gsrc),"s"(lds_dst):"memory");}
__device__ __forceinline__ float max3f(float a,float b,float c){float r;asm("v_max3_f32 %0, %1, %2, %3":"=v"(r):"v"(a),"v"(b),"v"(c));return r;}
__device__ __forceinline__ float max2f(float a,float b){float r;asm("v_max_f32_e32 %0, %1, %2":"=v"(r):"v"(a),"v"(b));return r;}
__device__ __forceinline__ float fadd_s(float a,float b){float r;asm("v_add_f32_e32 %0, %1, %2":"=v"(r):"v"(a),"v"(b));return r;}
__device__ __forceinline__ float fsub_s(float a,float b){float r;asm("v_sub_f32_e32 %0, %1, %2":"=v"(r):"v"(a),"v"(b));return r;}
typedef float f32x2_t __attribute__((ext_vector_type(2))); typedef __bf16 bf16x2_t __attribute__((ext_vector_type(2)));
__device__ __forceinline__ unsigned cvtpk_s(float lo,float hi){f32x2_t v={lo,hi};bf16x2_t b=__builtin_convertvector(v,bf16x2_t);return __builtin_bit_cast(unsigned,b);}
#define WAIT_BAR(N) asm volatile("s_waitcnt vmcnt(" #N ") lgkmcnt(0)\n\ts_barrier":::"memory")

__device__ __forceinline__ void qkt(f32x16&p0,f32x16&p1,const char*Kslot,const bf16x8*qr,const f32x16&negm,int r32,int hi){
  const char*kb=Kslot+hi*1024+r32*16;
  #pragma unroll
  for(int d0=0;d0<4;++d0){
    const bf16x8 b0=*reinterpret_cast<const bf16x8*>(kb+d0*2048);
    const bf16x8 b1=*reinterpret_cast<const bf16x8*>(kb+d0*2048+512);
    if(d0==0){p0=__builtin_amdgcn_mfma_f32_32x32x16_bf16(b0,qr[0],negm,0,0,0);p1=__builtin_amdgcn_mfma_f32_32x32x16_bf16(b1,qr[0],negm,0,0,0);}
    else{p0=__builtin_amdgcn_mfma_f32_32x32x16_bf16(b0,qr[d0],p0,0,0,0);p1=__builtin_amdgcn_mfma_f32_32x32x16_bf16(b1,qr[d0],p1,0,0,0);}}
}
typedef __attribute__((address_space(3))) const char* lds_cptr;
typedef short v4i16_t __attribute__((ext_vector_type(4)));
__device__ __forceinline__ void kload8(bf16x8*kf,lds_cptr kp){
  kf[0]=*(const __attribute__((address_space(3))) bf16x8*)(kp);      kf[1]=*(const __attribute__((address_space(3))) bf16x8*)(kp+512);
  kf[2]=*(const __attribute__((address_space(3))) bf16x8*)(kp+2048); kf[3]=*(const __attribute__((address_space(3))) bf16x8*)(kp+2560);
  kf[4]=*(const __attribute__((address_space(3))) bf16x8*)(kp+4096); kf[5]=*(const __attribute__((address_space(3))) bf16x8*)(kp+4608);
  kf[6]=*(const __attribute__((address_space(3))) bf16x8*)(kp+6144); kf[7]=*(const __attribute__((address_space(3))) bf16x8*)(kp+6656);
}
__device__ __forceinline__ void kload2(bf16x8*kf,lds_cptr kp,int j){ kf[2*j]=*(const __attribute__((address_space(3))) bf16x8*)(kp+j*2048); kf[2*j+1]=*(const __attribute__((address_space(3))) bf16x8*)(kp+j*2048+512); }
__device__ __forceinline__ s16x4 vtr(lds_cptr p){ return __builtin_bit_cast(s16x4,__builtin_amdgcn_ds_read_tr16_b64_v4i16((__attribute__((address_space(3))) v4i16_t*)p)); }
__device__ __forceinline__ float rowmax(const f32x16&p0,const f32x16&p1){
  float a=max3f(p0[0],p0[1],p1[0]),b=max3f(p0[2],p0[3],p1[1]);a=max3f(a,p1[2],p1[3]);
  #pragma unroll
  for(int r=4;r<16;r+=4){a=max3f(a,p0[r],p0[r+1]);b=max3f(b,p0[r+2],p0[r+3]);a=max3f(a,p1[r],p1[r+1]);b=max3f(b,p1[r+2],p1[r+3]);}
  const float m=max2f(a,b);
  auto rr=__builtin_amdgcn_permlane32_swap(__float_as_uint(m),__float_as_uint(m),false,false);
  return max2f(__uint_as_float(rr[0]),__uint_as_float(rr[1]));
}
__device__ __forceinline__ void pv(f32x16*o,int vb,bf16x8 pa0,bf16x8 pa1,bf16x8 pa2,bf16x8 pa3){
  #pragma unroll
  for(int d0=0;d0<2;++d0){s16x4 lo[4],hi[4];
    #pragma unroll
    for(int ks=0;ks<4;++ks){
      asm volatile("ds_read_b64_tr_b16 %0,%1 offset:%c2":"=&v"(lo[ks]):"v"(vb),"i"(d0*4096+ks*1024):"memory");
      asm volatile("ds_read_b64_tr_b16 %0,%1 offset:%c2":"=&v"(hi[ks]):"v"(vb),"i"(d0*4096+ks*1024+512):"memory");}
    asm volatile("s_waitcnt lgkmcnt(0)":::"memory");SBAR();
    #define PK(k) (bf16x8){lo[k][0],lo[k][1],lo[k][2],lo[k][3],hi[k][0],hi[k][1],hi[k][2],hi[k][3]}
    o[d0]=__builtin_amdgcn_mfma_f32_32x32x16_bf16(pa0,PK(0),o[d0],0,0,0);
    o[d0]=__builtin_amdgcn_mfma_f32_32x32x16_bf16(pa1,PK(1),o[d0],0,0,0);
    o[d0]=__builtin_amdgcn_mfma_f32_32x32x16_bf16(pa2,PK(2),o[d0],0,0,0);
    o[d0]=__builtin_amdgcn_mfma_f32_32x32x16_bf16(pa3,PK(3),o[d0],0,0,0);
    #undef PK
  }
}

#ifndef ATTN_STORE16
#define ATTN_STORE16(p,v) (*(u32x4*)(p)=(v))
#endif
__device__ __forceinline__ void na_fill_table(const float*rpbh,char*shm){
  int tid_=threadIdx.x; asm volatile("":"+v"(tid_));
  __attribute__((address_space(3))) float* tw=(__attribute__((address_space(3))) float*)((__attribute__((address_space(3))) char*)shm+LDS_NATAB);
  for(int i=tid_;i<15*128;i+=NW*64){ const int dr=i>>7, j=(i&127)-63; tw[i]=(j>=-15&&j<=15)?rpbh[dr*31+j+15]*1.4426950408889634f:0.f; }
}
template<int THRL,int MODE> __device__ __forceinline__ void attn_unit(const bf16*Q0,const bf16*__restrict__ Kh,const bf16*__restrict__ Vh,unsigned char*O0,const int NT,const int R0w,const int nar0,const float*rpbh,char*shm,
    const bool pre,const bf16*nQ0,const bf16*nKh,const bf16*nVh){
  int tid_=threadIdx.x; asm volatile("":"+v"(tid_));
  const int tid=tid_,lane=tid&63,r32=lane&31,hi=lane>>5; const int wid=__builtin_amdgcn_readfirstlane(tid>>6);
  const bf16*Qw=Q0+(long)wid*QBLK*DM;
  const unsigned lds0=(unsigned)(uintptr_t)shm;
  float*wsf=(float*)(shm+LDS_WS)+wid*64;
  const bf16*ksrc=Kh+(long)lane*DM+wid*8;
  const bf16*vsrc=Vh+(long)(16*(wid&3)+(lane>>2))*DM+(wid>>2)*32+(lane&3)*8;
  const unsigned kdst=lds0+LDS_K+wid*1024, vdst=lds0+LDS_V+wid*1024;
  #define DMA_K(t,slot) glds16(ksrc+(long)TILE(t)*KVBLK*DM,(unsigned)__builtin_amdgcn_readfirstlane(kdst+(slot)))
  #define DMA_V(t,slot) glds16(vsrc+(long)TILE(t)*KVBLK*DM,(unsigned)__builtin_amdgcn_readfirstlane(vdst+(slot)))
  const int vb0=(int)(lds0+LDS_V)+((lane>>4)&1)*32+(lane&3)*8+(4*hi+((lane&15)>>2))*64;
  const char*Kbase=shm+LDS_K; bf16x8 kf[8];
  const lds_cptr shm3=(lds_cptr)shm; const lds_cptr kp0=shm3+LDS_K+hi*1024+r32*16; const lds_cptr vp0=shm3+LDS_V+((lane>>4)&1)*32+(lane&3)*8+(4*hi+((lane&15)>>2))*64;
  #define TILE(t) ((t)+(((t)>=4)?R0w:0))
  const int nr=nar0+(wid>>1), nc=32*(wid&1)+r32; const int nrs=min(max(nr-4,0),24), ncs=min(max(nc-8,0),48);
  const __attribute__((address_space(3))) float* ntab=(const __attribute__((address_space(3))) float*)((lds_cptr)shm+LDS_NATAB)+63-nc+4*hi;
  (void)rpbh;
  if(!pre){DMA_K(0,0);DMA_V(0,0);DMA_K(1,SLOTB);}
  else{DMA_V(0,0);}
  bf16x8 qr[4];
  #pragma unroll
  for(int d0=0;d0<4;++d0)qr[d0]=__builtin_nontemporal_load(reinterpret_cast<const bf16x8*>(&Qw[(long)r32*DM+d0*16+hi*8]));
  float mhat=0.f,l_reg=0.f;f32x16 o[2];o[0]=f32x16{};o[1]=f32x16{};f32x16 negm=f32x16{}; if(MODE==0)asm volatile("":"+v"(negm));
  #define CMASK(P0,P1,t) do{ if(MODE==1){ if((t)<4){ _Pragma("unroll") for(int r=0;r<16;++r){P0[r]-=mhat;P1[r]-=mhat;} } else { const int kr_=R0w+(t)-4; \
      if((unsigned)(kr_-nrs)>=8u){ _Pragma("unroll") for(int r=0;r<16;++r){P0[r]=-INFINITY;P1[r]=-INFINITY;} } \
      else{ const __attribute__((address_space(3))) float* br_=ntab+(kr_-nr+7)*128; \
        _Pragma("unroll") for(int r=0;r<16;++r){ const int ko_=(r&3)+8*(r>>2); const int kc_=ko_+4*hi; \
          P0[r]=((unsigned)(kc_-ncs)<16u)?P0[r]+(br_[ko_]-mhat):-INFINITY; P1[r]=((unsigned)(kc_+32-ncs)<16u)?P1[r]+(br_[ko_+32]-mhat):-INFINITY; \
          if((r&3)==3){ asm volatile("":"+v"(P0),"+v"(P1)); SBAR(); } } } } } }while(0)
  bool resc=false;
  #define NEGMC (MODE==1?f32x16{}:negm)
  #define START(P0,P1) do{ const float rm=rowmax(P0,P1); resc=false; \
    { const float dl=rm; mhat=fadd_s(mhat,dl); \
      _Pragma("unroll") for(int r=0;r<16;++r){P0[r]=fsub_s(P0[r],dl);P1[r]=fsub_s(P1[r],dl);} \
      if(MODE==0){ _Pragma("unroll") for(int r=0;r<16;++r)negm[r]=-mhat; asm volatile("":"+v"(negm)); } } \
    _Pragma("unroll") for(int r=0;r<16;++r)P0[r]=__builtin_amdgcn_exp2f(P0[r]); }while(0)
  #define RESC() do{ if(resc){ asm volatile("s_waitcnt lgkmcnt(0)":::"memory"); \
      _Pragma("unroll") for(int d_=0;d_<2;++d_) _Pragma("unroll") for(int r=0;r<16;++r)o[d_][r]*=wsf[crow(r,hi)]; } }while(0)
  f32x16 pA0,pA1,pB0,pB1;
  int sl_prev=0,sl_cur=0,sl_next=SLOTB;
  #define ROT() do{sl_prev=sl_cur;sl_cur=sl_next;sl_next=(sl_next==(NSLOT-1)*SLOTB)?0:sl_next+SLOTB;}while(0)
  if(!pre){ DMA_K(2,2*SLOTB);
    WAIT_BAR(3); }
  else{ WAIT_BAR(5); }
  qkt(pA0,pA1,Kbase,qr,negm,r32,hi);asm volatile("s_nop 15\n\ts_nop 7":"+v"(pA0),"+v"(pA1));CMASK(pA0,pA1,0);
  START(pA0,pA1);
  _Pragma("unroll") for(int r=0;r<16;++r)pA1[r]=__builtin_amdgcn_exp2f(pA1[r]);
  WAIT_BAR(0);
  DMA_K(3,0);DMA_V(1,SLOTB);
  ROT();
  kload8(kf,kp0+sl_cur);
  WAIT_BAR(2);
  s16x4 vlo[8],vhi[8]; u32x4 pw0,pw1,pw2,pw3;
  #define PKW(P,B) cvtpk_s(P[B],P[B+1])
  #define PAF(k) __builtin_bit_cast(bf16x8,pw##k)
  #define VFR(i) (bf16x8){vlo[i][0],vlo[i][1],vlo[i][2],vlo[i][3],vhi[i][0],vhi[i][1],vhi[i][2],vhi[i][3]}
  #define PIN(x) asm volatile("":"+v"(x))
  #define MX3(a,b,c) __builtin_fmaxf(__builtin_fmaxf((a),(b)),(c))
  #define GAPA(MF,A0,A1,A2,A3,W0,W1,PW) do{ MF; sacc+=A0; sacc+=A1; sacc+=A2; sacc+=A3; PIN(sacc); W0; W1; PIN(PW); SBAR(); }while(0)
  #define EX(v) __builtin_amdgcn_exp2f(v)
  #define GAPB(MF,X,B) do{ MF; X[B]=EX(X[B]); X[B+1]=EX(X[B+1]); X[B+2]=EX(X[B+2]); X[B+3]=EX(X[B+3]); PIN(X); SBAR(); }while(0)
  #define VRD(i) do{ vlo[i]=vtr(vp_+(((i)>>2)*4096+((i)&3)*1024)); vhi[i]=vtr(vp_+(((i)>>2)*4096+((i)&3)*1024+512)); }while(0)
  #define KRD(G,j) do{ if(G){ kload2(kf,kp0+sl_next,j); SBAR(); } }while(0)
  #define STEP(C0,C1,P0,P1,t,GK,GV,GL) do{ SBAR(); \
    const lds_cptr vp_=vp0+sl_prev; \
    VRD(0); SBAR(); float sacc=(P0[0]+P0[1]); \
    GAPA(C0=__builtin_amdgcn_mfma_f32_32x32x16_bf16(kf[0],qr[0],NEGMC,0,0,0), P0[2],P0[3],P0[4],P0[5],     pw0[0]=PKW(P0,0), pw0[1]=PKW(P0,2), pw0); \
    VRD(4); SBAR(); GAPA(C1=__builtin_amdgcn_mfma_f32_32x32x16_bf16(kf[1],qr[0],NEGMC,0,0,0), P0[6],P0[7],P0[8],P0[9],     pw0[2]=PKW(P0,4), pw0[3]=PKW(P0,6), pw0); \
    VRD(1); SBAR(); GAPA(C0=__builtin_amdgcn_mfma_f32_32x32x16_bf16(kf[2],qr[1],C0,0,0,0),   P0[10],P0[11],P0[12],P0[13], pw1[0]=PKW(P0,8), pw1[1]=PKW(P0,10), pw1); \
    VRD(5); SBAR(); GAPA(C1=__builtin_amdgcn_mfma_f32_32x32x16_bf16(kf[3],qr[1],C1,0,0,0),   P0[14],P0[15],P1[0],P1[1],   pw1[2]=PKW(P0,12),pw1[3]=PKW(P0,14), pw1); \
    VRD(2); SBAR(); GAPA(C0=__builtin_amdgcn_mfma_f32_32x32x16_bf16(kf[4],qr[2],C0,0,0,0),   P1[2],P1[3],P1[4],P1[5],     pw2[0]=PKW(P1,0), pw2[1]=PKW(P1,2), pw2); \
    VRD(6); SBAR(); GAPA(C1=__builtin_amdgcn_mfma_f32_32x32x16_bf16(kf[5],qr[2],C1,0,0,0),   P1[6],P1[7],P1[8],P1[9],     pw2[2]=PKW(P1,4), pw2[3]=PKW(P1,6), pw2); \
    VRD(3); SBAR(); GAPA(C0=__builtin_amdgcn_mfma_f32_32x32x16_bf16(kf[6],qr[3],C0,0,0,0),   P1[10],P1[11],P1[12],P1[13], pw3[0]=PKW(P1,8), pw3[1]=PKW(P1,10), pw3); \
    VRD(7); SBAR(); GAPA(C1=__builtin_amdgcn_mfma_f32_32x32x16_bf16(kf[7],qr[3],C1,0,0,0),   P1[14],P1[15],0.f,0.f,       pw3[2]=PKW(P1,12),pw3[3]=PKW(P1,14), pw3); \
    l_reg+=sacc; \
    if(GK){DMA_K((t)+3,sl_cur);} if(GV){DMA_V((t)+1,sl_next);} \
    CMASK(C0,C1,t); \
    { float a=MX3(C0[0],C0[1],C1[0]),b=MX3(C0[2],C0[3],C1[1]); a=MX3(a,C1[2],C1[3]); \
      _Pragma("unroll") for(int r=4;r<16;r+=4){a=MX3(a,C0[r],C0[r+1]);b=MX3(b,C0[r+2],C0[r+3]);a=MX3(a,C1[r],C1[r+1]);b=MX3(b,C1[r+2],C1[r+3]);} \
      float rm=__builtin_fmaxf(a,b); { auto rr=__builtin_amdgcn_permlane32_swap(__float_as_uint(rm),__float_as_uint(rm),false,false); rm=__builtin_fmaxf(__uint_as_float(rr[0]),__uint_as_float(rr[1])); } \
      resc=false; \
      if(__builtin_expect(__any(rm>(float)THRL),0)){ const float dl=__builtin_fmaxf(rm,0.f); mhat+=dl; \
        _Pragma("unroll") for(int r=0;r<16;++r){C0[r]-=dl;C1[r]-=dl;} \
        if(MODE==0){ _Pragma("unroll") for(int r=0;r<16;++r)negm[r]=-mhat; asm volatile("":"+v"(negm)); } \
        const float f=__builtin_amdgcn_exp2f(-dl); l_reg*=f; if(hi==0)wsf[r32]=f; resc=true; } } \
    SBAR(); \
    GAPB(o[0]=__builtin_amdgcn_mfma_f32_32x32x16_bf16(PAF(0),VFR(0),o[0],0,0,0), C0,0); \
    GAPB(o[1]=__builtin_amdgcn_mfma_f32_32x32x16_bf16(PAF(0),VFR(4),o[1],0,0,0), C0,4); \
    KRD(GL,0); GAPB(o[0]=__builtin_amdgcn_mfma_f32_32x32x16_bf16(PAF(1),VFR(1),o[0],0,0,0), C0,8); \
    KRD(GL,1); GAPB(o[1]=__builtin_amdgcn_mfma_f32_32x32x16_bf16(PAF(1),VFR(5),o[1],0,0,0), C0,12); \
    KRD(GL,2); GAPB(o[0]=__builtin_amdgcn_mfma_f32_32x32x16_bf16(PAF(2),VFR(2),o[0],0,0,0), C1,0); \
    KRD(GL,3); GAPB(o[1]=__builtin_amdgcn_mfma_f32_32x32x16_bf16(PAF(2),VFR(6),o[1],0,0,0), C1,4); \
    GAPB(o[0]=__builtin_amdgcn_mfma_f32_32x32x16_bf16(PAF(3),VFR(3),o[0],0,0,0), C1,8); \
    GAPB(o[1]=__builtin_amdgcn_mfma_f32_32x32x16_bf16(PAF(3),VFR(7),o[1],0,0,0), C1,12); \
    }while(0)
  int t=1;
  for(;t+5<NT;t+=2){
    STEP(pB0,pB1,pA0,pA1,t,true,true,true);     WAIT_BAR(2); RESC(); ROT();
    STEP(pA0,pA1,pB0,pB1,t+1,true,true,true);   WAIT_BAR(2); RESC(); ROT();
  }
  #define ENDW(tt) do{ if((tt)+3<NT){WAIT_BAR(2);} else if((tt)+2<NT){WAIT_BAR(1);} else {WAIT_BAR(0);} }while(0)
  for(;t+1<NT;t+=2){
    STEP(pB0,pB1,pA0,pA1,t,(t+3<NT),(t+1<NT),(t+1<NT));       ENDW(t);   RESC(); ROT();
    STEP(pA0,pA1,pB0,pB1,t+1,(t+4<NT),(t+2<NT),(t+2<NT));     ENDW(t+1); RESC(); ROT();
  }
  if(nKh){
    const bf16*nks=nKh+(long)lane*DM+wid*8;
    glds16(nks,(unsigned)__builtin_amdgcn_readfirstlane(kdst)); glds16(nks+(long)KVBLK*DM,(unsigned)__builtin_amdgcn_readfirstlane(kdst+SLOTB)); glds16(nks+(long)2*KVBLK*DM,(unsigned)__builtin_amdgcn_readfirstlane(kdst+2*SLOTB));
  }
  STEP(pB0,pB1,pA0,pA1,NT-1,false,false,false); RESC();
  if(nKh){ const bf16*nQt=nQ0+(long)(wid*QBLK+r32)*DM+hi*32;
    glds4(nQt,(unsigned)__builtin_amdgcn_readfirstlane(lds0+LDS_OST+NW*2048+wid*256));
    if(wid<2) glds4(nVh+(long)(wid*64+lane)*DM,(unsigned)__builtin_amdgcn_readfirstlane(lds0+LDS_OST+NW*2048+NW*256+wid*256)); }
  { float sacc=pB0[0]+pB0[1]; _Pragma("unroll") for(int r=2;r<16;++r)sacc+=pB0[r]; _Pragma("unroll") for(int r=0;r<16;++r)sacc+=pB1[r]; l_reg+=sacc;
    pw0=(u32x4){PKW(pB0,0),PKW(pB0,2),PKW(pB0,4),PKW(pB0,6)};pw1=(u32x4){PKW(pB0,8),PKW(pB0,10),PKW(pB0,12),PKW(pB0,14)};pw2=(u32x4){PKW(pB1,0),PKW(pB1,2),PKW(pB1,4),PKW(pB1,6)};pw3=(u32x4){PKW(pB1,8),PKW(pB1,10),PKW(pB1,12),PKW(pB1,14)};
    SBAR(); pv(o,vb0+sl_cur,PAF(0),PAF(1),PAF(2),PAF(3)); }
  #undef PKW
  #undef PAF
  #undef VFR
  #undef PIN
  #undef MX3
  #undef GAPA
  #undef GAPB
  #undef EX
  #undef VRD
  #undef KRD
  #undef STEP
  #undef ENDW
  {auto rr=__builtin_amdgcn_permlane32_swap(__float_as_uint(l_reg),__float_as_uint(l_reg),false,false);l_reg=__uint_as_float(rr[0])+__uint_as_float(rr[1]);}
  if(hi==0)wsf[32+r32]=l_reg;asm volatile("s_waitcnt lgkmcnt(0)":::"memory");
  float rli[16];
  #pragma unroll
  for(int r=0;r<16;++r)rli[r]=__builtin_amdgcn_rcpf(wsf[32+crow(r,hi)]);
  unsigned char*Ow=O0+(long)wid*QBLK*ATTN_OPITCH;
  { unsigned char*stg=(unsigned char*)(shm+LDS_OST)+wid*2048;
    #pragma unroll
    for(int r=0;r<16;++r){const int orow=crow(r,hi); const float sc=rli[r]*ATTN_OSCALE;
      const unsigned w=(unsigned)__builtin_amdgcn_cvt_pk_fp8_f32(__builtin_amdgcn_fmed3f(o[0][r]*sc,-448.f,448.f),__builtin_amdgcn_fmed3f(o[1][r]*sc,-448.f,448.f),0,false);
      stg[orow*64+r32]=(unsigned char)w; stg[orow*64+32+r32]=(unsigned char)(w>>8);}
    asm volatile("s_waitcnt lgkmcnt(0)":::"memory");
    #pragma unroll
    for(int i=0;i<2;++i){const int row=i*16+(lane>>2),ch=lane&3; const u32x4 v=*(const u32x4*)(stg+row*64+ch*16); ATTN_STORE16(Ow+(long)row*ATTN_OPITCH+ch*16,v);} }
  asm volatile("s_waitcnt lgkmcnt(0)\n\ts_barrier":::"memory");
  #undef TILE
  #undef DMA_K
  #undef DMA_V
  #undef CMASK
  #undef NEGMC
  #undef START
  #undef RESC
  #undef ROT
}
constexpr int ATTN_LDS_BYTES=LDS_BYTES+NATAB_BYTES;
#undef SBAR
#undef WAIT_BAR
}
#define GAS __attribute__((address_space(1)))
#define LAS __attribute__((address_space(3)))
typedef unsigned short bf16;
typedef unsigned v4u __attribute__((ext_vector_type(4)));
typedef float f32x4 __attribute__((ext_vector_type(4)));
typedef short bf16x8 __attribute__((ext_vector_type(8)));
typedef GAS unsigned gu32;
typedef GAS unsigned long long gu64;
#define RLX_AGENT __ATOMIC_RELAXED, __HIP_MEMORY_SCOPE_AGENT
#define LDS_WAIT() asm volatile("s_waitcnt lgkmcnt(0)" ::: "memory")
#define VM_WAIT() asm volatile("s_waitcnt vmcnt(0)" ::: "memory")
__device__ __forceinline__ unsigned long long rt() { return __builtin_amdgcn_s_memrealtime(); }
__device__ __forceinline__ unsigned f2bf(float f) { unsigned u = __builtin_bit_cast(unsigned, f); return (u + 0x7fffu + ((u >> 16) & 1u)) >> 16; }
typedef float f32x2_pk __attribute__((ext_vector_type(2))); typedef __bf16 bf16x2_pk __attribute__((ext_vector_type(2)));
__device__ __forceinline__ unsigned pk2(float lo, float hi) { const f32x2_pk v = {lo, hi}; return __builtin_bit_cast(unsigned, __builtin_convertvector(v, bf16x2_pk)); }

#define XB_TMO      128
#define XB_XCNT(j)  (256  + 64 * (j))
#define XB_XSUB(j)  (1280 + 64 * (j))
#define XB_XGEN(j)  (2304 + 64 * (j))
#define XB_TOP      3328
#define XB_TOPGEN   3392
#define XCD_BAR_WORDS 3456
#define XB_SPIN_CAP (1u << 18)

__device__ __forceinline__ unsigned xb_ld(unsigned* p)              { return __hip_atomic_load(p, __ATOMIC_RELAXED, __HIP_MEMORY_SCOPE_AGENT); }
__device__ __forceinline__ unsigned xb_add(unsigned* p, unsigned v) { return __hip_atomic_fetch_add(p, v, __ATOMIC_RELAXED, __HIP_MEMORY_SCOPE_AGENT); }
__device__ __forceinline__ unsigned xb_xcc_id() { return (unsigned)__builtin_amdgcn_s_getreg((3 << 11) | 20) & 0xFu; }
#define XB_SPIN(cond, bar) do { unsigned _sp = 0; while (cond) { __builtin_amdgcn_s_sleep(1); \
    if ((++_sp & 255u) == 0u) { if (xb_ld(&(bar)[XB_TMO])) break; if (_sp > XB_SPIN_CAP) { atomicAdd(&(bar)[XB_TMO], 1u); break; } } } } while (0)

struct XcdBarrier {
    unsigned* bar; unsigned x;
    volatile LAS unsigned* st;
};

__device__ __forceinline__ XcdBarrier xcd_barrier_post(unsigned* bar, volatile LAS unsigned* st) {
    XcdBarrier b; b.bar = bar; b.x = xb_xcc_id(); b.st = st;
    if (threadIdx.x == 0) (void)xb_add(&bar[XB_XCNT(b.x)], 1u);
    return b;
}
__device__ __forceinline__ void xcd_barrier_complete(unsigned* bar, unsigned x, unsigned& nloc, unsigned& nx) {
    const unsigned G = gridDim.x * gridDim.y * gridDim.z;
    unsigned sum, cnt, mine, sp = 0u;
    for (;;) {
        sum = 0u; cnt = 0u; mine = 0u;
#pragma unroll
        for (unsigned j = 0; j < 16; ++j) { const unsigned c = xb_ld(&bar[XB_XCNT(j)]); sum += c; cnt += (c > 0u) ? 1u : 0u; mine = (j == x) ? c : mine; }
        if (sum == G) break;
        __builtin_amdgcn_s_sleep(1);
        if ((++sp & 255u) == 0u) { if (xb_ld(&bar[XB_TMO])) break; if (sp > XB_SPIN_CAP) { atomicAdd(&bar[XB_TMO], 1u); break; } }
    }
    nloc = mine > 0u ? mine : 1u; nx = cnt > 0u ? cnt : 1u;
}

__device__ __forceinline__ void xcd_barrier(const XcdBarrier& b) {
    asm volatile("s_waitcnt vmcnt(0)" ::: "memory");
    __syncthreads();
    if (threadIdx.x == 0) {
        unsigned* bar = b.bar;
        __builtin_amdgcn_s_waitcnt(0);
        unsigned nloc = b.st[0], nx = b.st[1];
        if (nloc == 0u) { xcd_barrier_complete(bar, b.x, nloc, nx); b.st[0] = nloc; b.st[1] = nx; }
        const unsigned old = xb_add(&bar[XB_XSUB(b.x)], 1u);
        const unsigned gen = old / nloc;
        if (old + 1u == (gen + 1u) * nloc) {
            __builtin_amdgcn_fence(__ATOMIC_RELEASE, "agent");
            asm volatile("s_waitcnt vmcnt(0)" ::: "memory");
            const unsigned og = xb_add(&bar[XB_TOP], 1u);
            const unsigned tg = og / nx;
            if (og + 1u == (tg + 1u) * nx) xb_add(&bar[XB_TOPGEN], 1u);
            else XB_SPIN(xb_ld(&bar[XB_TOPGEN]) == tg, bar);
            __builtin_amdgcn_fence(__ATOMIC_ACQUIRE, "agent");
            xb_add(&bar[XB_XGEN(b.x)], 1u);
            asm volatile("s_waitcnt vmcnt(0)" ::: "memory");
        } else {
            XB_SPIN(xb_ld(&bar[XB_XGEN(b.x)]) == gen, bar);
            __builtin_amdgcn_fence(__ATOMIC_ACQUIRE, "agent");
            asm volatile("s_waitcnt vmcnt(0)" ::: "memory");
        }
    }
    __syncthreads();
}
constexpr int DMODEL = 1024, NB = 32, SEQ = 2048, CTXL = 256, SB = SEQ + CTXL  , DEPTH = 2, NE = 16;
#ifndef MK_NCHUNK
#define MK_NCHUNK 2
#endif
constexpr int NCHUNK = MK_NCHUNK, BC = NB / NCHUNK, MC = BC * SB;
constexpr int PW = 4352, NPROJ = 7424, GW = NPROJ - PW;
constexpr int C_LX = 0, C_LG = 1024, C_NQ = 2048, C_GQ = 2560, C_NK = 3072, C_NV = 3584, C_GK = 4096, C_GV = 4224;
constexpr float EPS = 1e-6f;
constexpr float QSCALE = 0.125f * 1.4426950408889634f;
constexpr int NMOD = 6 * DMODEL;

enum { I_X = 0, I_C, I_CTX, I_CCTX, I_WMOD, I_BMOD, I_NORMG, I_WIN, I_CONVW, I_CONVB, I_LWA, I_LBA, I_LWX, I_LBX, I_LLAM, I_RPB, I_QNG, I_KNG, I_WOA, I_WOB, I_WOC, I_WOUT, I_WR, I_WG, I_WU, I_WD, N_IN };

struct Args { const float* in[N_IN]; float* out; unsigned char* ws; int ph_lo, ph_hi; };
constexpr size_t MiB = 1u << 20;
constexpr size_t WS_CTL = 0, CTL_ZERO_BYTES = 3 * MiB;
constexpr size_t CTL_MOD_OFF = 1 * MiB;
constexpr int CW_TMO = 0, CW_BAR = 4096;
constexpr size_t WS_W = 4 * MiB, LW = 64 * MiB;
constexpr size_t W_P = 0, W_O = 8 * MiB, W_OUT = 12 * MiB, W_LRU = 14 * MiB, W_GU = 16 * MiB, W_D = 48 * MiB;
constexpr size_t WS_XR = 132 * MiB;
constexpr size_t WS_H = 276 * MiB;
constexpr size_t WS_HT = 348 * MiB;
constexpr size_t WS_AFFEN = 420 * MiB, WS_AFFNE = 423 * MiB, WS_SLOT = 426 * MiB;
constexpr size_t WS_ROWIDX = WS_SLOT + 3 * MiB;
static_assert((size_t)MC * NE * 4 <= 3 * MiB && WS_ROWIDX + (size_t)(NE * BC * 288) * 4 <= 430 * MiB, "slot / row-list map");
constexpr size_t WS_P = 430 * MiB;
constexpr size_t WS_O1 = WS_P, WS_HS = WS_P + 72 * MiB, WS_ACT = WS_P + 216 * MiB;
constexpr size_t WS_G8 = WS_P + (size_t)MC * PW * 2;
constexpr size_t WS_M8 = WS_G8 + (size_t)MC * GW;
constexpr float M8_SA = 4.f, M8_SB = 32.f, MQ_S = 16.f;
constexpr size_t WS_END = WS_M8 + (size_t)MC * 2048;
static_assert(NCHUNK == 2, "the workspace map below is laid out for two chunks");
static_assert(WS_END <= 1024 * MiB && (size_t)MC * 1024 * 2 <= 72 * MiB && WS_ACT + 72 * MiB <= WS_G8 && WS_HS + 144 * MiB <= WS_ACT, "d_ws map");
static_assert(CTL_MOD_OFF + (size_t)DEPTH * 33 * NMOD * 4 <= CTL_ZERO_BYTES, "mod accumulators inside the memset region");

constexpr int RING_BYTES = 131072, LDSCTL_OFF = 135168  , MISC_OFF = LDSCTL_OFF + 320, LDS_BYTES = 147456;
static_assert(8 * 16640 <= LDSCTL_OFF && MISC_OFF + 128 <= LDS_BYTES, "LDS map");

__device__ __forceinline__ float bf2f(unsigned v) { return __uint_as_float(v << 16); }
__device__ __forceinline__ float shfl_idx(float v, int src) { return __builtin_bit_cast(float, __builtin_amdgcn_ds_bpermute(src << 2, __builtin_bit_cast(int, v))); }
__device__ __forceinline__ float shx(float v, int m, int lane) { return shfl_idx(v, lane ^ m); }
#define DPPF(v, CTRL) __builtin_bit_cast(float, __builtin_amdgcn_update_dpp(0, __builtin_bit_cast(int, (v)), (CTRL), 0xf, 0xf, false))
__device__ __forceinline__ float sum16(float v) {
    v += DPPF(v, 0xB1); v += DPPF(v, 0x4E); v += DPPF(v, 0x141); v += DPPF(v, 0x140); return v; }
__device__ __forceinline__ float swap16_sum(float v) { const auto r = __builtin_amdgcn_permlane16_swap(__float_as_uint(v), __float_as_uint(v), false, false); return __uint_as_float(r[0]) + __uint_as_float(r[1]); }
__device__ __forceinline__ float swap32_sum(float v) { const auto r = __builtin_amdgcn_permlane32_swap(__float_as_uint(v), __float_as_uint(v), false, false); return __uint_as_float(r[0]) + __uint_as_float(r[1]); }
__device__ __forceinline__ float swap16_get(float v, int lane) { const auto r = __builtin_amdgcn_permlane16_swap(__float_as_uint(v), __float_as_uint(v), false, false); return __uint_as_float((lane & 16) ? r[0] : r[1]); }
__device__ __forceinline__ float swap32_get(float v, int lane) { const auto r = __builtin_amdgcn_permlane32_swap(__float_as_uint(v), __float_as_uint(v), false, false); return __uint_as_float((lane & 32) ? r[0] : r[1]); }
__device__ __forceinline__ float wave_sum(float v, int lane) { (void)lane; return swap32_sum(swap16_sum(sum16(v))); }
__device__ __forceinline__ float half_sum(float v) { return swap16_sum(sum16(v)); }
#define PH_IDS int tid_ = threadIdx.x; asm volatile("" : "+v"(tid_)); const int tid = tid_, lane = tid & 63, wid = __builtin_amdgcn_readfirstlane(tid >> 6); \
    int vcu_ = F.vcu; asm volatile("" : "+s"(vcu_)); const int vcu = vcu_; (void)vcu; (void)wid; (void)lane;
__device__ __forceinline__ float fast_rcp(float x) { return __builtin_amdgcn_rcpf(x); }
__device__ __forceinline__ float sigmoidf_(float x) { return fast_rcp(1.f + __expf(-x)); }

struct Frame {
    LAS unsigned char* lds;
    int vcu, G;
    float* out; unsigned char* ws;
};

__device__ __forceinline__ void tr_item(const float* W, int ldw, bf16* WT, int ldt, int k0, int n0, int drow0, int dk0, float scale, LAS float* scr, int lane) {
    float t_[32];
#pragma unroll
    for (int i = 0; i < 32; ++i) { const int kk = 2 * i + (lane >> 5); t_[i] = W[(size_t)(k0 + kk) * ldw + n0 + (lane & 31)]; }
#pragma unroll
    for (int i = 0; i < 32; ++i) { const int kk = 2 * i + (lane >> 5); scr[kk * 33 + (lane & 31)] = t_[i] * scale; }
    LDS_WAIT(); asm volatile("" ::: "memory");
    const int c = lane & 7;
#pragma unroll
    for (int j = 0; j < 4; ++j) { const int n = (lane >> 3) + 8 * j; const LAS float* s = scr + (8 * c) * 33 + n;
        v4u o; o.x = pk2(s[0 * 33], s[1 * 33]); o.y = pk2(s[2 * 33], s[3 * 33]); o.z = pk2(s[4 * 33], s[5 * 33]); o.w = pk2(s[6 * 33], s[7 * 33]);
        *(GAS v4u*)(WT + (size_t)(drow0 + n) * ldt + dk0 + 8 * c) = o; }
    LDS_WAIT(); asm volatile("" ::: "memory");
}

__device__ __forceinline__ unsigned pk4_fp8(float a, float b, float c, float d) { int w = __builtin_amdgcn_cvt_pk_fp8_f32(a, b, 0, false); w = __builtin_amdgcn_cvt_pk_fp8_f32(c, d, w, true); return (unsigned)w; }
__device__ __forceinline__ void tr_item_fp8(const float* W, int ldw, unsigned char* WT, int ldt, int k0, int n0, int drow0, int dk0, float scale, LAS float* scr, int lane) {
    f32x4 t_[16];
#pragma unroll
    for (int i = 0; i < 16; ++i) t_[i] = __builtin_nontemporal_load((const f32x4*)(W + (size_t)(k0 + 4 * i + (lane >> 4)) * ldw + n0 + 4 * (lane & 15)));
#pragma unroll
    for (int i = 0; i < 16; ++i) { LAS float* d = scr + (4 * i + (lane >> 4)) * 65 + 4 * (lane & 15); d[0] = t_[i].x * scale; d[1] = t_[i].y * scale; d[2] = t_[i].z * scale; d[3] = t_[i].w * scale; }
    LDS_WAIT(); asm volatile("" ::: "memory");
    const LAS float* s = scr + lane;
    GAS v4u* dst = (GAS v4u*)(WT + (size_t)(drow0 + lane) * ldt + dk0);
#pragma unroll
    for (int q4 = 0; q4 < 4; ++q4) { unsigned o[4];
#pragma unroll
        for (int q = 0; q < 4; ++q) { const int k = 16 * q4 + 4 * q; o[q] = pk4_fp8(s[k * 65], s[(k + 1) * 65], s[(k + 2) * 65], s[(k + 3) * 65]); }
        dst[q4] = (v4u){o[0], o[1], o[2], o[3]}; }
    LDS_WAIT(); asm volatile("" ::: "memory");
}

constexpr int IT_WIN = 16 * 116, IT_WOA = 256, IT_WOB = 128, IT_WOC = 128, IT_WOUT = 256, IT_LRU = 256, IT_GU = 16 * 512, IT_D = 16 * 256;
constexpr int IT_LAYER = IT_WIN + IT_WOA + IT_WOB + IT_WOC + IT_WOUT + IT_LRU + IT_GU + IT_D;
__device__ __forceinline__ void ph_prologue(const Args& A_, Frame& F) {
    PH_IDS
    float* mod = (float*)(F.ws + CTL_MOD_OFF);
    const int q0 = vcu + F.G * wid, NADA = DEPTH * 96 * 3, nconv = F.G * 8 - NADA; const bool split = nconv >= F.G * 4;
    for (int q = q0; q < NADA; q += F.G * 8) {
        const int l = q / 288, rem = q % 288, g = rem / 3, r0 = (rem % 3) * 11;
        const float* W = A_.in[I_WMOD] + (size_t)l * DMODEL * NMOD + g * 64 + lane;
        float acc[11];
#pragma unroll
        for (int i = 0; i < 11; ++i) acc[i] = 0.f;
        float wA[32], wB[32], cn[11];
#define ADA_LOADW(dst, kb_, h_) do { const float* Wk_ = W + (size_t)((kb_) * 64 + 32 * (h_)) * NMOD; _Pragma("unroll") for (int kk = 0; kk < 32; ++kk) dst[kk] = Wk_[(size_t)kk * NMOD]; } while (0)
#define ADA_LOADC(kb_) do { _Pragma("unroll") for (int i = 0; i < 11; ++i) { const int r = r0 + i; cn[i] = (r < 32) ? A_.in[I_C][r * DMODEL + (kb_) * 64 + lane] : A_.in[I_CCTX][(kb_) * 64 + lane]; } } while (0)
#define ADA_FMA(src, h_) do { _Pragma("unroll") for (int kk = 0; kk < 32; ++kk) _Pragma("unroll") for (int i = 0; i < 11; ++i) \
            acc[i] += __builtin_bit_cast(float, __builtin_amdgcn_readlane(__builtin_bit_cast(int, sv[i]), 32 * (h_) + kk)) * src[kk]; } while (0)
        ADA_LOADC(0); ADA_LOADW(wA, 0, 0);
        for (int kb = 0; kb < 16; ++kb) {
            float sv[11];
#pragma unroll
            for (int i = 0; i < 11; ++i) sv[i] = cn[i] * sigmoidf_(cn[i]);
            if (kb + 1 < 16) ADA_LOADC(kb + 1);
            ADA_LOADW(wB, kb, 1);
            ADA_FMA(wA, 0);
            if (kb + 1 < 16) ADA_LOADW(wA, kb + 1, 0);
            ADA_FMA(wB, 1);
        }
#undef ADA_LOADW
#undef ADA_LOADC
#undef ADA_FMA
        const float bm = A_.in[I_BMOD][l * NMOD + g * 64 + lane];
        const int seg = (g * 64) >> 10, cc = ((g * 64) & 1023) + lane;
        const float ngv = (seg == 1) ? A_.in[I_NORMG][(l * 4 + 0) * DMODEL + cc] : (seg == 2) ? A_.in[I_NORMG][(l * 4 + 1) * DMODEL + cc] : (seg == 4) ? A_.in[I_NORMG][(l * 4 + 2) * DMODEL + cc] : (seg == 5) ? A_.in[I_NORMG][(l * 4 + 3) * DMODEL + cc] : 1.f;
        const float one = (seg == 1 || seg == 4) ? 1.f : 0.f;
#pragma unroll
        for (int i = 0; i < 11; ++i) mod[(size_t)(l * 33 + r0 + i) * NMOD + g * 64 + lane] = (acc[i] + bm + one) * ngv;
    }
    LAS float* scr = (LAS float*)(F.lds + wid * 16640);
    const int gw = split ? q0 - NADA : vcu * 8 + wid, NGW = split ? nconv : F.G * 8;
    for (int it = (gw >= 0 ? gw : DEPTH * IT_LAYER); it < DEPTH * IT_LAYER; it += NGW) {
        const int l = it / IT_LAYER; int r = it - l * IT_LAYER;
        unsigned char* wl = F.ws + WS_W + (size_t)l * LW;
        if (r < IT_WIN) { const int k0 = 64 * (r / 116), n0 = 64 * (r % 116);
            const int dr = (n0 < 2560) ? n0 : (n0 < 3584) ? n0 + 512 : (n0 < 4096) ? n0 - 1024 : n0;
            const float sc = (n0 >= 2048 && n0 < 2560) ? QSCALE : 1.f;
            tr_item_fp8(A_.in[I_WIN] + (size_t)l * DMODEL * NPROJ, NPROJ, wl + W_P, 1024, k0, n0, dr, k0, sc * 64.f, scr, lane); continue; } r -= IT_WIN;
        if (r < IT_WOA) { const int k0 = 64 * (r / 16), n0 = 64 * (r % 16); tr_item_fp8(A_.in[I_WOA] + (size_t)l * 1024 * 1024, 1024, wl + W_O, 2048, k0, n0, n0, k0, 64.f, scr, lane); continue; } r -= IT_WOA;
        if (r < IT_WOB) { const int k0 = 64 * (r / 16), n0 = 64 * (r % 16); tr_item_fp8(A_.in[I_WOB] + (size_t)l * 512 * 1024, 1024, wl + W_O, 2048, k0, n0, n0, 1024 + k0, 64.f, scr, lane); continue; } r -= IT_WOB;
        if (r < IT_WOC) { const int k0 = 64 * (r / 16), n0 = 64 * (r % 16); tr_item_fp8(A_.in[I_WOC] + (size_t)l * 512 * 1024, 1024, wl + W_O, 2048, k0, n0, n0, 1536 + k0, 64.f, scr, lane); continue; } r -= IT_WOC;
        if (r < IT_WOUT) { const int k0 = 64 * (r / 16), n0 = 64 * (r % 16); tr_item_fp8(A_.in[I_WOUT] + (size_t)l * 1024 * 1024, 1024, wl + W_OUT, 1024, k0, n0, n0, k0, 64.f, scr, lane); continue; } r -= IT_WOUT;
        if (r < IT_LRU) { const int mi = r >> 3, sub = r & 7, dir = mi >> 4, mat = (mi >> 3) & 1, blk = mi & 7, k0 = 64 * (sub >> 2), n0 = 32 * (sub & 3);
            const float* src = (mat ? A_.in[I_LWX] : A_.in[I_LWA]) + (size_t)((l * 2 + dir) * 8 + blk) * 128 * 128;
            tr_item(src, 128, (bf16*)(wl + W_LRU) + (size_t)((dir * 2 + mat) * 8 + blk) * 128 * 128, 128, k0, n0, n0, k0, 1.f, scr, lane); continue; } r -= IT_LRU;
        if (r < IT_GU) { const int e = r >> 9, rr = r & 511, mat = rr >> 8, q = rr & 255, k0 = 64 * (q / 16), n0 = 64 * (q % 16);
            const float* src = (mat ? A_.in[I_WU] : A_.in[I_WG]) + (size_t)(l * NE + e) * 1024 * 1024;
            tr_item_fp8(src, 1024, wl + W_GU + (size_t)e * 2048 * 1024, 1024, k0, n0, (n0 >> 7) * 256 + mat * 128 + (n0 & 127), k0, 64.f, scr, lane); continue; } r -= IT_GU;
        { const int e = r >> 8, q = r & 255, k0 = 64 * (q / 16), n0 = 64 * (q % 16);
            tr_item_fp8(A_.in[I_WD] + (size_t)(l * NE + e) * 1024 * 1024, 1024, wl + W_D + (size_t)e * 1024 * 1024, 1024, k0, n0, n0, k0, 64.f, scr, lane); }
    }
}

__device__ __forceinline__ void row_load(const float* p, int lane, f32x4 (&v)[4]) {
#pragma unroll
    for (int j = 0; j < 4; ++j) v[j] = ((const f32x4*)p)[lane + 64 * j];
}
__device__ __forceinline__ float row_rstd(const f32x4 (&v)[4], int lane) {
    float s = 0.f;
#pragma unroll
    for (int j = 0; j < 4; ++j) s += (v[j].x * v[j].x + v[j].y * v[j].y) + (v[j].z * v[j].z + v[j].w * v[j].w);
    return rsqrtf(wave_sum(s, lane) * (1.f / DMODEL) + EPS);
}
__device__ __forceinline__ void row_store_bf16(bf16* p, int lane, const f32x4 (&v)[4]) {
#pragma unroll
    for (int j = 0; j < 4; ++j) ((unsigned long long*)p)[lane + 64 * j] = (unsigned long long)pk2(v[j].x, v[j].y) | ((unsigned long long)pk2(v[j].z, v[j].w) << 32);
}
__device__ __forceinline__ void row_store_fp8(unsigned char* p, int lane, const f32x4 (&v)[4]) {
#pragma unroll
    for (int j = 0; j < 4; ++j) ((unsigned*)p)[lane + 64 * j] = pk4_fp8(v[j].x, v[j].y, v[j].z, v[j].w);
}
__device__ __forceinline__ void row_load_bf16(const bf16* p, int lane, f32x4 (&v)[4]) {
#pragma unroll
    for (int j = 0; j < 4; ++j) { const unsigned long long w = ((const unsigned long long*)p)[lane + 64 * j];
        v[j].x = bf2f((unsigned)w & 0xffffu); v[j].y = bf2f(((unsigned)w >> 16)); v[j].z = bf2f((unsigned)(w >> 32) & 0xffffu); v[j].w = bf2f((unsigned)(w >> 48)); }
}
__device__ __forceinline__ const float* res_in(const Args& A_, int b, int s) {
    if (s < CTXL) return A_.in[I_CTX] + ((size_t)b * CTXL + s) * DMODEL;
    return A_.in[I_X] + ((size_t)b * SEQ + (s - CTXL)) * DMODEL;
}
__device__ __forceinline__ bf16* res_xr(const Frame& F, int b, int s) { return (bf16*)(F.ws + WS_XR) + ((size_t)b * SB + s) * DMODEL; }
__device__ __forceinline__ const float* mod_row(const Args& A_, const Frame& F, int l, int b, int s) { return (const float*)(F.ws + CTL_MOD_OFF) + (size_t)(l * 33 + (s < CTXL ? 32 : b)) * NMOD; }

__device__ __forceinline__ void ph_norm1(const Args& A_, Frame& F, int l, int ch) {
    PH_IDS
    const int gw = vcu * 8 + wid, NGW = F.G * 8;
    bf16* H = (bf16*)(F.ws + WS_H);
    f32x4 vn[4]; unsigned long long vb[4];
    if (gw < MC) { const int bl = gw / SB, s = gw - bl * SB, b = ch * BC + bl;
#pragma unroll
        for (int j = 0; j < 4; ++j) { if (l == 0) vn[j] = __builtin_nontemporal_load((const f32x4*)res_in(A_, b, s) + lane + 64 * j); else vb[j] = ((const unsigned long long*)res_xr(F, b, s))[lane + 64 * j]; } }
    for (int row = gw; row < MC; row += NGW) {
        const int bl = row / SB, s = row - bl * SB, b = ch * BC + bl;
        f32x4 v[4];
#pragma unroll
        for (int j = 0; j < 4; ++j) { if (l == 0) v[j] = vn[j]; else { const unsigned long long w = vb[j]; v[j].x = bf2f((unsigned)w & 0xffffu); v[j].y = bf2f(((unsigned)w >> 16)); v[j].z = bf2f((unsigned)(w >> 32) & 0xffffu); v[j].w = bf2f((unsigned)(w >> 48)); } }
        if (row + NGW < MC) { const int r2 = row + NGW, bl2 = r2 / SB, s2 = r2 - bl2 * SB, b2 = ch * BC + bl2;
#pragma unroll
            for (int j = 0; j < 4; ++j) { if (l == 0) vn[j] = __builtin_nontemporal_load((const f32x4*)res_in(A_, b2, s2) + lane + 64 * j); else vb[j] = ((const unsigned long long*)res_xr(F, b2, s2))[lane + 64 * j]; } }
        const float rstd = row_rstd(v, lane);
        const float* mr = mod_row(A_, F, l, b, s);
#pragma unroll
        for (int j = 0; j < 4; ++j) { const f32x4 sh = ((const f32x4*)mr)[lane + 64 * j], c0 = ((const f32x4*)(mr + DMODEL))[lane + 64 * j];
            v[j] = (v[j] * rstd) * c0 + sh; }
        row_store_fp8((unsigned char*)H + (size_t)row * DMODEL, lane, v);
    }
}

__device__ __forceinline__ void ph_prep(const Args& A_, Frame& F, int l) {
    PH_IDS
    const int gw = vcu * 8 + wid, NGW = F.G * 8;
    bf16* P = (bf16*)(F.ws + WS_P);
    const int l7 = lane & 7, kr = lane >> 4, d0 = (l7 & 3) * 8;
    const float sg = (l7 >= 4) ? 1.f : -1.f;
    float gq[8], gk[8], invf[8];
#pragma unroll
    for (int e = 0; e < 8; ++e) { gq[e] = A_.in[I_QNG][l * 64 + l7 * 8 + e] * QSCALE; gk[e] = A_.in[I_KNG][l * 64 + l7 * 8 + e];
        invf[e] = __builtin_amdgcn_exp2f(-(float)((d0 + e) & 15) * (13.287712379549449f / 16.f)) * 0.15915494309189535f; }
    constexpr int NR = 4;
    const int nrw = (MC - gw + NGW - 1) / NGW, ngr = (nrw + NR - 1) / NR;
    v4u qn[NR], kn;
#define PREP_FETCH(g) do { _Pragma("unroll") for (int r = 0; r < NR; ++r) { const int row_ = gw + ((g) * NR + r) * NGW; qn[r] = __builtin_nontemporal_load((const v4u*)(P + (size_t)(row_ < MC ? row_ : gw) * PW + C_GQ + lane * 8)); } \
        { const int row_ = gw + ((g) * NR + kr) * NGW; kn = __builtin_nontemporal_load((const v4u*)(P + (size_t)(row_ < MC ? row_ : gw) * PW + C_GK + (lane & 15) * 8)); } } while (0)
#define PREP_X4(v) DPPF(DPPF((v), 0x141), 0x1B)
#define PREP_DO(w, g_, lat_, t_, out) do { float x_[8]; _Pragma("unroll") for (int k = 0; k < 4; ++k) { x_[2 * k] = bf2f((w)[k] & 0xffffu); x_[2 * k + 1] = __uint_as_float((w)[k] & 0xffff0000u); } \
        float ss_ = 0.f; _Pragma("unroll") for (int e = 0; e < 8; ++e) ss_ += x_[e] * x_[e]; \
        ss_ += DPPF(ss_, 0xB1); ss_ += DPPF(ss_, 0x4E); ss_ += DPPF(ss_, 0x141); \
        const float rs_ = rsqrtf(ss_ * (1.f / 64.f) + EPS); const float pos_ = (float)((d0 < 16) ? ((t_) >> 6) : ((t_) & 63)); float o_[8]; \
        _Pragma("unroll") for (int e = 0; e < 8; ++e) { const float y_ = x_[e] * rs_ * g_[e]; const float yp_ = PREP_X4(y_); \
            const float fr_ = __builtin_amdgcn_fractf(pos_ * invf[e]); const float cs_ = (lat_) ? __builtin_amdgcn_cosf(fr_) : 1.f, sn_ = (lat_) ? __builtin_amdgcn_sinf(fr_) : 0.f; \
            o_[e] = y_ * cs_ + sg * (yp_ * sn_); } \
        out = (v4u){pk2(o_[0], o_[1]), pk2(o_[2], o_[3]), pk2(o_[4], o_[5]), pk2(o_[6], o_[7])}; } while (0)
    PREP_FETCH(0);
    for (int g = 0; g < ngr; ++g) {
        v4u qc[NR], kc = kn;
#pragma unroll
        for (int r = 0; r < NR; ++r) qc[r] = qn[r];
        if (g + 1 < ngr) PREP_FETCH(g + 1);
#pragma unroll
        for (int r = 0; r < NR; ++r) { const int row = gw + (g * NR + r) * NGW;
            if (row < MC) { const int s = row % SB; const bool lat = s >= CTXL; const int t = s - CTXL; v4u o; PREP_DO(qc[r], gq, lat, t, o);
                *(v4u*)(P + (size_t)row * PW + C_GQ + lane * 8) = o; } }
        { const int row = gw + (g * NR + kr) * NGW; const int rc = row < MC ? row : gw; const int s = rc % SB; const bool lat = s >= CTXL; const int t = s - CTXL; v4u o; PREP_DO(kc, gk, lat, t, o);
            if (row < MC) *(v4u*)(P + (size_t)row * PW + C_GK + (lane & 15) * 8) = o; }
    }
#undef PREP_FETCH
#undef PREP_X4
#undef PREP_DO
}
constexpr int LRU_UP = 136;
constexpr int LRU_UB = 64 * LRU_UP * 2, LRU_OP = 144, LRU_OB = 64 * LRU_OP;
constexpr int LRU_U0 = 0, LRU_O0 = 4 * LRU_UB, LRU_CW = LRU_O0 + 4 * LRU_OB;
static_assert(LRU_CW + 640 * 4 <= RING_BYTES, "LRU LDS map");
__device__ __forceinline__ float gelu_tanh(float g) { const float z = 0.7978845608028654f * (g + 0.044715f * g * g * g); return g * (1.f - fast_rcp(1.f + __expf(2.f * z))); }
__device__ __forceinline__ int lru_chunk(int dir, int s) { return dir == 0 ? s : (s < 4 ? 3 - s : 39 - s); }
__device__ __forceinline__ bool lru_first(int s) { return s < 4 ? (s <= 1) : (s <= 19); }
__device__ __forceinline__ void ph_lru(const Args& A_, Frame& F, int l) {
    PH_IDS
    const int fr = lane & 15, fq = lane >> 4, nt = wid & 3, dir = wid >> 2;
    bf16* P = (bf16*)(F.ws + WS_P); bf16* HT = (bf16*)(F.ws + WS_HT); unsigned char* M8 = F.ws + WS_M8;
    const bf16* WL = (const bf16*)(F.ws + WS_W + (size_t)l * LW + W_LRU);
    LAS unsigned char* lds = F.lds;
    LAS float* CW = (LAS float*)(lds + LRU_CW);
    for (int item = blockIdx.x; item < BC * 16; item += F.G) {
        const int bl = item >> 4, cb = item & 15, blk = cb >> 1, half = cb & 1;
        const int cdir = tid >> 8, ctg = (tid >> 4) & 15, cgrp = tid & 15, tb = cdir ? 58 - 4 * ctg : 4 * ctg - 2;
        __syncthreads();
        for (int i = tid; i < 640; i += 512) CW[i] = (i < 512) ? A_.in[I_CONVW][(size_t)(l * 4 + (i >> 7)) * 1024 + blk * 128 + (i & 127)] : A_.in[I_CONVB][l * 1024 + blk * 128 + (i - 512)];
        __syncthreads();
        const int otok = (tid >> 3) & 63, og = tid & 7;
        const int chl = half * 64 + nt * 16 + fr, chan = blk * 128 + chl;
        bf16x8 Bf[2][4];
#pragma unroll
        for (int mat = 0; mat < 2; ++mat)
#pragma unroll
            for (int ks = 0; ks < 4; ++ks) Bf[mat][ks] = *(const bf16x8*)(WL + ((size_t)((dir * 2 + mat) * 8 + blk) * 128 + chl) * 128 + ks * 32 + fq * 8);
        const float ba = A_.in[I_LBA][(l * 2 + dir) * 1024 + chan], bx = A_.in[I_LBX][(l * 2 + dir) * 1024 + chan];
        const float nba = -1.4426950408889634f * ba, nbx = -1.4426950408889634f * bx;
        const float lamc = -8.f * log1pf(__expf(-A_.in[I_LLAM][(l * 2 + dir) * 1024 + chan])) * 1.4426950408889634f;
        float hprev = 0.f;
        bf16x8 xr[7]; unsigned xok = 0u;
#define LRU_LOADX(st) do { const int tc_ = lru_chunk(cdir, (st)); const int seg0_ = (tc_ < 4) ? 0 : CTXL, segl_ = (tc_ < 4) ? CTXL : SEQ, tcl_ = (tc_ < 4) ? tc_ : tc_ - 4; \
            const char* xb_ = (const char*)(P + (size_t)(bl * SB + seg0_) * PW + C_LX + blk * 128);     \
            _Pragma("unroll") for (int i_ = 0; i_ < 7; ++i_) { const int st_ = 64 * tcl_ + tb + i_; const bool ok_ = (unsigned)st_ < (unsigned)segl_; \
                xr[i_] = *(const bf16x8*)(xb_ + ((unsigned)(ok_ ? st_ : 0) * (unsigned)PW + 8u * (unsigned)cgrp) * 2u); xok = ok_ ? (xok | (1u << i_)) : (xok & ~(1u << i_)); } } while (0)
#define LRU_CONV(bufi) do { LAS unsigned char* Uw0_ = lds + LRU_U0 + ((bufi) * 2 + cdir) * LRU_UB + (4 * ctg) * (LRU_UP * 2) + cgrp * 16; unsigned pk_[4][4]; \
            _Pragma("unroll") for (int c2_ = 0; c2_ < 4; ++c2_) { typedef float f2_ __attribute__((ext_vector_type(2))); \
                f2_ w_[5]; _Pragma("unroll") for (int k_ = 0; k_ < 5; ++k_) w_[k_] = *(const LAS f2_*)(CW + k_ * 128 + 8 * cgrp + 2 * c2_); \
                f2_ x_[7]; _Pragma("unroll") for (int i_ = 0; i_ < 7; ++i_) { const unsigned wd_ = __builtin_bit_cast(v4u, xr[i_])[c2_] & (0u - ((xok >> i_) & 1u)); x_[i_] = (f2_){bf2f(wd_ & 0xffffu), __uint_as_float(wd_ & 0xffff0000u)}; } \
                if (cdir == 0) { _Pragma("unroll") for (int j_ = 0; j_ < 4; ++j_) { f2_ a_ = w_[4]; \
                    _Pragma("unroll") for (int k_ = 0; k_ < 4; ++k_) a_ += w_[k_] * x_[j_ + k_]; \
                    pk_[j_][c2_] = pk2(a_.x, a_.y); } } \
                else { _Pragma("unroll") for (int j_ = 0; j_ < 4; ++j_) { f2_ a_ = w_[4]; \
                    _Pragma("unroll") for (int k_ = 0; k_ < 4; ++k_) a_ += w_[k_] * x_[3 - j_ + k_]; \
                    pk_[j_][c2_] = pk2(a_.x, a_.y); } } } \
            _Pragma("unroll") for (int j_ = 0; j_ < 4; ++j_) *(LAS v4u*)(Uw0_ + j_ * (LRU_UP * 2)) = (v4u){pk_[j_][0], pk_[j_][1], pk_[j_][2], pk_[j_][3]}; } while (0)
        LRU_LOADX(0); LRU_CONV(0);
        __syncthreads();
        if (dir == 1) __builtin_amdgcn_s_setprio(1);
#ifndef MK_LRU_SEC
#define MK_LRU_SEC 0
#endif
#define LSEC_B(k) if (MK_LRU_SEC == (k)) { lsec_t0 = __builtin_amdgcn_s_memrealtime(); }
#define LSEC_E(k) if (MK_LRU_SEC == (k)) { lsec_acc += __builtin_amdgcn_s_memrealtime() - lsec_t0; }
        unsigned long long lsec_t0 = 0, lsec_acc = 0;
        for (int s = 0; s <= 36; ++s) {
            const int buf = s & 1;
            LSEC_B(1)
            v4u ohf[2], ogt[2]; const bool ofirst = (s >= 1) ? lru_first(s - 1) : true;
            unsigned orow[2];
#pragma unroll
            for (int i = 0; i < 2; ++i) orow[i] = (unsigned)(bl * SB + 64 * lru_chunk(i, s >= 1 ? s - 1 : 0) + otok);
#define LRU_LOADO() do { if (s >= 1 && !ofirst) { _Pragma("unroll") for (int i = 0; i < 2; ++i) { \
                ohf[i] = __builtin_nontemporal_load((const v4u*)((const char*)HT + (orow[i] * (unsigned)DMODEL + (unsigned)(blk * 128 + half * 64 + og * 8)) * 2u)); \
                ogt[i] = __builtin_nontemporal_load((const v4u*)((const char*)P + (orow[i] * (unsigned)PW + (unsigned)(C_LG + blk * 128 + half * 64 + og * 8)) * 2u)); } } } while (0)
            if (s >= 36) LRU_LOADO();
            if (s + 1 < 36) LRU_LOADX(s + 1);
            LSEC_E(1) LSEC_B(2)
            if (s < 36) {
                const LAS unsigned char* U = lds + LRU_U0 + (buf * 2 + dir) * LRU_UB;
                LAS unsigned char* O = lds + LRU_O0 + (buf * 2 + dir) * LRU_OB;
                float Pa[4][4], Pb[4][4];
#pragma unroll
                for (int m = 0; m < 4; ++m) {
                    f32x4 acc0 = (f32x4){0.f, 0.f, 0.f, 0.f}, acc1 = (f32x4){0.f, 0.f, 0.f, 0.f};
#pragma unroll
                    for (int ks = 0; ks < 4; ++ks) { const bf16x8 Af = *(const LAS bf16x8*)(U + (16 * m + fr) * (LRU_UP * 2) + (ks * 32 + fq * 8) * 2);
                        acc0 = __builtin_amdgcn_mfma_f32_16x16x32_bf16(Af, Bf[0][ks], acc0, 0, 0, 0);
                        acc1 = __builtin_amdgcn_mfma_f32_16x16x32_bf16(Af, Bf[1][ks], acc1, 0, 0, 0); }
                    float A = 1.f, Bv = 0.f;
#pragma unroll
                    for (int j = 0; j < 4; ++j) { const int rho = 16 * m + 4 * fq + j;
                        const float u = bf2f(*(const LAS unsigned short*)(U + rho * (LRU_UP * 2) + chl * 2));
                        const float r = fast_rcp(1.f + __builtin_amdgcn_exp2f(__builtin_fmaf(acc0[j], -1.4426950408889634f, nba))), ig = fast_rcp(1.f + __builtin_amdgcn_exp2f(__builtin_fmaf(acc1[j], -1.4426950408889634f, nbx)));
                        const float a = __builtin_amdgcn_exp2f(lamc * r); const float b = __builtin_amdgcn_sqrtf(fmaxf(1.f - a * a, 0.f)) * (ig * u);
                        Bv = a * Bv + b; A *= a; Pa[m][j] = A; Pb[m][j] = Bv; }
                    asm volatile("" ::: "memory"); }
                LRU_LOADO();
                float EA[4], EB[4], TA[4], TB[4];
                { const bool odd = (fq & 1) != 0, hi = (fq >> 1) != 0;
#pragma unroll
                for (int m = 0; m < 4; ++m) { const float a = Pa[m][3], b = Pb[m][3];
                    const float pa = swap16_get(a, lane), pb = swap16_get(b, lane);
                    const float ptA = a * pa, ptB = odd ? (a * pb + b) : (pa * b + pb);
                    const float oA = swap32_get(ptA, lane), oB = swap32_get(ptB, lane);
                    const float t01A = hi ? oA : ptA, t01B = hi ? oB : ptB, t23A = hi ? ptA : oA, t23B = hi ? ptB : oB;
                    TA[m] = t01A * t23A; TB[m] = t23A * t01B + t23B;
                    const float e1A = odd ? pa : 1.f, e1B = odd ? pb : 0.f;
                    EA[m] = hi ? t01A * e1A : e1A; EB[m] = hi ? (e1A * t01B + e1B) : e1B; } }
                float CA = 1.f, CB = 0.f;
#pragma unroll
                for (int m = 0; m < 4; ++m) {
                    const float GA = EA[m] * CA, GB = EA[m] * CB + EB[m];
                    const float hg = GB + GA * hprev;
#pragma unroll
                    for (int j = 0; j < 4; j += 2) { const unsigned w2 = pk2(Pb[m][j] + Pa[m][j] * hg, Pb[m][j + 1] + Pa[m][j + 1] * hg);
                        const int rho = 16 * m + 4 * fq + j, tok0 = dir ? 63 - rho : rho, tok1 = dir ? tok0 - 1 : tok0 + 1;
                        *(LAS unsigned short*)(O + tok0 * LRU_OP + (nt * 16 + fr) * 2) = (unsigned short)w2; *(LAS unsigned short*)(O + tok1 * LRU_OP + (nt * 16 + fr) * 2) = (unsigned short)(w2 >> 16); }
                    CB = TA[m] * CB + TB[m]; CA = TA[m] * CA; }
                hprev = CB + CA * hprev;
            }
            LSEC_E(2) LSEC_B(3)
            if (s >= 1) {
#pragma unroll
                for (int i = 0; i < 2; ++i) { const v4u hv = *(const LAS v4u*)(lds + LRU_O0 + ((buf ^ 1) * 2 + i) * LRU_OB + otok * LRU_OP + og * 16);
                    if (ofirst) *(v4u*)((char*)HT + (orow[i] * (unsigned)DMODEL + (unsigned)(blk * 128 + half * 64 + og * 8)) * 2u) = hv;
                    else { float y[8];
#pragma unroll
                        for (int e = 0; e < 4; ++e) { const float h0 = bf2f(hv[e] & 0xffffu) + bf2f(ohf[i][e] & 0xffffu), h1 = bf2f(hv[e] >> 16) + bf2f(ohf[i][e] >> 16);
                            y[2 * e] = __builtin_amdgcn_fmed3f(h0 * bf2f(ogt[i][e] & 0xffffu) * M8_SA, -448.f, 448.f); y[2 * e + 1] = __builtin_amdgcn_fmed3f(h1 * bf2f(ogt[i][e] >> 16) * M8_SA, -448.f, 448.f); }
                        typedef unsigned u32x2_ __attribute__((ext_vector_type(2)));
                        *(u32x2_*)(M8 + (orow[i] * 2048u + (unsigned)(blk * 128 + half * 64 + og * 8))) = (u32x2_){pk4_fp8(y[0], y[1], y[2], y[3]), pk4_fp8(y[4], y[5], y[6], y[7])}; } }
            }
            LSEC_E(3) LSEC_B(4)
            if (s + 1 < 36) LRU_CONV(buf ^ 1);
            LSEC_E(4) LSEC_B(5)
            if (s == 2 || s == 20) VM_WAIT();
            asm volatile("s_waitcnt lgkmcnt(0)\n\ts_barrier" ::: "memory");
            LSEC_E(5)
        }
#undef LRU_LOADX
#undef LRU_LOADO
        __builtin_amdgcn_s_setprio(0);
        if (MK_LRU_SEC != 0) { const unsigned long long te_ = __builtin_amdgcn_s_memrealtime() + 3ull * lsec_acc; while (__builtin_amdgcn_s_memrealtime() < te_) __builtin_amdgcn_s_sleep(8); }
#undef LRU_CONV
    }
}

__device__ __forceinline__ void ph_attn(const Args& A_, Frame& F, int l, char* lds_generic) {
    PH_IDS
    using abf = attn_body::bf16;
    abf* P = (abf*)(F.ws + WS_P); unsigned char* M8 = F.ws + WS_M8;
    const int ndense = BC * 64 + (l == 0 ? BC * 16 : 0), nna = BC * 64;
    const int cd = (vcu < ndense) ? (ndense - vcu + F.G - 1) / F.G : 0, cn = (vcu < nna) ? (nna - vcu + F.G - 1) / F.G : 0;
    struct Desc { const abf *Q0, *Kh, *Vh; unsigned char* O8; int NT, R0w, nar0, h, mode; };
    auto desc = [&](int i, Desc& d) {
        if (i < cd) { const int v = vcu + i * F.G; d.mode = 0; d.R0w = 0; d.nar0 = 0; d.h = 0;
            if (v < BC * 64) { const int u = v;
                const int qb = ((u & 7) + 2 * (u >> 8)) & 7, rest = ((u >> 3) & 31) + 32 * (u >> 8), bl = rest >> 3, h = rest & 7;
                d.Q0 = P + (size_t)(bl * SB + CTXL + 256 * qb) * PW + C_GQ + h * 64; d.Kh = P + (size_t)(bl * SB) * PW + C_GK + (h >> 2) * 64; d.Vh = d.Kh + (C_GV - C_GK); d.NT = SB / 64;
                d.O8 = M8 + (size_t)(bl * SB + CTXL + 256 * qb) * 2048 + 1536 + h * 64; }
            else { const int u = v - BC * 64; const int kind = u / (BC * 8), idx = u % (BC * 8), bl = idx >> 3, h = idx & 7;
                if (kind == 0) { d.Q0 = P + (size_t)(bl * SB) * PW + C_GQ + h * 64; d.Kh = P + (size_t)(bl * SB) * PW + C_GK + (h >> 2) * 64; d.Vh = d.Kh + (C_GV - C_GK); d.O8 = M8 + (size_t)(bl * SB) * 2048 + 1536 + h * 64; }
                else { d.Q0 = P + (size_t)(bl * SB) * PW + C_NQ + h * 64; d.Kh = P + (size_t)(bl * SB) * PW + C_NK + h * 64; d.Vh = d.Kh + (C_NV - C_NK); d.O8 = M8 + (size_t)(bl * SB) * 2048 + 1024 + h * 64; }
                d.NT = CTXL / 64; } }
        else { const int u = vcu + (i - cd) * F.G; d.mode = 1;
            const int qb = ((u & 7) + 2 * (u >> 8)) & 7, rest = ((u >> 3) & 31) + 32 * (u >> 8), bl = rest >> 3, h = rest & 7;
            d.Q0 = P + (size_t)(bl * SB + CTXL + 256 * qb) * PW + C_NQ + h * 64; d.Kh = P + (size_t)(bl * SB) * PW + C_NK + h * 64; d.Vh = d.Kh + (C_NV - C_NK);
            d.NT = 4 + ((qb == 0 || qb == 7) ? 8 : 12); d.R0w = (qb == 0) ? 0 : 4 * qb - 4; d.nar0 = 4 * qb; d.h = h;
            d.O8 = M8 + (size_t)(bl * SB + CTXL + 256 * qb) * 2048 + 1024 + h * 64; } };
    int htab = -1;
    bool pre = false;
    for (int i = 0; i < cd + cn; ++i) {
        Desc cur; desc(i, cur);
        const bool hn = i + 1 < cd + cn; const abf* nQ0 = nullptr; const abf* nKh = nullptr;
        const abf* nVh = nullptr;
        if (hn) { Desc nx; desc(i + 1, nx); nQ0 = nx.Q0; nKh = nx.Kh; nVh = nx.Vh; }
        if (cur.mode == 0) attn_body::attn_unit<8, 0>(cur.Q0, cur.Kh, cur.Vh, cur.O8, cur.NT, 0, 0, nullptr, lds_generic, pre, nQ0, nKh, nVh);
        else {
            if (cur.h != htab) { __syncthreads(); attn_body::na_fill_table(A_.in[I_RPB] + (size_t)(l * 8 + cur.h) * 15 * 31, lds_generic); __syncthreads(); htab = cur.h; }
            attn_body::attn_unit<8, 1>(cur.Q0, cur.Kh, cur.Vh, cur.O8, cur.NT, cur.R0w, cur.nar0, nullptr, lds_generic, pre, nQ0, nKh, nVh); }
        pre = hn;
    }
}

struct TileMap {
    int nM, nN, nwg, G, c;
    __device__ __forceinline__ void init(int nM_, int nN_, int G_, int c_) { nM = nM_; nN = nN_; nwg = nM_ * nN_; G = G_; c = c_; }
    __device__ __forceinline__ bool get(int i, int& pm, int& pn) const { return getL((long)i * G + c, pm, pn); }
    __device__ __forceinline__ bool getL(long L, int& pm, int& pn) const {
        if (L >= nwg) return false;
        int wgid = (int)L; { const int q = nwg / 8, r = nwg % 8, xcd = wgid % 8, off = wgid / 8; wgid = (xcd < r ? xcd * (q + 1) : r * (q + 1) + (xcd - r) * q) + off; }
        const int nig = 8 * nN, gid = wgid / nig, fm = gid * 8, gsz = (nM - fm) < 8 ? (nM - fm) : 8;
        pm = fm + ((wgid % nig) % gsz); pn = (wgid % nig) / gsz; return true;
    }
};
struct SchedPlain {
    TileMap T; const char* A; const char* B; size_t astep, bstep; bool skipctx;
    __device__ __forceinline__ bool next(int i, pg8::Unit& u) const { int pm, pn; if (!T.get(i, pm, pn)) return false; if (skipctx) pm = (pm >> 3) * 9 + 1 + (pm & 7);
        u.pm = pm; u.pn = pn; u.A = A + (size_t)pm * astep; u.B = B + (size_t)pn * bstep; return true; }
    __device__ __forceinline__ void a_ready(const pg8::Unit&) const {}
    __device__ __forceinline__ void done(const pg8::Unit&) const {}
};
struct SchedG1 {
    TileMap T1, T2; const char* A; const char* B; bool last;
    __device__ __forceinline__ void init(bool last_, int G, int c) { last = last_; if (last_) { T1.init(BC * 8, NPROJ / 256, G, c); T2.init(BC, 9, G, c); } else { T1.init(MC / 256, NPROJ / 256, G, c); T2.init(0, 9, G, c); } }
    __device__ __forceinline__ bool next(int i, pg8::Unit& u) const { int pm, pn; const long L = (long)i * T1.G + T1.c;
        if (L < T1.nwg) { T1.getL(L, pm, pn); if (last) pm = (pm >> 3) * 9 + 1 + (pm & 7); }
        else { if (!T2.getL(L - T1.nwg, pm, pn)) return false; pm = pm * 9; pn = (pn < 4) ? pn : 8 + pn; }
        u.pm = pm; u.pn = pn; u.A = A + (size_t)pm * (256 * 1024); u.B = B + (size_t)pn * (256 * 1024); return true; }
    __device__ __forceinline__ void a_ready(const pg8::Unit&) const {}
    __device__ __forceinline__ void done(const pg8::Unit&) const {}
};
struct EpiG1 {
    static constexpr bool PERM = true, AFTER_DRAIN = false;
    bf16* O; unsigned char* G8;
    __device__ __forceinline__ void operator()(const pg8::f32x4 (&acc)[2][2][4][2], const pg8::Unit& u, int wr, int wc, int fr, int fq) const {
        int row0 = u.pm * 256 + wr * 64 + fr, col0 = u.pn * 256 + wc * 32 + 8 * fq; asm volatile("" : "+v"(row0), "+v"(col0));
        if (u.pn >= PW / 256) {
            const int gt = u.pn - PW / 256;
            unsigned char* tb = G8 + ((size_t)((gt >> 2) * (MC / 256) + u.pm) * 4 + (gt & 3)) * 65536 + ((wr * 4 + wc) * 8192 + (fq * 16 + fr) * 16);
#pragma unroll
            for (int ai = 0; ai < 2; ++ai)
#pragma unroll
                for (int m = 0; m < 4; ++m) {
#define G1_E4(v_) pk4_fp8(fminf(__builtin_amdgcn_exp2f((v_)[0] * -1.4426950408889634f), 448.f), fminf(__builtin_amdgcn_exp2f((v_)[1] * -1.4426950408889634f), 448.f), fminf(__builtin_amdgcn_exp2f((v_)[2] * -1.4426950408889634f), 448.f), fminf(__builtin_amdgcn_exp2f((v_)[3] * -1.4426950408889634f), 448.f))
                    __builtin_nontemporal_store((v4u){G1_E4(acc[ai][0][m][0]), G1_E4(acc[ai][0][m][1]), G1_E4(acc[ai][1][m][0]), G1_E4(acc[ai][1][m][1])}, (v4u*)(tb + (ai * 4 + m) * 1024)); }
#undef G1_E4
            return; }
        const bool gl = (u.pn >= C_LG / 256 && u.pn < C_NQ / 256);
#pragma unroll
        for (int ai = 0; ai < 2; ++ai)
#pragma unroll
            for (int m = 0; m < 4; ++m) { bf16* rowp = O + (size_t)(row0 + ai * 128 + m * 16) * PW + col0;
#pragma unroll
                for (int bj = 0; bj < 2; ++bj) { float o[8];
#pragma unroll
                    for (int e = 0; e < 8; ++e) { const float v = acc[ai][bj][m][e >> 2][e & 3]; o[e] = gl ? gelu_tanh(v) : v; }
                    *(v4u*)(rowp + bj * 128) = (v4u){pk2(o[0], o[1]), pk2(o[2], o[3]), pk2(o[4], o[5]), pk2(o[6], o[7])}; } }
    }
};
struct SchedMoe {
    TileMap T; const char* A; const char* B; size_t astep, bstep, estep; const int* gidx;
    __device__ __forceinline__ bool next(int i, pg8::Unit& u) const { int pm, pn; if (!T.get(i, pm, pn)) return false;
        const int e = (pm < NE * BC) ? pm / BC : (pm - NE * BC) / (BC / 8);
        u.pm = pm; u.pn = pn; u.A = A + (size_t)pm * astep; u.B = B + (size_t)e * estep + (size_t)pn * bstep; u.gidx = gidx ? gidx + (size_t)pm * 256 : nullptr; return true; }
    __device__ __forceinline__ void a_ready(const pg8::Unit&) const {}
    __device__ __forceinline__ void done(const pg8::Unit&) const {}
};
struct EpiMerge {
    static constexpr bool PERM = true, AFTER_DRAIN = false; static constexpr int HOOK_T0 = 8, HOOK_T1 = 12;
    const unsigned char* G8; unsigned char* O;
    typedef unsigned u32x2_ __attribute__((ext_vector_type(2)));
    static __device__ __forceinline__ void f8x8(const u32x2_ w, float (&o)[8]) {
        const auto a = __builtin_amdgcn_cvt_pk_f32_fp8((int)w[0], false), b = __builtin_amdgcn_cvt_pk_f32_fp8((int)w[0], true), c = __builtin_amdgcn_cvt_pk_f32_fp8((int)w[1], false), d = __builtin_amdgcn_cvt_pk_f32_fp8((int)w[1], true);
        o[0] = a[0]; o[1] = a[1]; o[2] = b[0]; o[3] = b[1]; o[4] = c[0]; o[5] = c[1]; o[6] = d[0]; o[7] = d[1]; }
    __device__ __forceinline__ void khook(pg8::f32x4 (&acc)[2][2][4][2], const pg8::Unit& u, int t, int wr, int wc, int fr, int fq) const {
        const int bn = (t == HOOK_T0) ? 0 : 1; const float kf = (t == HOOK_T0) ? (M8_SB / M8_SA) : 1.f;
        int loff = (wr * 4 + wc) * 8192 + (fq * 16 + fr) * 16; asm volatile("" : "+v"(loff));
        const unsigned char* tn = G8 + ((size_t)(bn * (MC / 256) + u.pm) * 4 + u.pn) * 65536 + loff; const unsigned char* td = tn + (size_t)(MC / 256) * 4 * 65536;
        v4u gn[2][4], gd[2][4];
#pragma unroll
        for (int ai = 0; ai < 2; ++ai)
#pragma unroll
            for (int m = 0; m < 4; ++m) { gn[ai][m] = __builtin_nontemporal_load((const v4u*)(tn + (ai * 4 + m) * 1024)); gd[ai][m] = __builtin_nontemporal_load((const v4u*)(td + (ai * 4 + m) * 1024)); }
#pragma unroll
        for (int ai = 0; ai < 2; ++ai) {
#pragma unroll
            for (int m = 0; m < 4; ++m)
#pragma unroll
                for (int bj = 0; bj < 2; ++bj)
                    { float ln[8], ld[8]; f8x8((u32x2_){gn[ai][m][2 * bj], gn[ai][m][2 * bj + 1]}, ln); f8x8((u32x2_){gd[ai][m][2 * bj], gd[ai][m][2 * bj + 1]}, ld);
#pragma unroll
                    for (int e = 0; e < 8; ++e) acc[ai][bj][m][e >> 2][e & 3] *= (kf + kf * ld[e]) * fast_rcp(1.f + ln[e]); }
            asm volatile("" ::: "memory"); }
    }
    __device__ __forceinline__ void operator()(const pg8::f32x4 (&acc)[2][2][4][2], const pg8::Unit& u, int wr, int wc, int fr, int fq) const {
        int row0 = u.pm * 256 + wr * 64 + fr, col0 = u.pn * 256 + wc * 32 + 8 * fq; asm volatile("" : "+v"(row0), "+v"(col0));
        int loff = (wr * 4 + wc) * 8192 + (fq * 16 + fr) * 16; asm volatile("" : "+v"(loff));
        const unsigned char* tc = G8 + ((size_t)(2 * (MC / 256) + u.pm) * 4 + u.pn) * 65536 + loff;
        v4u gc[2][4];
#pragma unroll
        for (int ai = 0; ai < 2; ++ai)
#pragma unroll
            for (int m = 0; m < 4; ++m) gc[ai][m] = __builtin_nontemporal_load((const v4u*)(tc + (ai * 4 + m) * 1024));
#pragma unroll
        for (int ai = 0; ai < 2; ++ai) {
#pragma unroll
            for (int m = 0; m < 4; ++m) { const size_t r = (size_t)(row0 + ai * 128 + m * 16);
#pragma unroll
                for (int bj = 0; bj < 2; ++bj) { float o[8], lc[8]; f8x8((u32x2_){gc[ai][m][2 * bj], gc[ai][m][2 * bj + 1]}, lc);
#pragma unroll
                    for (int e = 0; e < 8; ++e) o[e] = __builtin_amdgcn_fmed3f(acc[ai][bj][m][e >> 2][e & 3] * fast_rcp((M8_SB / MQ_S) + (M8_SB / MQ_S) * lc[e]), -448.f, 448.f);
                    *(u32x2_*)(O + r * DMODEL + col0 + bj * 128) = (u32x2_){pk4_fp8(o[0], o[1], o[2], o[3]), pk4_fp8(o[4], o[5], o[6], o[7])}; } }
            asm volatile("" ::: "memory"); }
    }
};
struct EpiSwiglu {
    static constexpr bool PERM = true, AFTER_DRAIN = false;
    unsigned char* O;
    __device__ __forceinline__ void operator()(const pg8::f32x4 (&acc)[2][2][4][2], const pg8::Unit& u, int wr, int wc, int fr, int fq) const {
        int row0 = u.pm * 256 + wr * 64 + fr, col0 = u.pn * 128 + wc * 32 + 8 * fq; asm volatile("" : "+v"(row0), "+v"(col0));
#pragma unroll
        for (int ai = 0; ai < 2; ++ai)
#pragma unroll
            for (int m = 0; m < 4; ++m) { float o[8];
#pragma unroll
                for (int e = 0; e < 8; ++e) { const float g = acc[ai][0][m][e >> 2][e & 3], up = acc[ai][1][m][e >> 2][e & 3]; o[e] = g * sigmoidf_(g) * up; }
                typedef unsigned u32x2_ __attribute__((ext_vector_type(2)));
                *(u32x2_*)(O + (size_t)(row0 + ai * 128 + m * 16) * DMODEL + col0) = (u32x2_){pk4_fp8(o[0], o[1], o[2], o[3]), pk4_fp8(o[4], o[5], o[6], o[7])}; }
    }
};

__device__ __forceinline__ void ph_norm2(const Args& A_, Frame& F, int l, int ch) {
    PH_IDS
    const int gw = vcu * 8 + wid, NGW = F.G * 8;
    LAS f32x4* WR = (LAS f32x4*)F.lds;
    __syncthreads();
    for (int i = tid; i < 4096; i += 512) { const int k = i >> 2, q = i & 3; const int slot = ((k >> 2) & 63) + 64 * ((k & 3) + 4 * (k >> 8));
        WR[q * 1024 + slot] = *(const f32x4*)(A_.in[I_WR] + (size_t)l * DMODEL * NE + k * NE + q * 4); }
    __syncthreads();
    const bf16* O1 = (const bf16*)(F.ws + WS_O1); bf16* H = (bf16*)(F.ws + WS_H);
    float* affen = (float*)(F.ws + WS_AFFEN); float* affne = (float*)(F.ws + WS_AFFNE);
    const int nrows = (l == 0) ? MC : BC * SEQ;
#define N2_ROW(idx) ((l == 0) ? (idx) : ((idx) / SEQ) * SB + CTXL + ((idx) % SEQ))
    unsigned long long on[2][4], xb[2][4]; f32x4 xn[2][4];
#define N2_FETCH(base) do { _Pragma("unroll") for (int rr = 0; rr < 2; ++rr) { const int i2_ = ((base) + rr * NGW < nrows) ? (base) + rr * NGW : (base); const int row_ = N2_ROW(i2_), bl_ = row_ / SB, s_ = row_ - bl_ * SB; \
            _Pragma("unroll") for (int j = 0; j < 4; ++j) { on[rr][j] = __builtin_nontemporal_load((const unsigned long long*)(O1 + (size_t)row_ * DMODEL) + lane + 64 * j); \
                if (l == 0) xn[rr][j] = __builtin_nontemporal_load((const f32x4*)res_in(A_, ch * BC + bl_, s_) + lane + 64 * j); else xb[rr][j] = __builtin_nontemporal_load((const unsigned long long*)res_xr(F, ch * BC + bl_, s_) + lane + 64 * j); } } } while (0)
    if (gw < nrows) N2_FETCH(gw);
#ifndef MK_N2_SEC
#define MK_N2_SEC 0
#endif
#define NSEC_B(k) if (MK_N2_SEC == (k)) { nsec_t0 = __builtin_amdgcn_s_memrealtime(); }
#define NSEC_E(k) if (MK_N2_SEC == (k)) { nsec_acc += __builtin_amdgcn_s_memrealtime() - nsec_t0; }
    unsigned long long nsec_t0 = 0, nsec_acc = 0;
    for (int idx = gw; idx < nrows; idx += 2 * NGW) {
        NSEC_B(1)
        int row[2], bl[2], s[2], b[2]; bool ok[2];
#pragma unroll
        for (int rr = 0; rr < 2; ++rr) { ok[rr] = idx + rr * NGW < nrows; row[rr] = N2_ROW(ok[rr] ? idx + rr * NGW : idx); bl[rr] = row[rr] / SB; s[rr] = row[rr] - bl[rr] * SB; b[rr] = ch * BC + bl[rr]; }
        f32x4 o[2][4], x[2][4];
#pragma unroll
        for (int rr = 0; rr < 2; ++rr)
#pragma unroll
            for (int j = 0; j < 4; ++j) { const unsigned long long w = on[rr][j];
                o[rr][j].x = bf2f((unsigned)w & 0xffffu); o[rr][j].y = bf2f(((unsigned)w >> 16)); o[rr][j].z = bf2f((unsigned)(w >> 32) & 0xffffu); o[rr][j].w = bf2f((unsigned)(w >> 48));
                if (l == 0) x[rr][j] = xn[rr][j]; else { const unsigned long long q = xb[rr][j]; x[rr][j].x = bf2f((unsigned)q & 0xffffu); x[rr][j].y = bf2f(((unsigned)q >> 16)); x[rr][j].z = bf2f((unsigned)(q >> 32) & 0xffffu); x[rr][j].w = bf2f((unsigned)(q >> 48)); } }
        if (idx + 2 * NGW < nrows) N2_FETCH(idx + 2 * NGW);
        NSEC_E(1) NSEC_B(2)
        const float* mr[2]; float rs1[2], rs2[2];
#pragma unroll
        for (int rr = 0; rr < 2; ++rr) { mr[rr] = mod_row(A_, F, l, b[rr], s[rr]); rs1[rr] = row_rstd(o[rr], lane); }
#pragma unroll
        for (int rr = 0; rr < 2; ++rr) {
#pragma unroll
            for (int j = 0; j < 4; ++j) { const f32x4 c1 = ((const f32x4*)(mr[rr] + 2 * DMODEL))[lane + 64 * j]; x[rr][j] = x[rr][j] + c1 * (o[rr][j] * rs1[rr]); }
            if (ok[rr]) row_store_bf16(res_xr(F, b[rr], s[rr]), lane, x[rr]); }
#pragma unroll
        for (int rr = 0; rr < 2; ++rr) rs2[rr] = row_rstd(x[rr], lane);
#pragma unroll
        for (int rr = 0; rr < 2; ++rr) {
#pragma unroll
            for (int j = 0; j < 4; ++j) { const f32x4 sh = ((const f32x4*)(mr[rr] + 3 * DMODEL))[lane + 64 * j], c2 = ((const f32x4*)(mr[rr] + 4 * DMODEL))[lane + 64 * j];
                x[rr][j] = (x[rr][j] * rs2[rr]) * c2 + sh; }
            if (ok[rr]) row_store_fp8((unsigned char*)H + (size_t)row[rr] * DMODEL, lane, x[rr]); }
        NSEC_E(2) NSEC_B(3)
        float v[2][16];
#pragma unroll
        for (int rr = 0; rr < 2; ++rr)
#pragma unroll
            for (int e = 0; e < 16; ++e) v[rr][e] = 0.f;
#pragma unroll
        for (int j = 0; j < 4; ++j)
#pragma unroll
            for (int i = 0; i < 4; ++i) { const int slot = lane + 64 * (i + 4 * j);
#pragma unroll
                for (int q = 0; q < 4; ++q) { const f32x4 w = WR[q * 1024 + slot];
#pragma unroll
                    for (int rr = 0; rr < 2; ++rr) { const float xv = x[rr][j][i]; v[rr][4 * q] += xv * w.x; v[rr][4 * q + 1] += xv * w.y; v[rr][4 * q + 2] += xv * w.z; v[rr][4 * q + 3] += xv * w.w; } }
                if (i & 1) asm volatile("" ::: "memory"); }
        NSEC_E(3) NSEC_B(4)
        const int e = ((lane >> 5) & 1) * 8 + ((lane >> 4) & 1) * 4 + ((lane >> 3) & 1) * 2 + ((lane >> 2) & 1);
#pragma unroll
        for (int rr = 0; rr < 2; ++rr) {
#pragma unroll
            for (int e2 = 0; e2 < 8; ++e2) { const bool up = (lane & 32) != 0; const float snd = up ? v[rr][e2] : v[rr][e2 + 8], kp = up ? v[rr][e2 + 8] : v[rr][e2]; v[rr][e2] = kp + swap32_get(snd, lane); }
#pragma unroll
            for (int e2 = 0; e2 < 4; ++e2) { const bool up = (lane & 16) != 0; const float snd = up ? v[rr][e2] : v[rr][e2 + 4], kp = up ? v[rr][e2 + 4] : v[rr][e2]; v[rr][e2] = kp + swap16_get(snd, lane); }
#pragma unroll
            for (int e2 = 0; e2 < 2; ++e2) { const bool up = (lane & 8) != 0; const float snd = up ? v[rr][e2] : v[rr][e2 + 2], kp = up ? v[rr][e2 + 2] : v[rr][e2]; v[rr][e2] = kp + shx(snd, 8, lane); }
            { const bool up = (lane & 4) != 0; const float snd = up ? v[rr][0] : v[rr][1], kp = up ? v[rr][1] : v[rr][0]; v[rr][0] = kp + shx(snd, 4, lane); } }
#pragma unroll
        for (int rr = 0; rr < 2; ++rr) {
            float lg = v[rr][0]; lg += DPPF(lg, 0x4E); lg += DPPF(lg, 0xB1);
            float mx = lg;
            mx = fmaxf(mx, DPPF(mx, 0x141)); mx = fmaxf(mx, DPPF(mx, 0x140)); mx = fmaxf(mx, swap16_get(mx, lane)); mx = fmaxf(mx, swap32_get(mx, lane));
            const float ex = __expf(lg - mx); float sm = ex;
            sm += DPPF(sm, 0x141); sm += DPPF(sm, 0x140); sm = swap32_sum(swap16_sum(sm));
            const float aff = ex / sm;
            if (ok[rr] && (lane & 3) == 0) { affen[(size_t)(bl[rr] * NE + e) * SB + s[rr]] = aff; affne[(size_t)row[rr] * NE + e] = aff; } }
        NSEC_E(4)
    }
#undef N2_FETCH
    if (MK_N2_SEC != 0) { const unsigned long long te_ = __builtin_amdgcn_s_memrealtime() + 3ull * nsec_acc; while (__builtin_amdgcn_s_memrealtime() < te_) __builtin_amdgcn_s_sleep(8); }
#undef N2_ROW
}

__device__ __forceinline__ unsigned topk_scan32(unsigned v, int lane) {
    unsigned s = v;
#pragma unroll
    for (int o = 1; o < 32; o <<= 1) { const unsigned t = (unsigned)__builtin_amdgcn_ds_bpermute(((lane - o) & 63) << 2, (int)s); if (lane >= o) s += t; }
    return s - v;
}
__device__ __forceinline__ void ph_topk(const Args& A_, Frame& F, int l) {
    PH_IDS
    LAS unsigned* HIST = (LAS unsigned*)F.lds;
    LAS unsigned* CW = HIST + 256;
    LAS unsigned* WT = HIST + 272;
    const float* affen = (const float*)(F.ws + WS_AFFEN); int* slot_of = (int*)(F.ws + WS_SLOT);
    int* rowidx = (int*)(F.ws + WS_ROWIDX);
    const int nitems = (l == 0) ? 2 * BC * NE : BC * NE;
    for (int item = blockIdx.x; item < nitems; item += F.G) {
        const int set = item / (BC * NE), ie = item % (BC * NE), bl = ie / NE, e = ie % NE;
        const int n = set ? CTXL : SEQ, cap = n / 8, seg0 = set ? 0 : CTXL;
        unsigned key[4]; bool valid[4];
#pragma unroll
        for (int j = 0; j < 4; ++j) { const int idx = tid + 512 * j; valid[j] = idx < n; key[j] = valid[j] ? __float_as_uint(affen[(size_t)(bl * NE + e) * SB + seg0 + idx]) : 0u; }
        unsigned prefix = 0u, need = (unsigned)cap;
#pragma unroll 1
        for (int pass = 0; pass < 4; ++pass) { const int shift = 24 - 8 * pass;
            __syncthreads();
            if (tid < 256) HIST[tid] = 0u;
            __syncthreads();
#pragma unroll
            for (int j = 0; j < 4; ++j) if (valid[j] && (pass == 0 || (key[j] >> (shift + 8)) == prefix)) atomicAdd((unsigned*)&HIST[(key[j] >> shift) & 255u], 1u);
            __syncthreads();
            if (wid == 0) {
                unsigned c[4];
#pragma unroll
                for (int b = 0; b < 4; ++b) c[b] = HIST[4 * lane + b];
                const unsigned s = (c[0] + c[1]) + (c[2] + c[3]); unsigned S = s;
#pragma unroll
                for (int o = 1; o < 64; o <<= 1) { const unsigned t = (unsigned)__builtin_amdgcn_ds_bpermute(((lane + o) & 63) << 2, (int)S); if (lane + o < 64) S += t; }
                unsigned cum = S - s;
#pragma unroll
                for (int b = 3; b >= 0; --b) { if (cum < need && cum + c[b] >= need) { CW[0] = (prefix << 8) | (unsigned)(4 * lane + b); CW[1] = need - cum; } cum += c[b]; }
            }
            __syncthreads();
            prefix = CW[0]; need = CW[1];
        }
        const unsigned T = prefix, need_eq = need;
        unsigned rk[4];
#pragma unroll
        for (int j = 0; j < 4; ++j) { const bool eq = valid[j] && key[j] == T; const unsigned long long bm = __builtin_amdgcn_ballot_w64(eq);
            rk[j] = __builtin_amdgcn_mbcnt_hi((unsigned)(bm >> 32), __builtin_amdgcn_mbcnt_lo((unsigned)bm, 0u)); if (lane == 0) WT[j * 8 + wid] = (unsigned)__builtin_popcountll(bm); }
        __syncthreads();
        if (wid == 0) { const unsigned v = (lane < 32) ? WT[lane] : 0u; const unsigned p = topk_scan32(v, lane); if (lane < 32) WT[lane] = p; }
        __syncthreads();
        bool sel[4];
#pragma unroll
        for (int j = 0; j < 4; ++j) { const unsigned r = rk[j] + WT[j * 8 + wid]; sel[j] = valid[j] && (key[j] > T || (key[j] == T && r < need_eq)); }
        __syncthreads();
#pragma unroll
        for (int j = 0; j < 4; ++j) { const unsigned long long bm = __builtin_amdgcn_ballot_w64(sel[j]);
            rk[j] = __builtin_amdgcn_mbcnt_hi((unsigned)(bm >> 32), __builtin_amdgcn_mbcnt_lo((unsigned)bm, 0u)); if (lane == 0) WT[j * 8 + wid] = (unsigned)__builtin_popcountll(bm); }
        __syncthreads();
        if (wid == 0) { const unsigned v = (lane < 32) ? WT[lane] : 0u; const unsigned p = topk_scan32(v, lane); if (lane < 32) WT[lane] = p; }
        __syncthreads();
        const int dst0 = set ? (NE * BC) * 256 + (e * BC + bl) * 32 : (e * BC + bl) * 256;
#pragma unroll
        for (int j = 0; j < 4; ++j) if (valid[j]) { const int p = (int)(rk[j] + WT[j * 8 + wid]); const int row = bl * SB + seg0 + tid + 512 * j;
            slot_of[(size_t)row * NE + e] = sel[j] ? dst0 + p : -1; if (sel[j]) rowidx[dst0 + p] = row; }
    }
}

__device__ __forceinline__ void ph_combine(const Args& A_, Frame& F, int l, int ch) {
    PH_IDS
    const int gw = vcu * 8 + wid, NGW = F.G * 8;
    const bf16* Y = (const bf16*)(F.ws + WS_HS); const float* affne = (const float*)(F.ws + WS_AFFNE); const int* slot_of = (const int*)(F.ws + WS_SLOT);
    const int nrows = (l == 0) ? MC : BC * SEQ;
#define CB_ROW(idx) ((l == 0) ? (idx) : ((idx) / SEQ) * SB + CTXL + ((idx) % SEQ))
    int sln = -1; float afn = 0.f; unsigned long long xn[4];
    if (gw < nrows) { const int row = CB_ROW(gw), bl = row / SB, s = row - bl * SB; sln = slot_of[(size_t)row * NE + (lane & 15)]; afn = affne[(size_t)row * NE + (lane & 15)];
#pragma unroll
        for (int j = 0; j < 4; ++j) xn[j] = __builtin_nontemporal_load((const unsigned long long*)res_xr(F, ch * BC + bl, s) + lane + 64 * j); }
    for (int idx = gw; idx < nrows; idx += NGW) {
        const int row = CB_ROW(idx), bl = row / SB, s = row - bl * SB, b = ch * BC + bl;
        const int sl = sln; const float af = afn; unsigned long long xq[4];
#pragma unroll
        for (int j = 0; j < 4; ++j) xq[j] = xn[j];
        if (idx + NGW < nrows) { const int row2 = CB_ROW(idx + NGW), bl2 = row2 / SB, s2 = row2 - bl2 * SB; sln = slot_of[(size_t)row2 * NE + (lane & 15)]; afn = affne[(size_t)row2 * NE + (lane & 15)];
#pragma unroll
            for (int j = 0; j < 4; ++j) xn[j] = __builtin_nontemporal_load((const unsigned long long*)res_xr(F, ch * BC + bl2, s2) + lane + 64 * j); }
        f32x4 acc[4];
#pragma unroll
        for (int j = 0; j < 4; ++j) acc[j] = (f32x4){0.f, 0.f, 0.f, 0.f};
        unsigned em = (unsigned)__builtin_amdgcn_ballot_w64(sl >= 0) & 0xffffu;
        while (em) {
            const int e0 = __builtin_ctz(em); em &= em - 1u; const bool two = em != 0u; const int e1 = two ? __builtin_ctz(em) : e0; em &= em - 1u;
            const int s0 = __builtin_amdgcn_readlane(sl, e0), s1 = __builtin_amdgcn_readlane(sl, e1);
            const float a0 = __builtin_bit_cast(float, __builtin_amdgcn_readlane(__builtin_bit_cast(int, af), e0)), a1 = two ? __builtin_bit_cast(float, __builtin_amdgcn_readlane(__builtin_bit_cast(int, af), e1)) : 0.f;
            unsigned long long y0[4], y1[4];
#pragma unroll
            for (int j = 0; j < 4; ++j) y0[j] = __builtin_nontemporal_load((const unsigned long long*)(Y + (size_t)s0 * DMODEL) + lane + 64 * j);
            if (two) {
#pragma unroll
                for (int j = 0; j < 4; ++j) y1[j] = __builtin_nontemporal_load((const unsigned long long*)(Y + (size_t)s1 * DMODEL) + lane + 64 * j); }
            else {
#pragma unroll
                for (int j = 0; j < 4; ++j) y1[j] = 0ull; }
#pragma unroll
            for (int j = 0; j < 4; ++j) { const unsigned long long w = y0[j], q = y1[j];
                acc[j].x += bf2f((unsigned)w & 0xffffu) * a0; acc[j].y += bf2f((unsigned)w >> 16) * a0; acc[j].z += bf2f((unsigned)(w >> 32) & 0xffffu) * a0; acc[j].w += bf2f((unsigned)(w >> 48)) * a0;
                acc[j].x += bf2f((unsigned)q & 0xffffu) * a1; acc[j].y += bf2f((unsigned)q >> 16) * a1; acc[j].z += bf2f((unsigned)(q >> 32) & 0xffffu) * a1; acc[j].w += bf2f((unsigned)(q >> 48)) * a1; }
        }
        bf16* xr = res_xr(F, b, s);
        f32x4 x[4];
#pragma unroll
        for (int j = 0; j < 4; ++j) { const unsigned long long w = xq[j]; x[j].x = bf2f((unsigned)w & 0xffffu); x[j].y = bf2f(((unsigned)w >> 16)); x[j].z = bf2f((unsigned)(w >> 32) & 0xffffu); x[j].w = bf2f((unsigned)(w >> 48)); }
        const float rs = row_rstd(acc, lane); const float* mr = mod_row(A_, F, l, b, s);
#pragma unroll
        for (int j = 0; j < 4; ++j) { const f32x4 c3 = ((const f32x4*)(mr + 5 * DMODEL))[lane + 64 * j]; x[j] = x[j] + c3 * (acc[j] * rs); }
        if (l == DEPTH - 1) { float* od = F.out + ((size_t)b * SEQ + (s - CTXL)) * DMODEL;
#pragma unroll
            for (int j = 0; j < 4; ++j) __builtin_nontemporal_store(x[j], (f32x4*)od + lane + 64 * j); }
        else { row_store_bf16(xr, lane, x);
            const float rs1 = row_rstd(x, lane); const float* mn = mod_row(A_, F, l + 1, b, s);
#pragma unroll
            for (int j = 0; j < 4; ++j) { const f32x4 sh = ((const f32x4*)mn)[lane + 64 * j], c0 = ((const f32x4*)(mn + DMODEL))[lane + 64 * j]; x[j] = (x[j] * rs1) * c0 + sh; }
            row_store_fp8((unsigned char*)(F.ws + WS_H) + (size_t)row * DMODEL, lane, x); }
    }
#undef CB_ROW
}
constexpr int NPH = 12, NPHASES = 1 + DEPTH * NCHUNK * NPH;
__global__ void __launch_bounds__(512, 2) mk_fwd(Args A_) {
    extern __shared__ __attribute__((aligned(16))) unsigned char lds[];
    Frame F0;
    F0.lds = (LAS unsigned char*)lds;
    F0.G = gridDim.x; { const int bx = blockIdx.x; F0.vcu = (F0.G % 8 == 0) ? (bx % 8) * (F0.G / 8) + bx / 8 : bx; }
    F0.out = A_.out; F0.ws = A_.ws;
    volatile LAS unsigned* MISC = (volatile LAS unsigned*)(F0.lds + MISC_OFF);
    for (int u = threadIdx.x; u < (LDS_BYTES - LDSCTL_OFF) / 4; u += 512) ((LAS unsigned*)(F0.lds + LDSCTL_OFF))[u] = 0u;
    __syncthreads();
    const int lo = A_.ph_lo, hi = A_.ph_hi;
    const bool fused = (hi - lo) > 1;
    XcdBarrier bar; bar.bar = (unsigned*)(F0.ws + WS_CTL) + CW_BAR; bar.x = 0; bar.st = nullptr;
    if (fused) bar = xcd_barrier_post((unsigned*)(F0.ws + WS_CTL) + CW_BAR, MISC + 8);
#ifndef MK_PHMASK
#define MK_PHMASK 0x1fff
#endif
#define PHON(j) (((MK_PHMASK) >> (j)) & 1)
#define IN(k) (lo <= (k) && (k) < hi)
#ifndef MK_BAR_SEC
#define MK_BAR_SEC 0
#endif
    unsigned long long bsec_acc = 0;
#define SEAM(k) do { if (IN(k) && IN((k) + 1)) { unsigned long long bt0_ = 0; const bool bon_ = (((MK_BAR_SEC) >> ((k) == 0 ? 12 : ((k) - 1) % NPH)) & 1) != 0; if (bon_) bt0_ = __builtin_amdgcn_s_memrealtime(); xcd_barrier(bar); if (bon_) bsec_acc += __builtin_amdgcn_s_memrealtime() - bt0_; } } while (0)
#ifndef MK_PROBE_MASK
#define MK_PROBE_MASK 0
#endif
#ifndef MK_PROBE_MULT
#define MK_PROBE_MULT 3
#endif
#define PBEG(j) unsigned long long t0_ = 0; if (((MK_PROBE_MASK) >> (j)) & 1) t0_ = __builtin_amdgcn_s_memrealtime();
#define PEND(j) if (((MK_PROBE_MASK) >> (j)) & 1) { const unsigned long long t1_ = __builtin_amdgcn_s_memrealtime(), te_ = t1_ + (unsigned long long)(MK_PROBE_MULT) * (t1_ - t0_); while (__builtin_amdgcn_s_memrealtime() < te_) __builtin_amdgcn_s_sleep(8); }

    if (PHON(12) && IN(0)) { PBEG(12) ph_prologue(A_, F0); SEAM(0); PEND(12) }

    for (int ch = 0; ch < NCHUNK; ++ch)
        for (int l = 0; l < DEPTH; ++l) {
            const int p0 = 1 + (ch * DEPTH + l) * NPH;
            Frame F = F0; asm volatile("" : "+s"(F.vcu), "+s"(F.G));
            { GAS unsigned char* wsg = (GAS unsigned char*)F0.ws; GAS float* og = (GAS float*)F0.out; asm volatile("" : "+s"(wsg), "+s"(og));
              F.ws = (unsigned char*)wsg; F.out = (float*)og; }
            unsigned char* wl = F.ws + WS_W + (size_t)l * LW;
            if (PHON(0) && IN(p0 + 0) && l == 0 && ch == 0) { PBEG(0) ph_norm1(A_, F, l, ch); SEAM(p0 + 0); PEND(0) }
            if (PHON(1) && IN(p0 + 1)) { PBEG(1)
                pg8::Gemm g{512, 512, 512}; SchedG1 S; S.init(l == DEPTH - 1, F.G, (int)blockIdx.x);
                S.A = (const char*)(F.ws + WS_H); S.B = (const char*)(wl + W_P);
                EpiG1 E{(bf16*)(F.ws + WS_P), F.ws + WS_G8};
                pg8::gemm_phase<EpiG1, SchedG1, true, true, false, true>(F.lds, g, S, E);
                SEAM(p0 + 1); PEND(1)
            }
            if (PHON(3) && IN(p0 + 3)) { PBEG(3) ph_prep(A_, F, l); ph_lru(A_, F, l); SEAM(p0 + 3); PEND(3) }
            if (PHON(4) && IN(p0 + 4)) { PBEG(4) ph_attn(A_, F, l, (char*)lds); SEAM(p0 + 4); PEND(4) }
            if (PHON(5) && IN(p0 + 5)) { PBEG(5)
                pg8::Gemm g{1024, 1024, 1024}; SchedPlain S; S.skipctx = (l != 0); S.T.init(S.skipctx ? BC * 8 : MC / 256, 4, F.G, (int)blockIdx.x);
                S.A = (const char*)(F.ws + WS_M8); S.B = (const char*)(wl + W_O); S.astep = (size_t)256 * 2048; S.bstep = (size_t)256 * 2048;
                EpiMerge E{(const unsigned char*)(F.ws + WS_G8), F.ws + WS_H};
                pg8::gemm_phase<EpiMerge, SchedPlain, true, true, true, true>(F.lds, g, S, E);
                SEAM(p0 + 5); PEND(5)
            }
            if (PHON(6) && IN(p0 + 6)) { PBEG(6)
                pg8::Gemm g{512, 512, 512, 0x7b7b7b7b}; SchedPlain S; S.skipctx = (l != 0); S.T.init(S.skipctx ? BC * 8 : MC / 256, 4, F.G, (int)blockIdx.x);
                S.A = (const char*)(F.ws + WS_H); S.B = (const char*)(wl + W_OUT); S.astep = (size_t)256 * 1024; S.bstep = (size_t)256 * 1024;
                pg8::EpiBf16<0> E{(pg8::bf16_t*)(F.ws + WS_O1), 1024, nullptr, 0, 0, 1.f};
                pg8::gemm_phase<pg8::EpiBf16<0>, SchedPlain, true, true, false, true>(F.lds, g, S, E);
                SEAM(p0 + 6); PEND(6)
            }
            if (PHON(7) && IN(p0 + 7)) { PBEG(7) ph_norm2(A_, F, l, ch); SEAM(p0 + 7); PEND(7) }
            if (PHON(8) && IN(p0 + 8)) { PBEG(8) ph_topk(A_, F, l); SEAM(p0 + 8); PEND(8) }
            if (PHON(9) && IN(p0 + 9)) { PBEG(9)
                pg8::Gemm g{512, 512, 512}; SchedMoe S; S.T.init(l == 0 ? NE * BC + NE * BC / 8 : NE * BC, 8, F.G, (int)blockIdx.x);
                S.A = (const char*)(F.ws + WS_H); S.B = (const char*)(wl + W_GU); S.astep = 0; S.bstep = (size_t)256 * 1024; S.estep = (size_t)2048 * 1024; S.gidx = (const int*)(F.ws + WS_ROWIDX);
                EpiSwiglu E{(unsigned char*)(F.ws + WS_ACT)};
                pg8::gemm_phase<EpiSwiglu, SchedMoe, true, true, false, true, true>(F.lds, g, S, E);
                SEAM(p0 + 9); PEND(9)
            }
            if (PHON(10) && IN(p0 + 10)) { PBEG(10)
                pg8::Gemm g{512, 512, 512}; SchedMoe S; S.T.init(l == 0 ? NE * BC + NE * BC / 8 : NE * BC, 4, F.G, (int)blockIdx.x);
                S.A = (const char*)(F.ws + WS_ACT); S.B = (const char*)(wl + W_D); S.astep = (size_t)256 * 1024; S.bstep = (size_t)256 * 1024; S.estep = (size_t)1024 * 1024; S.gidx = nullptr;
                pg8::EpiBf16<0> E{(pg8::bf16_t*)(F.ws + WS_HS), 1024, nullptr, 0, 0, 1.f};
                pg8::gemm_phase<pg8::EpiBf16<0>, SchedMoe, true, true, false, true>(F.lds, g, S, E);
                SEAM(p0 + 10); PEND(10)
            }
            if (PHON(11) && IN(p0 + 11)) { PBEG(11) ph_combine(A_, F, l, ch);
                if (l == DEPTH - 1 && ch + 1 < NCHUNK) ph_norm1(A_, F, 0, ch + 1);
                SEAM(p0 + 11); PEND(11) }
        }
    if (MK_BAR_SEC) { const unsigned long long te_ = __builtin_amdgcn_s_memrealtime() + 3ull * bsec_acc; while (__builtin_amdgcn_s_memrealtime() < te_) __builtin_amdgcn_s_sleep(8); }
#undef IN
#undef SEAM
}

#ifndef MK_N_LAUNCHES
#define MK_N_LAUNCHES 1
#endif
extern "C" void kernel_launch(void* const* d_in, const int* in_sizes, int n_in, void* d_out, int out_size, void* d_ws, size_t ws_size, hipStream_t stream) {
    static int grid = 0;
    if (grid == 0) {
        if (n_in != N_IN || in_sizes[0] != NB * SEQ * DMODEL || out_size != NB * SEQ * DMODEL || ws_size < WS_END) { fprintf(stderr, "kernel_launch: unexpected shapes / workspace (%d inputs, ws %zu, need %zu)\n", n_in, ws_size, (size_t)WS_END); grid = -1; return; }
        int dev = 0, cus = 0, per_cu = 0;
        if (hipGetDevice(&dev) != hipSuccess || hipDeviceGetAttribute(&cus, hipDeviceAttributeMultiprocessorCount, dev) != hipSuccess) { grid = -1; return; }
        if (hipFuncSetAttribute((const void*)mk_fwd, hipFuncAttributeMaxDynamicSharedMemorySize, LDS_BYTES) != hipSuccess) { fprintf(stderr, "kernel_launch: hipFuncSetAttribute failed\n"); grid = -1; return; }
        if (hipOccupancyMaxActiveBlocksPerMultiprocessor(&per_cu, (const void*)mk_fwd, 512, LDS_BYTES) != hipSuccess || per_cu < 1) { fprintf(stderr, "kernel_launch: occupancy query says %d blocks per CU\n", per_cu); (void)hipGetLastError(); grid = -1; return; }
        grid = cus;
        if (grid != 256) fprintf(stderr, "kernel_launch: %d CUs (built and tuned for 256)\n", grid);
    }
    if (grid < 0) return;
    if (hipMemsetAsync((char*)d_ws + WS_CTL, 0, CTL_ZERO_BYTES, stream) != hipSuccess) return;
    Args a{};
    for (int i = 0; i < N_IN; ++i) a.in[i] = (const float*)d_in[i];
    a.out = (float*)d_out; a.ws = (unsigned char*)d_ws;
#if MK_N_LAUNCHES == 1
    a.ph_lo = 0; a.ph_hi = NPHASES;
    hipLaunchKernelGGL(mk_fwd, dim3(grid), dim3(512), LDS_BYTES, stream, a);
#else
    for (int p = 0; p < NPHASES; ++p) { a.ph_lo = p; a.ph_hi = p + 1; hipLaunchKernelGGL(mk_fwd, dim3(grid), dim3(512), LDS_BYTES, stream, a); }
#endif
}
```

```cpp
#include <hip/hip_runtime.h>
#include <cstdio>
#include <cstdint>
namespace pg8 {
#define PG8_LAS __attribute__((address_space(3)))
typedef unsigned short bf16_t;
typedef short bf16x8 __attribute__((ext_vector_type(8)));
typedef float f32x4 __attribute__((ext_vector_type(4)));
typedef unsigned u32x4 __attribute__((ext_vector_type(4)));
constexpr int BM = 256, BK = 64, HALF = 128, HTB = HALF * BK * 2  , STAGE_BYTES = 8 * HTB, NXCD = 8, WGM = 8;

__host__ __device__ __forceinline__ int lds_byte(int r, int c) { const int st = (r >> 4) * 2 + (c >> 5), rr = r & 15, cc = c & 31, ob = rr * 64 + cc * 2; return st * 1024 + (ob ^ (((ob >> 9) & 1) << 5)); }
__host__ __device__ __forceinline__ void stage_rc(int b, int& R, int& C) { const int st = b / 1024, sb = b % 1024, swz = sb ^ (((sb >> 9) & 1) << 5); R = (st >> 1) * 16 + swz / 64; C = (st & 1) * 32 + (swz % 64) / 2; }
__host__ __device__ __forceinline__ int perm32(int rho) { const int n = rho >> 4, i = rho & 15; return 8 * (i >> 2) + 4 * n + (i & 3); }

struct Unit { int pm, pn; const char* A; const char* B; const int* gidx; };
struct Gemm { int lda, ldb, K; int sca = 0x7f7f7f7f, scw = 0x79797979; };

__device__ __forceinline__ unsigned cvt_pk_bf16(float lo, float hi) { unsigned r; asm volatile("v_cvt_pk_bf16_f32 %0, %1, %2" : "=v"(r) : "v"(lo), "v"(hi)); return r; }
typedef float f32x2 __attribute__((ext_vector_type(2)));
__device__ __forceinline__ f32x2 gelu_pk(f32x2 v) {
    const f32x2 av = __builtin_elementwise_abs(v), d = av * 0.2316418882f + 1.0f;
    f32x2 t; t.x = __builtin_amdgcn_rcpf(d.x); t.y = __builtin_amdgcn_rcpf(d.y);
    f32x2 q = t * 0.5307027145f + (-0.7265760135f); q = q * t + 0.7107068705f; q = q * t + (-0.142248368f); q = q * t + 0.127414796f; q = q * t;
    const f32x2 s = (v * v) * (-0.72134752044f);
    f32x2 e; e.x = __builtin_amdgcn_exp2f(s.x); e.y = __builtin_amdgcn_exp2f(s.y);
    const f32x2 m = v * (q * e), r = v - m;
    f32x2 o; o.x = v.x < 0.f ? m.x : r.x; o.y = v.y < 0.f ? m.y : r.y; return o;
}

template <int ACT  > struct EpiBf16 {
    static constexpr bool PERM = true, AFTER_DRAIN = false; static_assert(ACT == 0 || ACT == 1, "EpiBf16: ACT is 0 (none) or 1 (gelu_pk)");
    bf16_t* O; int ldc; const float* bias; int split_cols; size_t split_stride; float scale0;
    __device__ __forceinline__ void operator()(const f32x4 (&acc)[2][2][4][2], const Unit& u, int wr, int wc, int fr, int fq) const {
        int row0 = u.pm * BM + wr * 64 + fr; asm volatile("" : "+v"(row0));
        int colt = u.pn * BM; bf16_t* base = O;
        float sc = 1.f; if (split_cols) { const int t = colt / split_cols; base += (size_t)t * split_stride; colt -= t * split_cols; if (t == 0) sc = scale0; }
        const int col0 = colt + wc * 32 + 8 * fq, bcol0 = u.pn * BM + wc * 32 + 8 * fq;
        f32x4 bv[2][2];
#pragma unroll
        for (int bj = 0; bj < 2; ++bj)
#pragma unroll
            for (int n = 0; n < 2; ++n) bv[bj][n] = bias ? *(const f32x4*)(bias + bcol0 + bj * HALF + 4 * n) : (f32x4){0.f, 0.f, 0.f, 0.f};
#pragma unroll
        for (int ai = 0; ai < 2; ++ai)
#pragma unroll
            for (int m = 0; m < 4; ++m) { bf16_t* rowp = base + (size_t)(row0 + ai * HALF + m * 16) * ldc + col0;
#pragma unroll
                for (int bj = 0; bj < 2; ++bj) { f32x4 v0 = acc[ai][bj][m][0] + bv[bj][0], v1 = acc[ai][bj][m][1] + bv[bj][1];
                    if (ACT == 1) { f32x2 a = gelu_pk((f32x2){v0[0], v0[1]}), b = gelu_pk((f32x2){v0[2], v0[3]}), c = gelu_pk((f32x2){v1[0], v1[1]}), d = gelu_pk((f32x2){v1[2], v1[3]});
                        v0 = (f32x4){a.x, a.y, b.x, b.y}; v1 = (f32x4){c.x, c.y, d.x, d.y}; }
                    v0 = v0 * sc; v1 = v1 * sc; u32x4 w; w.x = cvt_pk_bf16(v0[0], v0[1]); w.y = cvt_pk_bf16(v0[2], v0[3]); w.z = cvt_pk_bf16(v1[0], v1[1]); w.w = cvt_pk_bf16(v1[2], v1[3]);
                    *(u32x4*)(rowp + bj * HALF) = w; } }
    }
};

typedef int v8i32 __attribute__((ext_vector_type(8))); typedef int v4i32 __attribute__((ext_vector_type(4)));
__device__ __forceinline__ v8i32 cat8(bf16x8 lo, bf16x8 hi) { return __builtin_shufflevector(__builtin_bit_cast(v4i32, lo), __builtin_bit_cast(v4i32, hi), 0, 1, 2, 3, 4, 5, 6, 7); }
template <class Epi, class Sched, bool ALIGN_EPI = false, bool SP2 = false, bool KHOOK = false, bool FP8 = false, bool GATHER = false>
__device__ __forceinline__ void gemm_phase(PG8_LAS unsigned char* lds, const Gemm g, const Sched& S, const Epi& E) {
    int tid_ = threadIdx.x; asm volatile("" : "+v"(tid_));
    const int tid = tid_, wid = __builtin_amdgcn_readfirstlane(tid >> 6), lane = tid & 63, wr = wid >> 2, wc = wid & 3, fr = lane & 15, fq = lane >> 4;
    const int K = g.K, nt = K / BK;
    unsigned voffA[2], voffB[2];
#pragma unroll
    for (int i = 0; i < 2; ++i) { int R, C; stage_rc(tid * 16 + i * 8192, R, C); const int Rb = Epi::PERM ? ((R & ~31) + perm32(R & 31)) : R;
        voffA[i] = (unsigned)(R * g.lda + C) * 2u; voffB[i] = (unsigned)(Rb * g.ldb + C) * 2u; }
    static_assert(!GATHER || SP2, "GATHER is written for the SP2 loop");
    unsigned vg[2][2], nvg[2][2];
#define PG8_GLOAD(dst, U) do { _Pragma("unroll") for (int h_ = 0; h_ < 2; ++h_) _Pragma("unroll") for (int i_ = 0; i_ < 2; ++i_) { int R_, C_; stage_rc(tid * 16 + i_ * 8192, R_, C_); \
        dst[h_][i_] = (unsigned)(U).gidx[h_ * HALF + R_] * (unsigned)(g.lda * 2) + (unsigned)(C_ * 2); } } while (0)
#define PG8_STAGEA(bufoff, kbase, half, nx) do { if constexpr (GATHER) { const bool un_ = (nx); unsigned vs_[2] = {un_ ? nvg[half][0] : vg[half][0], un_ ? nvg[half][1] : vg[half][1]}; PG8_STAGE(bufoff, kbase, vs_); } \
        else { PG8_STAGE(bufoff, (kbase) + ((half) ? hstepA : (size_t)0), voffA); } } while (0)
    const size_t kstep = (size_t)(BK * 2);
    const size_t hstepA = (size_t)HALF * g.lda * 2, hstepB = (size_t)HALF * g.ldb * 2;
    const unsigned ldsw = (unsigned)wid * 1024u;
    const int aoff = lds_byte(wr * 64 + fr, fq * 8), boff = lds_byte(wc * 32 + fr, fq * 8);
#define PG8_SA(b, h) (((b) * 2 + (h)) * HTB)
#define PG8_SB(b, h) ((4 + (b) * 2 + (h)) * HTB)
#define PG8_STAGE(bufoff, gbase, voff) do { _Pragma("unroll") for (int _i = 0; _i < 2; ++_i) \
        __builtin_amdgcn_global_load_lds((const unsigned*)((const char*)(gbase) + (voff)[_i]), (PG8_LAS unsigned*)(lds + (bufoff) + ldsw + _i * 8192), 16, 0, 0); } while (0)
#define PG8_LDA(dst, b, h) do { _Pragma("unroll") for (int m = 0; m < 4; ++m) dst[m] = cat8(*(const PG8_LAS bf16x8*)(lds + PG8_SA(b, h) + aoff + m * 2048), *(const PG8_LAS bf16x8*)(lds + PG8_SA(b, h) + aoff + m * 2048 + 1024)); } while (0)
#define PG8_LDB(dst, b, h) do { _Pragma("unroll") for (int n = 0; n < 2; ++n) dst[n] = cat8(*(const PG8_LAS bf16x8*)(lds + PG8_SB(b, h) + boff + n * 2048), *(const PG8_LAS bf16x8*)(lds + PG8_SB(b, h) + boff + n * 2048 + 1024)); } while (0)
#define PG8_LO(x) __builtin_bit_cast(bf16x8, __builtin_shufflevector((x), (x), 0, 1, 2, 3))
#define PG8_HI(x) __builtin_bit_cast(bf16x8, __builtin_shufflevector((x), (x), 4, 5, 6, 7))
#define PG8_MMA(ai, bj, At, Bt) do { __builtin_amdgcn_s_setprio(1); _Pragma("unroll") for (int m = 0; m < 4; ++m) _Pragma("unroll") for (int n = 0; n < 2; ++n) { \
        if constexpr (FP8) asm volatile("v_mfma_scale_f32_16x16x128_f8f6f4 %0, %1, %2, %0, %3, %4 op_sel_hi:[0,0,0]" : "+v"(acc[ai][bj][m][n]) : "v"(Bt[n]), "v"(At[m]), "v"(fp8_scw), "v"(fp8_sca));   \
        else { acc[ai][bj][m][n] = __builtin_amdgcn_mfma_f32_16x16x32_bf16(PG8_LO(Bt[n]), PG8_LO(At[m]), acc[ai][bj][m][n], 0, 0, 0); \
               acc[ai][bj][m][n] = __builtin_amdgcn_mfma_f32_16x16x32_bf16(PG8_HI(Bt[n]), PG8_HI(At[m]), acc[ai][bj][m][n], 0, 0, 0); } } __builtin_amdgcn_s_setprio(0); } while (0)
#define PG8_WAIT_V(n) asm volatile("s_waitcnt vmcnt(" #n ")" ::: "memory")
#define PG8_WAIT_L(n) asm volatile("s_waitcnt lgkmcnt(" #n ")" ::: "memory")
#define PG8_BAR __builtin_amdgcn_s_barrier()
#define PG8_SCHED __builtin_amdgcn_sched_barrier(0)
    const int fp8_scw = g.scw, fp8_sca = g.sca;
    unsigned long long gsec_acc = 0;
    Unit cur, nxt; int ui = 0;
    if (!S.next(0, cur)) return;
    f32x4 acc[2][2][4][2];
#pragma unroll
    for (int a = 0; a < 2; ++a)
#pragma unroll
        for (int b = 0; b < 2; ++b)
#pragma unroll
            for (int m = 0; m < 4; ++m)
#pragma unroll
                for (int n = 0; n < 2; ++n) acc[a][b][m][n] = (f32x4){0.f, 0.f, 0.f, 0.f};
    v8i32 At[4], B0[2], B1[2];
    const char* cA = cur.A; const char* cB = cur.B;
    S.a_ready(cur);
    if constexpr (GATHER) PG8_GLOAD(vg, cur);
    if constexpr (SP2) {
        PG8_STAGE(PG8_SB(0, 0), cB, voffB); PG8_STAGE(PG8_SB(0, 1), cB + hstepB, voffB); PG8_STAGEA(PG8_SA(0, 0), cA, 0, false); PG8_STAGEA(PG8_SA(0, 1), cA, 1, false);
        if (wr == 1) PG8_BAR;
        PG8_WAIT_V(2); PG8_BAR;
        PG8_STAGE(PG8_SB(1, 0), cB + kstep, voffB); PG8_STAGEA(PG8_SA(1, 0), cA + kstep, 0, false); PG8_STAGE(PG8_SB(1, 1), cB + hstepB + kstep, voffB);
        PG8_WAIT_V(6); PG8_BAR;
    } else {
        PG8_STAGE(PG8_SB(0, 0), cB, voffB); PG8_STAGE(PG8_SA(0, 0), cA, voffA); PG8_STAGE(PG8_SB(0, 1), cB + hstepB, voffB); PG8_STAGE(PG8_SA(0, 1), cA + hstepA, voffA);
        if (wr == 1) PG8_BAR;
        PG8_WAIT_V(4); PG8_BAR;
        PG8_STAGE(PG8_SB(1, 0), cB + kstep, voffB); PG8_STAGE(PG8_SA(1, 0), cA + kstep, voffA); PG8_STAGE(PG8_SB(1, 1), cB + hstepB + kstep, voffB);
        PG8_WAIT_V(6); PG8_BAR;
    }
    for (;;) {
        const bool has_next = S.next(ui + 1, nxt);
        const char* nA = has_next ? nxt.A : cA; const char* nB = has_next ? nxt.B : cB;
        if constexpr (GATHER) { if (has_next) PG8_GLOAD(nvg, nxt); }
#pragma unroll 1
        for (int t = 0; t < nt; t += 2) {
            const bool last = (t == nt - 2);
            if constexpr (KHOOK) { if (t == Epi::HOOK_T0 || t == Epi::HOOK_T1) { if constexpr (ALIGN_EPI) { if (wr == 0) PG8_BAR; }
                if constexpr (FP8) asm volatile("s_nop 15\n\ts_nop 15" ::: "memory"); E.khook(acc, cur, t, wr, wc, fr, fq); if constexpr (ALIGN_EPI) { if (wr == 1) PG8_BAR; } } }
            const char* a1 = cA + (size_t)(t + 1) * kstep;
            const char* a2 = last ? nA : cA + (size_t)(t + 2) * kstep; const char* b2 = last ? nB : cB + (size_t)(t + 2) * kstep;
            const char* a3 = a2 + kstep; const char* b3 = b2 + kstep;
            if (last && has_next) S.a_ready(nxt);
            if constexpr (SP2) {
            PG8_LDB(B0, 0, 0); PG8_LDB(B1, 0, 1); PG8_SCHED; PG8_LDA(At, 0, 0); PG8_STAGEA(PG8_SA(1, 1), a1, 1, false);
            PG8_WAIT_V(8); PG8_WAIT_L(0); PG8_BAR; PG8_MMA(0, 0, At, B0); PG8_MMA(0, 1, At, B1); PG8_BAR; PG8_SCHED;
            PG8_LDA(At, 0, 1); PG8_STAGE(PG8_SB(0, 0), b2, voffB); PG8_STAGE(PG8_SB(0, 1), b2 + hstepB, voffB); PG8_STAGEA(PG8_SA(0, 0), a2, 0, last && has_next);
            PG8_WAIT_V(8); PG8_WAIT_L(0); PG8_BAR; PG8_MMA(1, 0, At, B0); PG8_MMA(1, 1, At, B1); PG8_BAR; PG8_SCHED;
            PG8_LDB(B0, 1, 0); PG8_LDB(B1, 1, 1); PG8_SCHED; PG8_LDA(At, 1, 0); PG8_STAGEA(PG8_SA(0, 1), a2, 1, last && has_next);
            PG8_WAIT_V(8); PG8_WAIT_L(0); PG8_BAR; PG8_MMA(0, 0, At, B0); PG8_MMA(0, 1, At, B1); PG8_BAR; PG8_SCHED;
            PG8_LDA(At, 1, 1); PG8_STAGE(PG8_SB(1, 0), b3, voffB); PG8_STAGE(PG8_SB(1, 1), b3 + hstepB, voffB); PG8_STAGEA(PG8_SA(1, 0), a3, 0, last && has_next);
            PG8_WAIT_V(8); PG8_WAIT_L(0); PG8_BAR; PG8_MMA(1, 0, At, B0); PG8_MMA(1, 1, At, B1); PG8_BAR; PG8_SCHED;
            } else {
            PG8_LDB(B0, 0, 0); PG8_SCHED; PG8_LDA(At, 0, 0); PG8_STAGE(PG8_SA(1, 1), a1 + hstepA, voffA);
            PG8_WAIT_L(8); PG8_BAR; PG8_WAIT_L(0); PG8_MMA(0, 0, At, B0); PG8_BAR; PG8_SCHED;
            PG8_LDB(B1, 0, 1); PG8_STAGE(PG8_SB(0, 0), b2, voffB);
            PG8_BAR; PG8_WAIT_L(0); PG8_MMA(0, 1, At, B1); PG8_BAR;
            PG8_LDA(At, 0, 1); PG8_STAGE(PG8_SA(0, 0), a2, voffA);
            PG8_BAR; PG8_WAIT_L(0); PG8_MMA(1, 0, At, B0); PG8_BAR; PG8_SCHED;
            PG8_STAGE(PG8_SB(0, 1), b2 + hstepB, voffB);
            PG8_WAIT_V(6); PG8_BAR; PG8_MMA(1, 1, At, B1); PG8_BAR;
            PG8_LDB(B0, 1, 0); PG8_SCHED; PG8_LDA(At, 1, 0); PG8_STAGE(PG8_SA(0, 1), a2 + hstepA, voffA);
            PG8_WAIT_L(8); PG8_BAR; PG8_WAIT_L(0); PG8_MMA(0, 0, At, B0); PG8_BAR; PG8_SCHED;
            PG8_LDB(B1, 1, 1); PG8_STAGE(PG8_SB(1, 0), b3, voffB);
            PG8_BAR; PG8_WAIT_L(0); PG8_MMA(0, 1, At, B1); PG8_BAR;
            PG8_LDA(At, 1, 1); PG8_STAGE(PG8_SA(1, 0), a3, voffA);
            PG8_BAR; PG8_WAIT_L(0); PG8_MMA(1, 0, At, B0); PG8_BAR; PG8_SCHED;
            PG8_STAGE(PG8_SB(1, 1), b3 + hstepB, voffB);
            PG8_WAIT_V(6); PG8_BAR; PG8_MMA(1, 1, At, B1); PG8_BAR;
            }
        }
        if constexpr (FP8) asm volatile("s_nop 15\n\ts_nop 15" ::: "memory");
        if constexpr (ALIGN_EPI) { if (wr == 0) PG8_BAR; }
#ifndef MK_GEMM_SEC
#define MK_GEMM_SEC 0
#endif
        unsigned long long gsec_t0 = 0; if (MK_GEMM_SEC == 1) gsec_t0 = __builtin_amdgcn_s_memrealtime();
        if constexpr (!Epi::AFTER_DRAIN) { E(acc, cur, wr, wc, fr, fq); S.done(cur); }
        if (MK_GEMM_SEC == 1) gsec_acc += __builtin_amdgcn_s_memrealtime() - gsec_t0;
        if (!has_next) break;
#pragma unroll
        for (int a = 0; a < 2; ++a)
#pragma unroll
            for (int b = 0; b < 2; ++b)
#pragma unroll
                for (int m = 0; m < 4; ++m)
#pragma unroll
                    for (int n = 0; n < 2; ++n) acc[a][b][m][n] = (f32x4){0.f, 0.f, 0.f, 0.f};
        cur = nxt; cA = nA; cB = nB; ++ui;
        if constexpr (GATHER) { vg[0][0] = nvg[0][0]; vg[0][1] = nvg[0][1]; vg[1][0] = nvg[1][0]; vg[1][1] = nvg[1][1]; }
        if constexpr (ALIGN_EPI) { if (wr == 1) PG8_BAR; }
    }
    PG8_WAIT_V(0);
    if constexpr (!ALIGN_EPI) { if (wr == 0) PG8_BAR; }
    PG8_BAR;
    if constexpr (Epi::AFTER_DRAIN) { E.fused(acc, cur, wr, wc, fr, fq, lds, wid, lane); S.done(cur); }
    if (MK_GEMM_SEC != 0) { const unsigned long long te_ = __builtin_amdgcn_s_memrealtime() + 3ull * gsec_acc; while (__builtin_amdgcn_s_memrealtime() < te_) __builtin_amdgcn_s_sleep(8); }
#undef PG8_SA
#undef PG8_SB
#undef PG8_STAGE
#undef PG8_STAGEA
#undef PG8_GLOAD
#undef PG8_LDA
#undef PG8_LDB
#undef PG8_MMA
#undef PG8_LO
#undef PG8_HI
#undef PG8_WAIT_V
#undef PG8_WAIT_L
#undef PG8_BAR
#undef PG8_SCHED
}
}
#include <hip/hip_bf16.h>
#include <cmath>
namespace attn_body {
using bf16=__hip_bfloat16;
using bf16x8=__attribute__((ext_vector_type(8)))short;
using s16x4=__attribute__((ext_vector_type(4)))short;
using f32x16=__attribute__((ext_vector_type(16)))float;
using u32x4=__attribute__((ext_vector_type(4)))unsigned;
constexpr int D=64,DM=4352;
constexpr int NW=8,QBLK=32,QB=QBLK*NW,KVBLK=64;
constexpr int ATTN_PITCH=DM, ATTN_UNIT_ROWS=QB;
constexpr int ATTN_OPITCH=2048; constexpr float ATTN_OSCALE=32.f;
__device__ __forceinline__ int crow(int r,int hi){return (r&3)+8*(r>>2)+4*hi;}
#define SBAR() __builtin_amdgcn_sched_barrier(0)
constexpr int NSLOT=3, SLOTB=8192;
constexpr int LDS_K=0, LDS_V=NSLOT*SLOTB, LDS_WS=2*NSLOT*SLOTB, LDS_OST=LDS_WS+NW*64*4, LDS_BYTES=LDS_OST+NW*4096, LDS_NATAB=LDS_BYTES, NATAB_BYTES=15*128*4;
constexpr float C2=0.125f*1.4426950408889634f;
__device__ __forceinline__ void glds16(const void*gsrc,unsigned lds_dst){unsigned keep;
  asm volatile("s_mov_b32 %0, m0\n\ts_mov_b32 m0, %2\n\ts_nop 0\n\tglobal_load_lds_dwordx4 %1, off\n\ts_mov_b32 m0, %0":"=&s"(keep):"v"(gsrc),"s"(lds_dst):"memory");}
__device__ __forceinline__ void glds4(const void*gsrc,unsigned lds_dst){unsigned keep;
  asm volatile("s_mov_b32 %0, m0\n\ts_mov_b32 m0, %2\n\ts_nop 0\n\tglobal_load_lds_dword %1, off\n\ts_mov_b32 m0, %0":"=&s"(keep):"v"(gsrc),"s"(lds_dst):"memory");}
__device__ __forceinline__ float max3f(float a,float b,float c){float r;asm("v_max3_f32 %0, %1, %2, %3":"=v"(r):"v"(a),"v"(b),"v"(c));return r;}
__device__ __forceinline__ float max2f(float a,float b){float r;asm("v_max_f32_e32 %0, %1, %2":"=v"(r):"v"(a),"v"(b));return r;}
__device__ __forceinline__ float fadd_s(float a,float b){float r;asm("v_add_f32_e32 %0, %1, %2":"=v"(r):"v"(a),"v"(b));return r;}
__device__ __forceinline__ float fsub_s(float a,float b){float r;asm("v_sub_f32_e32 %0, %1, %2":"=v"(r):"v"(a),"v"(b));return r;}
typedef float f32x2_t __attribute__((ext_vector_type(2))); typedef __bf16 bf16x2_t __attribute__((ext_vector_type(2)));
__device__ __forceinline__ unsigned cvtpk_s(float lo,float hi){f32x2_t v={lo,hi};bf16x2_t b=__builtin_convertvector(v,bf16x2_t);return __builtin_bit_cast(unsigned,b);}
#define WAIT_BAR(N) asm volatile("s_waitcnt vmcnt(" #N ") lgkmcnt(0)\n\ts_barrier":::"memory")

__device__ __forceinline__ void qkt(f32x16&p0,f32x16&p1,const char*Kslot,const bf16x8*qr,const f32x16&negm,int r32,int hi){
  const char*kb=Kslot+hi*1024+r32*16;
  #pragma unroll
  for(int d0=0;d0<4;++d0){
    const bf16x8 b0=*reinterpret_cast<const bf16x8*>(kb+d0*2048);
    const bf16x8 b1=*reinterpret_cast<const bf16x8*>(kb+d0*2048+512);
    if(d0==0){p0=__builtin_amdgcn_mfma_f32_32x32x16_bf16(b0,qr[0],negm,0,0,0);p1=__builtin_amdgcn_mfma_f32_32x32x16_bf16(b1,qr[0],negm,0,0,0);}
    else{p0=__builtin_amdgcn_mfma_f32_32x32x16_bf16(b0,qr[d0],p0,0,0,0);p1=__builtin_amdgcn_mfma_f32_32x32x16_bf16(b1,qr[d0],p1,0,0,0);}}
}
typedef __attribute__((address_space(3))) const char* lds_cptr;
typedef short v4i16_t __attribute__((ext_vector_type(4)));
__device__ __forceinline__ void kload8(bf16x8*kf,lds_cptr kp){
  kf[0]=*(const __attribute__((address_space(3))) bf16x8*)(kp);      kf[1]=*(const __attribute__((address_space(3))) bf16x8*)(kp+512);
  kf[2]=*(const __attribute__((address_space(3))) bf16x8*)(kp+2048); kf[3]=*(const __attribute__((address_space(3))) bf16x8*)(kp+2560);
  kf[4]=*(const __attribute__((address_space(3))) bf16x8*)(kp+4096); kf[5]=*(const __attribute__((address_space(3))) bf16x8*)(kp+4608);
  kf[6]=*(const __attribute__((address_space(3))) bf16x8*)(kp+6144); kf[7]=*(const __attribute__((address_space(3))) bf16x8*)(kp+6656);
}
__device__ __forceinline__ void kload2(bf16x8*kf,lds_cptr kp,int j){ kf[2*j]=*(const __attribute__((address_space(3))) bf16x8*)(kp+j*2048); kf[2*j+1]=*(const __attribute__((address_space(3))) bf16x8*)(kp+j*2048+512); }
__device__ __forceinline__ s16x4 vtr(lds_cptr p){ return __builtin_bit_cast(s16x4,__builtin_amdgcn_ds_read_tr16_b64_v4i16((__attribute__((address_space(3))) v4i16_t*)p)); }
__device__ __forceinline__ float rowmax(const f32x16&p0,const f32x16&p1){
  float a=max3f(p0[0],p0[1],p1[0]),b=max3f(p0[2],p0[3],p1[1]);a=max3f(a,p1[2],p1[3]);
  #pragma unroll
  for(int r=4;r<16;r+=4){a=max3f(a,p0[r],p0[r+1]);b=max3f(b,p0[r+2],p0[r+3]);a=max3f(a,p1[r],p1[r+1]);b=max3f(b,p1[r+2],p1[r+3]);}
  const float m=max2f(a,b);
  auto rr=__builtin_amdgcn_permlane32_swap(__float_as_uint(m),__float_as_uint(m),false,false);
  return max2f(__uint_as_float(rr[0]),__uint_as_float(rr[1]));
}
__device__ __forceinline__ void pv(f32x16*o,int vb,bf16x8 pa0,bf16x8 pa1,bf16x8 pa2,bf16x8 pa3){
  #pragma unroll
  for(int d0=0;d0<2;++d0){s16x4 lo[4],hi[4];
    #pragma unroll
    for(int ks=0;ks<4;++ks){
      asm volatile("ds_read_b64_tr_b16 %0,%1 offset:%c2":"=&v"(lo[ks]):"v"(vb),"i"(d0*4096+ks*1024):"memory");
      asm volatile("ds_read_b64_tr_b16 %0,%1 offset:%c2":"=&v"(hi[ks]):"v"(vb),"i"(d0*4096+ks*1024+512):"memory");}
    asm volatile("s_waitcnt lgkmcnt(0)":::"memory");SBAR();
    #define PK(k) (bf16x8){lo[k][0],lo[k][1],lo[k][2],lo[k][3],hi[k][0],hi[k][1],hi[k][2],hi[k][3]}
    o[d0]=__builtin_amdgcn_mfma_f32_32x32x16_bf16(pa0,PK(0),o[d0],0,0,0);
    o[d0]=__builtin_amdgcn_mfma_f32_32x32x16_bf16(pa1,PK(1),o[d0],0,0,0);
    o[d0]=__builtin_amdgcn_mfma_f32_32x32x16_bf16(pa2,PK(2),o[d0],0,0,0);
    o[d0]=__builtin_amdgcn_mfma_f32_32x32x16_bf16(pa3,PK(3),o[d0],0,0,0);
    #undef PK
  }
}

#ifndef ATTN_STORE16
#define ATTN_STORE16(p,v) (*(u32x4*)(p)=(v))
#endif
__device__ __forceinline__ void na_fill_table(const float*rpbh,char*shm){
  int tid_=threadIdx.x; asm volatile("":"+v"(tid_));
  __attribute__((address_space(3))) float* tw=(__attribute__((address_space(3))) float*)((__attribute__((address_space(3))) char*)shm+LDS_NATAB);
  for(int i=tid_;i<15*128;i+=NW*64){ const int dr=i>>7, j=(i&127)-63; tw[i]=(j>=-15&&j<=15)?rpbh[dr*31+j+15]*1.4426950408889634f:0.f; }
}
template<int THRL,int MODE> __device__ __forceinline__ void attn_unit(const bf16*Q0,const bf16*__restrict__ Kh,const bf16*__restrict__ Vh,unsigned char*O0,const int NT,const int R0w,const int nar0,const float*rpbh,char*shm,
    const bool pre,const bf16*nQ0,const bf16*nKh,const bf16*nVh){
  int tid_=threadIdx.x; asm volatile("":"+v"(tid_));
  const int tid=tid_,lane=tid&63,r32=lane&31,hi=lane>>5; const int wid=__builtin_amdgcn_readfirstlane(tid>>6);
  const bf16*Qw=Q0+(long)wid*QBLK*DM;
  const unsigned lds0=(unsigned)(uintptr_t)shm;
  float*wsf=(float*)(shm+LDS_WS)+wid*64;
  const bf16*ksrc=Kh+(long)lane*DM+wid*8;
  const bf16*vsrc=Vh+(long)(16*(wid&3)+(lane>>2))*DM+(wid>>2)*32+(lane&3)*8;
  const unsigned kdst=lds0+LDS_K+wid*1024, vdst=lds0+LDS_V+wid*1024;
  #define DMA_K(t,slot) glds16(ksrc+(long)TILE(t)*KVBLK*DM,(unsigned)__builtin_amdgcn_readfirstlane(kdst+(slot)))
  #define DMA_V(t,slot) glds16(vsrc+(long)TILE(t)*KVBLK*DM,(unsigned)__builtin_amdgcn_readfirstlane(vdst+(slot)))
  const int vb0=(int)(lds0+LDS_V)+((lane>>4)&1)*32+(lane&3)*8+(4*hi+((lane&15)>>2))*64;
  const char*Kbase=shm+LDS_K; bf16x8 kf[8];
  const lds_cptr shm3=(lds_cptr)shm; const lds_cptr kp0=shm3+LDS_K+hi*1024+r32*16; const lds_cptr vp0=shm3+LDS_V+((lane>>4)&1)*32+(lane&3)*8+(4*hi+((lane&15)>>2))*64;
  #define TILE(t) ((t)+(((t)>=4)?R0w:0))
  const int nr=nar0+(wid>>1), nc=32*(wid&1)+r32; const int nrs=min(max(nr-4,0),24), ncs=min(max(nc-8,0),48);
  const __attribute__((address_space(3))) float* ntab=(const __attribute__((address_space(3))) float*)((lds_cptr)shm+LDS_NATAB)+63-nc+4*hi;
  (void)rpbh;
  if(!pre){DMA_K(0,0);DMA_V(0,0);DMA_K(1,SLOTB);}
  else{DMA_V(0,0);}
  bf16x8 qr[4];
  #pragma unroll
  for(int d0=0;d0<4;++d0)qr[d0]=*reinterpret_cast<const bf16x8*>(&Qw[(long)r32*DM+d0*16+hi*8]);
  float mhat=0.f,l_reg=0.f;f32x16 o[2];o[0]=f32x16{};o[1]=f32x16{};f32x16 negm=f32x16{}; if(MODE==0)asm volatile("":"+v"(negm));
  #define CMASK(P0,P1,t) do{ if(MODE==1){ if((t)<4){ _Pragma("unroll") for(int r=0;r<16;++r){P0[r]-=mhat;P1[r]-=mhat;} } else { const int kr_=R0w+(t)-4; \
      if((unsigned)(kr_-nrs)>=8u){ _Pragma("unroll") for(int r=0;r<16;++r){P0[r]=-INFINITY;P1[r]=-INFINITY;} } \
      else{ const __attribute__((address_space(3))) float* br_=ntab+(kr_-nr+7)*128; \
        _Pragma("unroll") for(int r=0;r<16;++r){ const int ko_=(r&3)+8*(r>>2); const int kc_=ko_+4*hi; \
          P0[r]=((unsigned)(kc_-ncs)<16u)?P0[r]+(br_[ko_]-mhat):-INFINITY; P1[r]=((unsigned)(kc_+32-ncs)<16u)?P1[r]+(br_[ko_+32]-mhat):-INFINITY; \
          if((r&3)==3){ asm volatile("":"+v"(P0),"+v"(P1)); SBAR(); } } } } } }while(0)
  bool resc=false;
  #define NEGMC (MODE==1?f32x16{}:negm)
  #define START(P0,P1) do{ const float rm=rowmax(P0,P1); resc=false; \
    { const float dl=rm; mhat=fadd_s(mhat,dl); \
      _Pragma("unroll") for(int r=0;r<16;++r){P0[r]=fsub_s(P0[r],dl);P1[r]=fsub_s(P1[r],dl);} \
      if(MODE==0){ _Pragma("unroll") for(int r=0;r<16;++r)negm[r]=-mhat; asm volatile("":"+v"(negm)); } } \
    _Pragma("unroll") for(int r=0;r<16;++r)P0[r]=__builtin_amdgcn_exp2f(P0[r]); }while(0)
  #define RESC() do{ if(resc){ asm volatile("s_waitcnt lgkmcnt(0)":::"memory"); \
      _Pragma("unroll") for(int d_=0;d_<2;++d_) _Pragma("unroll") for(int r=0;r<16;++r)o[d_][r]*=wsf[crow(r,hi)]; } }while(0)
  f32x16 pA0,pA1,pB0,pB1;
  int sl_prev=0,sl_cur=0,sl_next=SLOTB;
  #define ROT() do{sl_prev=sl_cur;sl_cur=sl_next;sl_next=(sl_next==(NSLOT-1)*SLOTB)?0:sl_next+SLOTB;}while(0)
  if(!pre){ DMA_K(2,2*SLOTB);
    WAIT_BAR(3); }
  else{ WAIT_BAR(5); }
  qkt(pA0,pA1,Kbase,qr,negm,r32,hi);asm volatile("s_nop 15\n\ts_nop 7":"+v"(pA0),"+v"(pA1));CMASK(pA0,pA1,0);
  START(pA0,pA1);
  _Pragma("unroll") for(int r=0;r<16;++r)pA1[r]=__builtin_amdgcn_exp2f(pA1[r]);
  WAIT_BAR(0);
  DMA_K(3,0);DMA_V(1,SLOTB);
  ROT();
  kload8(kf,kp0+sl_cur);
  WAIT_BAR(2);
  s16x4 vlo[8],vhi[8]; u32x4 pw0,pw1,pw2,pw3;
  #define PKW(P,B) cvtpk_s(P[B],P[B+1])
  #define PAF(k) __builtin_bit_cast(bf16x8,pw##k)
  #define VFR(i) (bf16x8){vlo[i][0],vlo[i][1],vlo[i][2],vlo[i][3],vhi[i][0],vhi[i][1],vhi[i][2],vhi[i][3]}
  #define PIN(x) asm volatile("":"+v"(x))
  #define MX3(a,b,c) __builtin_fmaxf(__builtin_fmaxf((a),(b)),(c))
  #define GAPA(MF,A0,A1,A2,A3,W0,W1,PW) do{ MF; sacc+=A0; sacc+=A1; sacc+=A2; sacc+=A3; PIN(sacc); W0; W1; PIN(PW); SBAR(); }while(0)
  #define EX(v) __builtin_amdgcn_exp2f(v)
  #define GAPB(MF,X,B) do{ MF; X[B]=EX(X[B]); X[B+1]=EX(X[B+1]); X[B+2]=EX(X[B+2]); X[B+3]=EX(X[B+3]); PIN(X); SBAR(); }while(0)
  #define VRD(i) do{ vlo[i]=vtr(vp_+(((i)>>2)*4096+((i)&3)*1024)); vhi[i]=vtr(vp_+(((i)>>2)*4096+((i)&3)*1024+512)); }while(0)
  #define KRD(G,j) do{ if(G){ kload2(kf,kp0+sl_next,j); SBAR(); } }while(0)
  #define STEP(C0,C1,P0,P1,t,GK,GV,GL) do{ SBAR(); \
    const lds_cptr vp_=vp0+sl_prev; \
    VRD(0); SBAR(); float sacc=(P0[0]+P0[1]); \
    GAPA(C0=__builtin_amdgcn_mfma_f32_32x32x16_bf16(kf[0],qr[0],NEGMC,0,0,0), P0[2],P0[3],P0[4],P0[5],     pw0[0]=PKW(P0,0), pw0[1]=PKW(P0,2), pw0); \
    VRD(4); SBAR(); GAPA(C1=__builtin_amdgcn_mfma_f32_32x32x16_bf16(kf[1],qr[0],NEGMC,0,0,0), P0[6],P0[7],P0[8],P0[9],     pw0[2]=PKW(P0,4), pw0[3]=PKW(P0,6), pw0); \
    VRD(1); SBAR(); GAPA(C0=__builtin_amdgcn_mfma_f32_32x32x16_bf16(kf[2],qr[1],C0,0,0,0),   P0[10],P0[11],P0[12],P0[13], pw1[0]=PKW(P0,8), pw1[1]=PKW(P0,10), pw1); \
    VRD(5); SBAR(); GAPA(C1=__builtin_amdgcn_mfma_f32_32x32x16_bf16(kf[3],qr[1],C1,0,0,0),   P0[14],P0[15],P1[0],P1[1],   pw1[2]=PKW(P0,12),pw1[3]=PKW(P0,14), pw1); \
    VRD(2); SBAR(); GAPA(C0=__builtin_amdgcn_mfma_f32_32x32x16_bf16(kf[4],qr[2],C0,0,0,0),   P1[2],P1[3],P1[4],P1[5],     pw2[0]=PKW(P1,0), pw2[1]=PKW(P1,2), pw2); \
    VRD(6); SBAR(); GAPA(C1=__builtin_amdgcn_mfma_f32_32x32x16_bf16(kf[5],qr[2],C1,0,0,0),   P1[6],P1[7],P1[8],P1[9],     pw2[2]=PKW(P1,4), pw2[3]=PKW(P1,6), pw2); \
    VRD(3); SBAR(); GAPA(C0=__builtin_amdgcn_mfma_f32_32x32x16_bf16(kf[6],qr[3],C0,0,0,0),   P1[10],P1[11],P1[12],P1[13], pw3[0]=PKW(P1,8), pw3[1]=PKW(P1,10), pw3); \
    VRD(7); SBAR(); GAPA(C1=__builtin_amdgcn_mfma_f32_32x32x16_bf16(kf[7],qr[3],C1,0,0,0),   P1[14],P1[15],0.f,0.f,       pw3[2]=PKW(P1,12),pw3[3]=PKW(P1,14), pw3); \
    l_reg+=sacc; \
    if(GK){DMA_K((t)+3,sl_cur);} if(GV){DMA_V((t)+1,sl_next);} \
    CMASK(C0,C1,t); \
    { float a=MX3(C0[0],C0[1],C1[0]),b=MX3(C0[2],C0[3],C1[1]); a=MX3(a,C1[2],C1[3]); \
      _Pragma("unroll") for(int r=4;r<16;r+=4){a=MX3(a,C0[r],C0[r+1]);b=MX3(b,C0[r+2],C0[r+3]);a=MX3(a,C1[r],C1[r+1]);b=MX3(b,C1[r+2],C1[r+3]);} \
      float rm=__builtin_fmaxf(a,b); { auto rr=__builtin_amdgcn_permlane32_swap(__float_as_uint(rm),__float_as_uint(rm),false,false); rm=__builtin_fmaxf(__uint_as_float(rr[0]),__uint_as_float(rr[1])); } \
      resc=false; \
      if(__builtin_expect(__any(rm>(float)THRL),0)){ const float dl=__builtin_fmaxf(rm,0.f); mhat+=dl; \
        _Pragma("unroll") for(int r=0;r<16;++r){C0[r]-=dl;C1[r]-=dl;} \
        if(MODE==0){ _Pragma("unroll") for(int r=0;r<16;++r)negm[r]=-mhat; asm volatile("":"+v"(negm)); } \
        const float f=__builtin_amdgcn_exp2f(-dl); l_reg*=f; if(hi==0)wsf[r32]=f; resc=true; } } \
    SBAR(); \
    GAPB(o[0]=__builtin_amdgcn_mfma_f32_32x32x16_bf16(PAF(0),VFR(0),o[0],0,0,0), C0,0); \
    GAPB(o[1]=__builtin_amdgcn_mfma_f32_32x32x16_bf16(PAF(0),VFR(4),o[1],0,0,0), C0,4); \
    KRD(GL,0); GAPB(o[0]=__builtin_amdgcn_mfma_f32_32x32x16_bf16(PAF(1),VFR(1),o[0],0,0,0), C0,8); \
    KRD(GL,1); GAPB(o[1]=__builtin_amdgcn_mfma_f32_32x32x16_bf16(PAF(1),VFR(5),o[1],0,0,0), C0,12); \
    KRD(GL,2); GAPB(o[0]=__builtin_amdgcn_mfma_f32_32x32x16_bf16(PAF(2),VFR(2),o[0],0,0,0), C1,0); \
    KRD(GL,3); GAPB(o[1]=__builtin_amdgcn_mfma_f32_32x32x16_bf16(PAF(2),VFR(6),o[1],0,0,0), C1,4); \
    GAPB(o[0]=__builtin_amdgcn_mfma_f32_32x32x16_bf16(PAF(3),VFR(3),o[0],0,0,0), C1,8); \
    GAPB(o[1]=__builtin_amdgcn_mfma_f32_32x32x16_bf16(PAF(3),VFR(7),o[1],0,0,0), C1,12); \
    }while(0)
  int t=1;
  for(;t+5<NT;t+=2){
    STEP(pB0,pB1,pA0,pA1,t,true,true,true);     WAIT_BAR(2); RESC(); ROT();
    STEP(pA0,pA1,pB0,pB1,t+1,true,true,true);   WAIT_BAR(2); RESC(); ROT();
  }
  #define ENDW(tt) do{ if((tt)+3<NT){WAIT_BAR(2);} else if((tt)+2<NT){WAIT_BAR(1);} else {WAIT_BAR(0);} }while(0)
  for(;t+1<NT;t+=2){
    STEP(pB0,pB1,pA0,pA1,t,(t+3<NT),(t+1<NT),(t+1<NT));       ENDW(t);   RESC(); ROT();
    STEP(pA0,pA1,pB0,pB1,t+1,(t+4<NT),(t+2<NT),(t+2<NT));     ENDW(t+1); RESC(); ROT();
  }
  if(nKh){
    const bf16*nks=nKh+(long)lane*DM+wid*8;
    glds16(nks,(unsigned)__builtin_amdgcn_readfirstlane(kdst)); glds16(nks+(long)KVBLK*DM,(unsigned)__builtin_amdgcn_readfirstlane(kdst+SLOTB)); glds16(nks+(long)2*KVBLK*DM,(unsigned)__builtin_amdgcn_readfirstlane(kdst+2*SLOTB));
  }
  STEP(pB0,pB1,pA0,pA1,NT-1,false,false,false); RESC();
  if(nKh){ const bf16*nQt=nQ0+(long)(wid*QBLK+r32)*DM+hi*32;
    glds4(nQt,(unsigned)__builtin_amdgcn_readfirstlane(lds0+LDS_OST+NW*2048+wid*256));
    if(wid<2) glds4(nVh+(long)(wid*64+lane)*DM,(unsigned)__builtin_amdgcn_readfirstlane(lds0+LDS_OST+NW*2048+NW*256+wid*256)); }
  { float sacc=pB0[0]+pB0[1]; _Pragma("unroll") for(int r=2;r<16;++r)sacc+=pB0[r]; _Pragma("unroll") for(int r=0;r<16;++r)sacc+=pB1[r]; l_reg+=sacc;
    pw0=(u32x4){PKW(pB0,0),PKW(pB0,2),PKW(pB0,4),PKW(pB0,6)};pw1=(u32x4){PKW(pB0,8),PKW(pB0,10),PKW(pB0,12),PKW(pB0,14)};pw2=(u32x4){PKW(pB1,0),PKW(pB1,2),PKW(pB1,4),PKW(pB1,6)};pw3=(u32x4){PKW(pB1,8),PKW(pB1,10),PKW(pB1,12),PKW(pB1,14)};
    SBAR(); pv(o,vb0+sl_cur,PAF(0),PAF(1),PAF(2),PAF(3)); }
  #undef PKW
  #undef PAF
  #undef VFR
  #undef PIN
  #undef MX3
  #undef GAPA
  #undef GAPB
  #undef EX
  #undef VRD
  #undef KRD
  #undef STEP
  #undef ENDW
  {auto rr=__builtin_amdgcn_permlane32_swap(__float_as_uint(l_reg),__float_as_uint(l_reg),false,false);l_reg=__uint_as_float(rr[0])+__uint_as_float(rr[1]);}
  if(hi==0)wsf[32+r32]=l_reg;asm volatile("s_waitcnt lgkmcnt(0)":::"memory");
  float rli[16];
  #pragma unroll
  for(int r=0;r<16;++r)rli[r]=__builtin_amdgcn_rcpf(wsf[32+crow(r,hi)]);
  unsigned char*Ow=O0+(long)wid*QBLK*ATTN_OPITCH;
  { unsigned char*stg=(unsigned char*)(shm+LDS_OST)+wid*2048;
    #pragma unroll
    for(int r=0;r<16;++r){const int orow=crow(r,hi); const float sc=rli[r]*ATTN_OSCALE;
      const unsigned w=(unsigned)__builtin_amdgcn_cvt_pk_fp8_f32(__builtin_amdgcn_fmed3f(o[0][r]*sc,-448.f,448.f),__builtin_amdgcn_fmed3f(o[1][r]*sc,-448.f,448.f),0,false);
      stg[orow*64+r32]=(unsigned char)w; stg[orow*64+32+r32]=(unsigned char)(w>>8);}
    asm volatile("s_waitcnt lgkmcnt(0)":::"memory");
    #pragma unroll
    for(int i=0;i<2;++i){const int row=i*16+(lane>>2),ch=lane&3; const u32x4 v=*(const u32x4*)(stg+row*64+ch*16); ATTN_STORE16(Ow+(long)row*ATTN_OPITCH+ch*16,v);} }
  asm volatile("s_waitcnt lgkmcnt(0)\n\ts_barrier":::"memory");
  #undef TILE
  #undef DMA_K
  #undef DMA_V
  #undef CMASK
  #undef NEGMC
  #undef START
  #undef RESC
  #undef ROT
}
constexpr int ATTN_LDS_BYTES=LDS_BYTES+NATAB_BYTES;
#undef SBAR
#undef WAIT_BAR
}
#define GAS __attribute__((address_space(1)))
#define LAS __attribute__((address_space(3)))
typedef unsigned short bf16;
typedef unsigned v4u __attribute__((ext_vector_type(4)));
typedef float f32x4 __attribute__((ext_vector_type(4)));
typedef short bf16x8 __attribute__((ext_vector_type(8)));
typedef GAS unsigned gu32;
typedef GAS unsigned long long gu64;
#define RLX_AGENT __ATOMIC_RELAXED, __HIP_MEMORY_SCOPE_AGENT
#define LDS_WAIT() asm volatile("s_waitcnt lgkmcnt(0)" ::: "memory")
#define VM_WAIT() asm volatile("s_waitcnt vmcnt(0)" ::: "memory")
__device__ __forceinline__ unsigned long long rt() { return __builtin_amdgcn_s_memrealtime(); }
__device__ __forceinline__ unsigned f2bf(float f) { unsigned u = __builtin_bit_cast(unsigned, f); return (u + 0x7fffu + ((u >> 16) & 1u)) >> 16; }
typedef float f32x2_pk __attribute__((ext_vector_type(2))); typedef __bf16 bf16x2_pk __attribute__((ext_vector_type(2)));
__device__ __forceinline__ unsigned pk2(float lo, float hi) { const f32x2_pk v = {lo, hi}; return __builtin_bit_cast(unsigned, __builtin_convertvector(v, bf16x2_pk)); }

#define XB_TMO      128
#define XB_XCNT(j)  (256  + 64 * (j))
#define XB_XSUB(j)  (1280 + 64 * (j))
#define XB_XGEN(j)  (2304 + 64 * (j))
#define XB_TOP      3328
#define XB_TOPGEN   3392
#define XCD_BAR_WORDS 3456
#define XB_SPIN_CAP (1u << 18)

__device__ __forceinline__ unsigned xb_ld(unsigned* p)              { return __hip_atomic_load(p, __ATOMIC_RELAXED, __HIP_MEMORY_SCOPE_AGENT); }
__device__ __forceinline__ unsigned xb_add(unsigned* p, unsigned v) { return __hip_atomic_fetch_add(p, v, __ATOMIC_RELAXED, __HIP_MEMORY_SCOPE_AGENT); }
__device__ __forceinline__ unsigned xb_xcc_id() { return (unsigned)__builtin_amdgcn_s_getreg((3 << 11) | 20) & 0xFu; }
#define XB_SPIN(cond, bar) do { unsigned _sp = 0; while (cond) { __builtin_amdgcn_s_sleep(1); \
    if ((++_sp & 255u) == 0u) { if (xb_ld(&(bar)[XB_TMO])) break; if (_sp > XB_SPIN_CAP) { atomicAdd(&(bar)[XB_TMO], 1u); break; } } } } while (0)

struct XcdBarrier {
    unsigned* bar; unsigned x;
    volatile LAS unsigned* st;
};

__device__ __forceinline__ XcdBarrier xcd_barrier_post(unsigned* bar, volatile LAS unsigned* st) {
    XcdBarrier b; b.bar = bar; b.x = xb_xcc_id(); b.st = st;
    if (threadIdx.x == 0) (void)xb_add(&bar[XB_XCNT(b.x)], 1u);
    return b;
}
__device__ __forceinline__ void xcd_barrier_complete(unsigned* bar, unsigned x, unsigned& nloc, unsigned& nx) {
    const unsigned G = gridDim.x * gridDim.y * gridDim.z;
    unsigned sum, cnt, mine, sp = 0u;
    for (;;) {
        sum = 0u; cnt = 0u; mine = 0u;
#pragma unroll
        for (unsigned j = 0; j < 16; ++j) { const unsigned c = xb_ld(&bar[XB_XCNT(j)]); sum += c; cnt += (c > 0u) ? 1u : 0u; mine = (j == x) ? c : mine; }
        if (sum == G) break;
        __builtin_amdgcn_s_sleep(1);
        if ((++sp & 255u) == 0u) { if (xb_ld(&bar[XB_TMO])) break; if (sp > XB_SPIN_CAP) { atomicAdd(&bar[XB_TMO], 1u); break; } }
    }
    nloc = mine > 0u ? mine : 1u; nx = cnt > 0u ? cnt : 1u;
}

__device__ __forceinline__ void xcd_barrier(const XcdBarrier& b) {
    asm volatile("s_waitcnt vmcnt(0)" ::: "memory");
    __syncthreads();
    if (threadIdx.x == 0) {
        unsigned* bar = b.bar;
        __builtin_amdgcn_s_waitcnt(0);
        unsigned nloc = b.st[0], nx = b.st[1];
        if (nloc == 0u) { xcd_barrier_complete(bar, b.x, nloc, nx); b.st[0] = nloc; b.st[1] = nx; }
        const unsigned old = xb_add(&bar[XB_XSUB(b.x)], 1u);
        const unsigned gen = old / nloc;
        if (old + 1u == (gen + 1u) * nloc) {
            __builtin_amdgcn_fence(__ATOMIC_RELEASE, "agent");
            asm volatile("s_waitcnt vmcnt(0)" ::: "memory");
            const unsigned og = xb_add(&bar[XB_TOP], 1u);
            const unsigned tg = og / nx;
            if (og + 1u == (tg + 1u) * nx) xb_add(&bar[XB_TOPGEN], 1u);
            else XB_SPIN(xb_ld(&bar[XB_TOPGEN]) == tg, bar);
            __builtin_amdgcn_fence(__ATOMIC_ACQUIRE, "agent");
            xb_add(&bar[XB_XGEN(b.x)], 1u);
            asm volatile("s_waitcnt vmcnt(0)" ::: "memory");
        } else {
            XB_SPIN(xb_ld(&bar[XB_XGEN(b.x)]) == gen, bar);
            __builtin_amdgcn_fence(__ATOMIC_ACQUIRE, "agent");
            asm volatile("s_waitcnt vmcnt(0)" ::: "memory");
        }
    }
    __syncthreads();
}
constexpr int DMODEL = 1024, NB = 32, SEQ = 2048, CTXL = 256, SB = SEQ + CTXL  , DEPTH = 2, NE = 16;
#ifndef MK_NCHUNK
#define MK_NCHUNK 2
#endif
constexpr int NCHUNK = MK_NCHUNK, BC = NB / NCHUNK, MC = BC * SB;
constexpr int PW = 4352, NPROJ = 7424, GW = NPROJ - PW;
constexpr int C_LX = 0, C_LG = 1024, C_NQ = 2048, C_GQ = 2560, C_NK = 3072, C_NV = 3584, C_GK = 4096, C_GV = 4224;
constexpr float EPS = 1e-6f;
constexpr float QSCALE = 0.125f * 1.4426950408889634f;
constexpr int NMOD = 6 * DMODEL;

enum { I_X = 0, I_C, I_CTX, I_CCTX, I_WMOD, I_BMOD, I_NORMG, I_WIN, I_CONVW, I_CONVB, I_LWA, I_LBA, I_LWX, I_LBX, I_LLAM, I_RPB, I_QNG, I_KNG, I_WOA, I_WOB, I_WOC, I_WOUT, I_WR, I_WG, I_WU, I_WD, N_IN };

struct Args { const float* in[N_IN]; float* out; unsigned char* ws; int ph_lo, ph_hi; };
constexpr size_t MiB = 1u << 20;
constexpr size_t WS_CTL = 0, CTL_ZERO_BYTES = 3 * MiB;
constexpr size_t CTL_MOD_OFF = 1 * MiB;
constexpr int CW_TMO = 0, CW_BAR = 4096;
constexpr size_t WS_W = 4 * MiB, LW = 64 * MiB;
constexpr size_t W_P = 0, W_O = 8 * MiB, W_OUT = 12 * MiB, W_LRU = 14 * MiB, W_GU = 16 * MiB, W_D = 48 * MiB;
constexpr size_t WS_XR = 132 * MiB;
constexpr size_t WS_H = 276 * MiB;
constexpr size_t WS_HT = 348 * MiB;
constexpr size_t WS_AFFEN = 420 * MiB, WS_AFFNE = 423 * MiB, WS_SLOT = 426 * MiB;
constexpr size_t WS_ROWIDX = WS_SLOT + 3 * MiB;
static_assert((size_t)MC * NE * 4 <= 3 * MiB && WS_ROWIDX + (size_t)(NE * BC * 288) * 4 <= 430 * MiB, "slot / row-list map");
constexpr size_t WS_P = 430 * MiB;
constexpr size_t WS_O1 = WS_P, WS_HS = WS_P + 72 * MiB, WS_ACT = WS_P + 216 * MiB;
constexpr size_t WS_G8 = WS_P + (size_t)MC * PW * 2;
constexpr size_t WS_M8 = WS_G8 + (size_t)MC * GW;
constexpr float M8_SA = 4.f, M8_SB = 32.f, MQ_S = 16.f;
constexpr size_t WS_END = WS_M8 + (size_t)MC * 2048;
static_assert(NCHUNK == 2, "the workspace map below is laid out for two chunks");
static_assert(WS_END <= 1024 * MiB && (size_t)MC * 1024 * 2 <= 72 * MiB && WS_ACT + 72 * MiB <= WS_G8 && WS_HS + 144 * MiB <= WS_ACT, "d_ws map");
static_assert(CTL_MOD_OFF + (size_t)DEPTH * 33 * NMOD * 4 <= CTL_ZERO_BYTES, "mod accumulators inside the memset region");

constexpr int RING_BYTES = 131072, LDSCTL_OFF = 135168  , MISC_OFF = LDSCTL_OFF + 320, LDS_BYTES = 147456;
static_assert(8 * 16640 <= LDSCTL_OFF && MISC_OFF + 128 <= LDS_BYTES, "LDS map");

__device__ __forceinline__ float bf2f(unsigned v) { return __uint_as_float(v << 16); }
__device__ __forceinline__ float shfl_idx(float v, int src) { return __builtin_bit_cast(float, __builtin_amdgcn_ds_bpermute(src << 2, __builtin_bit_cast(int, v))); }
__device__ __forceinline__ float shx(float v, int m, int lane) { return shfl_idx(v, lane ^ m); }
#define DPPF(v, CTRL) __builtin_bit_cast(float, __builtin_amdgcn_update_dpp(0, __builtin_bit_cast(int, (v)), (CTRL), 0xf, 0xf, false))
__device__ __forceinline__ float sum16(float v) {
    v += DPPF(v, 0xB1); v += DPPF(v, 0x4E); v += DPPF(v, 0x141); v += DPPF(v, 0x140); return v; }
__device__ __forceinline__ float swap16_sum(float v) { const auto r = __builtin_amdgcn_permlane16_swap(__float_as_uint(v), __float_as_uint(v), false, false); return __uint_as_float(r[0]) + __uint_as_float(r[1]); }
__device__ __forceinline__ float swap32_sum(float v) { const auto r = __builtin_amdgcn_permlane32_swap(__float_as_uint(v), __float_as_uint(v), false, false); return __uint_as_float(r[0]) + __uint_as_float(r[1]); }
__device__ __forceinline__ float swap16_get(float v, int lane) { const auto r = __builtin_amdgcn_permlane16_swap(__float_as_uint(v), __float_as_uint(v), false, false); return __uint_as_float((lane & 16) ? r[0] : r[1]); }
__device__ __forceinline__ float swap32_get(float v, int lane) { const auto r = __builtin_amdgcn_permlane32_swap(__float_as_uint(v), __float_as_uint(v), false, false); return __uint_as_float((lane & 32) ? r[0] : r[1]); }
__device__ __forceinline__ float wave_sum(float v, int lane) { (void)lane; return swap32_sum(swap16_sum(sum16(v))); }
__device__ __forceinline__ float half_sum(float v) { return swap16_sum(sum16(v)); }
#define PH_IDS int tid_ = threadIdx.x; asm volatile("" : "+v"(tid_)); const int tid = tid_, lane = tid & 63, wid = __builtin_amdgcn_readfirstlane(tid >> 6); \
    int vcu_ = F.vcu; asm volatile("" : "+s"(vcu_)); const int vcu = vcu_; (void)vcu; (void)wid; (void)lane;
__device__ __forceinline__ float fast_rcp(float x) { return __builtin_amdgcn_rcpf(x); }
__device__ __forceinline__ float sigmoidf_(float x) { return fast_rcp(1.f + __expf(-x)); }

struct Frame {
    LAS unsigned char* lds;
    int vcu, G;
    float* out; unsigned char* ws;
};

__device__ __forceinline__ void tr_item(const float* W, int ldw, bf16* WT, int ldt, int k0, int n0, int drow0, int dk0, float scale, LAS float* scr, int lane) {
    float t_[32];
#pragma unroll
    for (int i = 0; i < 32; ++i) { const int kk = 2 * i + (lane >> 5); t_[i] = W[(size_t)(k0 + kk) * ldw + n0 + (lane & 31)]; }
#pragma unroll
    for (int i = 0; i < 32; ++i) { const int kk = 2 * i + (lane >> 5); scr[kk * 33 + (lane & 31)] = t_[i] * scale; }
    LDS_WAIT(); asm volatile("" ::: "memory");
    const int c = lane & 7;
#pragma unroll
    for (int j = 0; j < 4; ++j) { const int n = (lane >> 3) + 8 * j; const LAS float* s = scr + (8 * c) * 33 + n;
        v4u o; o.x = pk2(s[0 * 33], s[1 * 33]); o.y = pk2(s[2 * 33], s[3 * 33]); o.z = pk2(s[4 * 33], s[5 * 33]); o.w = pk2(s[6 * 33], s[7 * 33]);
        *(GAS v4u*)(WT + (size_t)(drow0 + n) * ldt + dk0 + 8 * c) = o; }
    LDS_WAIT(); asm volatile("" ::: "memory");
}

__device__ __forceinline__ unsigned pk4_fp8(float a, float b, float c, float d) { int w = __builtin_amdgcn_cvt_pk_fp8_f32(a, b, 0, false); w = __builtin_amdgcn_cvt_pk_fp8_f32(c, d, w, true); return (unsigned)w; }
__device__ __forceinline__ void tr_item_fp8(const float* W, int ldw, unsigned char* WT, int ldt, int k0, int n0, int drow0, int dk0, float scale, LAS float* scr, int lane) {
    f32x4 t_[16];
#pragma unroll
    for (int i = 0; i < 16; ++i) t_[i] = __builtin_nontemporal_load((const f32x4*)(W + (size_t)(k0 + 4 * i + (lane >> 4)) * ldw + n0 + 4 * (lane & 15)));
#pragma unroll
    for (int i = 0; i < 16; ++i) { LAS float* d = scr + (4 * i + (lane >> 4)) * 65 + 4 * (lane & 15); d[0] = t_[i].x * scale; d[1] = t_[i].y * scale; d[2] = t_[i].z * scale; d[3] = t_[i].w * scale; }
    LDS_WAIT(); asm volatile("" ::: "memory");
    const LAS float* s = scr + lane;
    GAS v4u* dst = (GAS v4u*)(WT + (size_t)(drow0 + lane) * ldt + dk0);
#pragma unroll
    for (int q4 = 0; q4 < 4; ++q4) { unsigned o[4];
#pragma unroll
        for (int q = 0; q < 4; ++q) { const int k = 16 * q4 + 4 * q; o[q] = pk4_fp8(s[k * 65], s[(k + 1) * 65], s[(k + 2) * 65], s[(k + 3) * 65]); }
        dst[q4] = (v4u){o[0], o[1], o[2], o[3]}; }
    LDS_WAIT(); asm volatile("" ::: "memory");
}

constexpr int IT_WIN = 16 * 116, IT_WOA = 256, IT_WOB = 128, IT_WOC = 128, IT_WOUT = 256, IT_LRU = 256, IT_GU = 16 * 512, IT_D = 16 * 256;
constexpr int IT_LAYER = IT_WIN + IT_WOA + IT_WOB + IT_WOC + IT_WOUT + IT_LRU + IT_GU + IT_D;
__device__ __forceinline__ void ph_prologue(const Args& A_, Frame& F) {
    PH_IDS
    float* mod = (float*)(F.ws + CTL_MOD_OFF);
    const int q0 = vcu + F.G * wid, NADA = DEPTH * 96 * 3, nconv = F.G * 8 - NADA; const bool split = nconv >= F.G * 4;
    for (int q = q0; q < NADA; q += F.G * 8) {
        const int l = q / 288, rem = q % 288, g = rem / 3, r0 = (rem % 3) * 11;
        const float* W = A_.in[I_WMOD] + (size_t)l * DMODEL * NMOD + g * 64 + lane;
        float acc[11];
#pragma unroll
        for (int i = 0; i < 11; ++i) acc[i] = 0.f;
        float wA[32], wB[32], cn[11];
#define ADA_LOADW(dst, kb_, h_) do { const float* Wk_ = W + (size_t)((kb_) * 64 + 32 * (h_)) * NMOD; _Pragma("unroll") for (int kk = 0; kk < 32; ++kk) dst[kk] = Wk_[(size_t)kk * NMOD]; } while (0)
#define ADA_LOADC(kb_) do { _Pragma("unroll") for (int i = 0; i < 11; ++i) { const int r = r0 + i; cn[i] = (r < 32) ? A_.in[I_C][r * DMODEL + (kb_) * 64 + lane] : A_.in[I_CCTX][(kb_) * 64 + lane]; } } while (0)
#define ADA_FMA(src, h_) do { _Pragma("unroll") for (int kk = 0; kk < 32; ++kk) _Pragma("unroll") for (int i = 0; i < 11; ++i) \
            acc[i] += __builtin_bit_cast(float, __builtin_amdgcn_readlane(__builtin_bit_cast(int, sv[i]), 32 * (h_) + kk)) * src[kk]; } while (0)
        ADA_LOADC(0); ADA_LOADW(wA, 0, 0);
        for (int kb = 0; kb < 16; ++kb) {
            float sv[11];
#pragma unroll
            for (int i = 0; i < 11; ++i) sv[i] = cn[i] * sigmoidf_(cn[i]);
            if (kb + 1 < 16) ADA_LOADC(kb + 1);
            ADA_LOADW(wB, kb, 1);
            ADA_FMA(wA, 0);
            if (kb + 1 < 16) ADA_LOADW(wA, kb + 1, 0);
            ADA_FMA(wB, 1);
        }
#undef ADA_LOADW
#undef ADA_LOADC
#undef ADA_FMA
        const float bm = A_.in[I_BMOD][l * NMOD + g * 64 + lane];
        const int seg = (g * 64) >> 10, cc = ((g * 64) & 1023) + lane;
        const float ngv = (seg == 1) ? A_.in[I_NORMG][(l * 4 + 0) * DMODEL + cc] : (seg == 2) ? A_.in[I_NORMG][(l * 4 + 1) * DMODEL + cc] : (seg == 4) ? A_.in[I_NORMG][(l * 4 + 2) * DMODEL + cc] : (seg == 5) ? A_.in[I_NORMG][(l * 4 + 3) * DMODEL + cc] : 1.f;
        const float one = (seg == 1 || seg == 4) ? 1.f : 0.f;
#pragma unroll
        for (int i = 0; i < 11; ++i) mod[(size_t)(l * 33 + r0 + i) * NMOD + g * 64 + lane] = (acc[i] + bm + one) * ngv;
    }
    LAS float* scr = (LAS float*)(F.lds + wid * 16640);
    const int gw = split ? q0 - NADA : vcu * 8 + wid, NGW = split ? nconv : F.G * 8;
    for (int it = (gw >= 0 ? gw : DEPTH * IT_LAYER); it < DEPTH * IT_LAYER; it += NGW) {
        const int l = it / IT_LAYER; int r = it - l * IT_LAYER;
        unsigned char* wl = F.ws + WS_W + (size_t)l * LW;
        if (r < IT_WIN) { const int k0 = 64 * (r / 116), n0 = 64 * (r % 116);
            const int dr = (n0 < 2560) ? n0 : (n0 < 3584) ? n0 + 512 : (n0 < 4096) ? n0 - 1024 : n0;
            const float sc = (n0 >= 2048 && n0 < 2560) ? QSCALE : 1.f;
            tr_item_fp8(A_.in[I_WIN] + (size_t)l * DMODEL * NPROJ, NPROJ, wl + W_P, 1024, k0, n0, dr, k0, sc * 64.f, scr, lane); continue; } r -= IT_WIN;
        if (r < IT_WOA) { const int k0 = 64 * (r / 16), n0 = 64 * (r % 16); tr_item_fp8(A_.in[I_WOA] + (size_t)l * 1024 * 1024, 1024, wl + W_O, 2048, k0, n0, n0, k0, 64.f, scr, lane); continue; } r -= IT_WOA;
        if (r < IT_WOB) { const int k0 = 64 * (r / 16), n0 = 64 * (r % 16); tr_item_fp8(A_.in[I_WOB] + (size_t)l * 512 * 1024, 1024, wl + W_O, 2048, k0, n0, n0, 1024 + k0, 64.f, scr, lane); continue; } r -= IT_WOB;
        if (r < IT_WOC) { const int k0 = 64 * (r / 16), n0 = 64 * (r % 16); tr_item_fp8(A_.in[I_WOC] + (size_t)l * 512 * 1024, 1024, wl + W_O, 2048, k0, n0, n0, 1536 + k0, 64.f, scr, lane); continue; } r -= IT_WOC;
        if (r < IT_WOUT) { const int k0 = 64 * (r / 16), n0 = 64 * (r % 16); tr_item_fp8(A_.in[I_WOUT] + (size_t)l * 1024 * 1024, 1024, wl + W_OUT, 1024, k0, n0, n0, k0, 64.f, scr, lane); continue; } r -= IT_WOUT;
        if (r < IT_LRU) { const int mi = r >> 3, sub = r & 7, dir = mi >> 4, mat = (mi >> 3) & 1, blk = mi & 7, k0 = 64 * (sub >> 2), n0 = 32 * (sub & 3);
            const float* src = (mat ? A_.in[I_LWX] : A_.in[I_LWA]) + (size_t)((l * 2 + dir) * 8 + blk) * 128 * 128;
            tr_item(src, 128, (bf16*)(wl + W_LRU) + (size_t)((dir * 2 + mat) * 8 + blk) * 128 * 128, 128, k0, n0, n0, k0, 1.f, scr, lane); continue; } r -= IT_LRU;
        if (r < IT_GU) { const int e = r >> 9, rr = r & 511, mat = rr >> 8, q = rr & 255, k0 = 64 * (q / 16), n0 = 64 * (q % 16);
            const float* src = (mat ? A_.in[I_WU] : A_.in[I_WG]) + (size_t)(l * NE + e) * 1024 * 1024;
            tr_item_fp8(src, 1024, wl + W_GU + (size_t)e * 2048 * 1024, 1024, k0, n0, (n0 >> 7) * 256 + mat * 128 + (n0 & 127), k0, 64.f, scr, lane); continue; } r -= IT_GU;
        { const int e = r >> 8, q = r & 255, k0 = 64 * (q / 16), n0 = 64 * (q % 16);
            tr_item_fp8(A_.in[I_WD] + (size_t)(l * NE + e) * 1024 * 1024, 1024, wl + W_D + (size_t)e * 1024 * 1024, 1024, k0, n0, n0, k0, 64.f, scr, lane); }
    }
}

__device__ __forceinline__ void row_load(const float* p, int lane, f32x4 (&v)[4]) {
#pragma unroll
    for (int j = 0; j < 4; ++j) v[j] = ((const f32x4*)p)[lane + 64 * j];
}
__device__ __forceinline__ float row_rstd(const f32x4 (&v)[4], int lane) {
    float s = 0.f;
#pragma unroll
    for (int j = 0; j < 4; ++j) s += (v[j].x * v[j].x + v[j].y * v[j].y) + (v[j].z * v[j].z + v[j].w * v[j].w);
    return rsqrtf(wave_sum(s, lane) * (1.f / DMODEL) + EPS);
}
__device__ __forceinline__ void row_store_bf16(bf16* p, int lane, const f32x4 (&v)[4]) {
#pragma unroll
    for (int j = 0; j < 4; ++j) ((unsigned long long*)p)[lane + 64 * j] = (unsigned long long)pk2(v[j].x, v[j].y) | ((unsigned long long)pk2(v[j].z, v[j].w) << 32);
}
__device__ __forceinline__ void row_store_fp8(unsigned char* p, int lane, const f32x4 (&v)[4]) {
#pragma unroll
    for (int j = 0; j < 4; ++j) ((unsigned*)p)[lane + 64 * j] = pk4_fp8(v[j].x, v[j].y, v[j].z, v[j].w);
}
__device__ __forceinline__ void row_load_bf16(const bf16* p, int lane, f32x4 (&v)[4]) {
#pragma unroll
    for (int j = 0; j < 4; ++j) { const unsigned long long w = ((const unsigned long long*)p)[lane + 64 * j];
        v[j].x = bf2f((unsigned)w & 0xffffu); v[j].y = bf2f(((unsigned)w >> 16)); v[j].z = bf2f((unsigned)(w >> 32) & 0xffffu); v[j].w = bf2f((unsigned)(w >> 48)); }
}
__device__ __forceinline__ const float* res_in(const Args& A_, int b, int s) {
    if (s < CTXL) return A_.in[I_CTX] + ((size_t)b * CTXL + s) * DMODEL;
    return A_.in[I_X] + ((size_t)b * SEQ + (s - CTXL)) * DMODEL;
}
__device__ __forceinline__ bf16* res_xr(const Frame& F, int b, int s) { return (bf16*)(F.ws + WS_XR) + ((size_t)b * SB + s) * DMODEL; }
__device__ __forceinline__ const float* mod_row(const Args& A_, const Frame& F, int l, int b, int s) { return (const float*)(F.ws + CTL_MOD_OFF) + (size_t)(l * 33 + (s < CTXL ? 32 : b)) * NMOD; }

__device__ __forceinline__ void ph_norm1(const Args& A_, Frame& F, int l, int ch) {
    PH_IDS
    const int gw = vcu * 8 + wid, NGW = F.G * 8;
    bf16* H = (bf16*)(F.ws + WS_H);
    f32x4 vn[4]; unsigned long long vb[4];
    if (gw < MC) { const int bl = gw / SB, s = gw - bl * SB, b = ch * BC + bl;
#pragma unroll
        for (int j = 0; j < 4; ++j) { if (l == 0) vn[j] = __builtin_nontemporal_load((const f32x4*)res_in(A_, b, s) + lane + 64 * j); else vb[j] = ((const unsigned long long*)res_xr(F, b, s))[lane + 64 * j]; } }
    for (int row = gw; row < MC; row += NGW) {
        const int bl = row / SB, s = row - bl * SB, b = ch * BC + bl;
        f32x4 v[4];
#pragma unroll
        for (int j = 0; j < 4; ++j) { if (l == 0) v[j] = vn[j]; else { const unsigned long long w = vb[j]; v[j].x = bf2f((unsigned)w & 0xffffu); v[j].y = bf2f(((unsigned)w >> 16)); v[j].z = bf2f((unsigned)(w >> 32) & 0xffffu); v[j].w = bf2f((unsigned)(w >> 48)); } }
        if (row + NGW < MC) { const int r2 = row + NGW, bl2 = r2 / SB, s2 = r2 - bl2 * SB, b2 = ch * BC + bl2;
#pragma unroll
            for (int j = 0; j < 4; ++j) { if (l == 0) vn[j] = __builtin_nontemporal_load((const f32x4*)res_in(A_, b2, s2) + lane + 64 * j); else vb[j] = ((const unsigned long long*)res_xr(F, b2, s2))[lane + 64 * j]; } }
        const float rstd = row_rstd(v, lane);
        const float* mr = mod_row(A_, F, l, b, s);
#pragma unroll
        for (int j = 0; j < 4; ++j) { const f32x4 sh = ((const f32x4*)mr)[lane + 64 * j], c0 = ((const f32x4*)(mr + DMODEL))[lane + 64 * j];
            v[j] = (v[j] * rstd) * c0 + sh; }
        row_store_fp8((unsigned char*)H + (size_t)row * DMODEL, lane, v);
    }
}

__device__ __forceinline__ void ph_prep(const Args& A_, Frame& F, int l) {
    PH_IDS
    const int gw = vcu * 8 + wid, NGW = F.G * 8;
    bf16* P = (bf16*)(F.ws + WS_P);
    const int l7 = lane & 7, kr = lane >> 4, d0 = (l7 & 3) * 8;
    const float sg = (l7 >= 4) ? 1.f : -1.f;
    float gq[8], gk[8], invf[8];
#pragma unroll
    for (int e = 0; e < 8; ++e) { gq[e] = A_.in[I_QNG][l * 64 + l7 * 8 + e] * QSCALE; gk[e] = A_.in[I_KNG][l * 64 + l7 * 8 + e];
        invf[e] = __builtin_amdgcn_exp2f(-(float)((d0 + e) & 15) * (13.287712379549449f / 16.f)) * 0.15915494309189535f; }
    constexpr int NR = 4;
    const int nrw = (MC - gw + NGW - 1) / NGW, ngr = (nrw + NR - 1) / NR;
    v4u qn[NR], kn;
#define PREP_FETCH(g) do { _Pragma("unroll") for (int r = 0; r < NR; ++r) { const int row_ = gw + ((g) * NR + r) * NGW; qn[r] = __builtin_nontemporal_load((const v4u*)(P + (size_t)(row_ < MC ? row_ : gw) * PW + C_GQ + lane * 8)); } \
        { const int row_ = gw + ((g) * NR + kr) * NGW; kn = __builtin_nontemporal_load((const v4u*)(P + (size_t)(row_ < MC ? row_ : gw) * PW + C_GK + (lane & 15) * 8)); } } while (0)
#define PREP_X4(v) DPPF(DPPF((v), 0x141), 0x1B)
#define PREP_DO(w, g_, lat_, t_, out) do { float x_[8]; _Pragma("unroll") for (int k = 0; k < 4; ++k) { x_[2 * k] = bf2f((w)[k] & 0xffffu); x_[2 * k + 1] = __uint_as_float((w)[k] & 0xffff0000u); } \
        float ss_ = 0.f; _Pragma("unroll") for (int e = 0; e < 8; ++e) ss_ += x_[e] * x_[e]; \
        ss_ += DPPF(ss_, 0xB1); ss_ += DPPF(ss_, 0x4E); ss_ += DPPF(ss_, 0x141); \
        const float rs_ = rsqrtf(ss_ * (1.f / 64.f) + EPS); const float pos_ = (float)((d0 < 16) ? ((t_) >> 6) : ((t_) & 63)); float o_[8]; \
        _Pragma("unroll") for (int e = 0; e < 8; ++e) { const float y_ = x_[e] * rs_ * g_[e]; const float yp_ = PREP_X4(y_); \
            const float fr_ = __builtin_amdgcn_fractf(pos_ * invf[e]); const float cs_ = (lat_) ? __builtin_amdgcn_cosf(fr_) : 1.f, sn_ = (lat_) ? __builtin_amdgcn_sinf(fr_) : 0.f; \
            o_[e] = y_ * cs_ + sg * (yp_ * sn_); } \
        out = (v4u){pk2(o_[0], o_[1]), pk2(o_[2], o_[3]), pk2(o_[4], o_[5]), pk2(o_[6], o_[7])}; } while (0)
    PREP_FETCH(0);
    for (int g = 0; g < ngr; ++g) {
        v4u qc[NR], kc = kn;
#pragma unroll
        for (int r = 0; r < NR; ++r) qc[r] = qn[r];
        if (g + 1 < ngr) PREP_FETCH(g + 1);
#pragma unroll
        for (int r = 0; r < NR; ++r) { const int row = gw + (g * NR + r) * NGW;
            if (row < MC) { const int s = row % SB; const bool lat = s >= CTXL; const int t = s - CTXL; v4u o; PREP_DO(qc[r], gq, lat, t, o);
                *(v4u*)(P + (size_t)row * PW + C_GQ + lane * 8) = o; } }
        { const int row = gw + (g * NR + kr) * NGW; const int rc = row < MC ? row : gw; const int s = rc % SB; const bool lat = s >= CTXL; const int t = s - CTXL; v4u o; PREP_DO(kc, gk, lat, t, o);
            if (row < MC) *(v4u*)(P + (size_t)row * PW + C_GK + (lane & 15) * 8) = o; }
    }
#undef PREP_FETCH
#undef PREP_X4
#undef PREP_DO
}
constexpr int LRU_UP = 136;
constexpr int LRU_UB = 64 * LRU_UP * 2, LRU_OP = 144, LRU_OB = 64 * LRU_OP;
constexpr int LRU_U0 = 0, LRU_O0 = 4 * LRU_UB, LRU_CW = LRU_O0 + 4 * LRU_OB;
static_assert(LRU_CW + 640 * 4 <= RING_BYTES, "LRU LDS map");
__device__ __forceinline__ float gelu_tanh(float g) { const float z = 0.7978845608028654f * (g + 0.044715f * g * g * g); return g * (1.f - fast_rcp(1.f + __expf(2.f * z))); }
__device__ __forceinline__ int lru_chunk(int dir, int s) { return dir == 0 ? s : (s < 4 ? 3 - s : 39 - s); }
__device__ __forceinline__ bool lru_first(int s) { return s < 4 ? (s <= 1) : (s <= 19); }
__device__ __forceinline__ void ph_lru(const Args& A_, Frame& F, int l) {
    PH_IDS
    const int fr = lane & 15, fq = lane >> 4, nt = wid & 3, dir = wid >> 2;
    bf16* P = (bf16*)(F.ws + WS_P); bf16* HT = (bf16*)(F.ws + WS_HT); unsigned char* M8 = F.ws + WS_M8;
    const bf16* WL = (const bf16*)(F.ws + WS_W + (size_t)l * LW + W_LRU);
    LAS unsigned char* lds = F.lds;
    LAS float* CW = (LAS float*)(lds + LRU_CW);
    for (int item = blockIdx.x; item < BC * 16; item += F.G) {
        const int bl = item >> 4, cb = item & 15, blk = cb >> 1, half = cb & 1;
        const int cdir = tid >> 8, ctg = (tid >> 4) & 15, cgrp = tid & 15, tb = cdir ? 58 - 4 * ctg : 4 * ctg - 2;
        __syncthreads();
        for (int i = tid; i < 640; i += 512) CW[i] = (i < 512) ? A_.in[I_CONVW][(size_t)(l * 4 + (i >> 7)) * 1024 + blk * 128 + (i & 127)] : A_.in[I_CONVB][l * 1024 + blk * 128 + (i - 512)];
        __syncthreads();
        const int otok = (tid >> 3) & 63, og = tid & 7;
        const int chl = half * 64 + nt * 16 + fr, chan = blk * 128 + chl;
        bf16x8 Bf[2][4];
#pragma unroll
        for (int mat = 0; mat < 2; ++mat)
#pragma unroll
            for (int ks = 0; ks < 4; ++ks) Bf[mat][ks] = *(const bf16x8*)(WL + ((size_t)((dir * 2 + mat) * 8 + blk) * 128 + chl) * 128 + ks * 32 + fq * 8);
        const float ba = A_.in[I_LBA][(l * 2 + dir) * 1024 + chan], bx = A_.in[I_LBX][(l * 2 + dir) * 1024 + chan];
        const float nba = -1.4426950408889634f * ba, nbx = -1.4426950408889634f * bx;
        const float lamc = -8.f * log1pf(__expf(-A_.in[I_LLAM][(l * 2 + dir) * 1024 + chan])) * 1.4426950408889634f;
        float hprev = 0.f;
        bf16x8 xr[7]; unsigned xok = 0u;
#define LRU_LOADX(st) do { const int tc_ = lru_chunk(cdir, (st)); const int seg0_ = (tc_ < 4) ? 0 : CTXL, segl_ = (tc_ < 4) ? CTXL : SEQ, tcl_ = (tc_ < 4) ? tc_ : tc_ - 4; \
            const char* xb_ = (const char*)(P + (size_t)(bl * SB + seg0_) * PW + C_LX + blk * 128);     \
            _Pragma("unroll") for (int i_ = 0; i_ < 7; ++i_) { const int st_ = 64 * tcl_ + tb + i_; const bool ok_ = (unsigned)st_ < (unsigned)segl_; \
                xr[i_] = *(const bf16x8*)(xb_ + ((unsigned)(ok_ ? st_ : 0) * (unsigned)PW + 8u * (unsigned)cgrp) * 2u); xok = ok_ ? (xok | (1u << i_)) : (xok & ~(1u << i_)); } } while (0)
#define LRU_CONV(bufi) do { LAS unsigned char* Uw0_ = lds + LRU_U0 + ((bufi) * 2 + cdir) * LRU_UB + (4 * ctg) * (LRU_UP * 2) + cgrp * 16; unsigned pk_[4][4]; \
            _Pragma("unroll") for (int c2_ = 0; c2_ < 4; ++c2_) { typedef float f2_ __attribute__((ext_vector_type(2))); \
                f2_ w_[5]; _Pragma("unroll") for (int k_ = 0; k_ < 5; ++k_) w_[k_] = *(const LAS f2_*)(CW + k_ * 128 + 8 * cgrp + 2 * c2_); \
                f2_ x_[7]; _Pragma("unroll") for (int i_ = 0; i_ < 7; ++i_) { const unsigned wd_ = __builtin_bit_cast(v4u, xr[i_])[c2_] & (0u - ((xok >> i_) & 1u)); x_[i_] = (f2_){bf2f(wd_ & 0xffffu), __uint_as_float(wd_ & 0xffff0000u)}; } \
                if (cdir == 0) { _Pragma("unroll") for (int j_ = 0; j_ < 4; ++j_) { f2_ a_ = w_[4]; \
                    _Pragma("unroll") for (int k_ = 0; k_ < 4; ++k_) a_ += w_[k_] * x_[j_ + k_]; \
                    pk_[j_][c2_] = pk2(a_.x, a_.y); } } \
                else { _Pragma("unroll") for (int j_ = 0; j_ < 4; ++j_) { f2_ a_ = w_[4]; \
                    _Pragma("unroll") for (int k_ = 0; k_ < 4; ++k_) a_ += w_[k_] * x_[3 - j_ + k_]; \
                    pk_[j_][c2_] = pk2(a_.x, a_.y); } } } \
            _Pragma("unroll") for (int j_ = 0; j_ < 4; ++j_) *(LAS v4u*)(Uw0_ + j_ * (LRU_UP * 2)) = (v4u){pk_[j_][0], pk_[j_][1], pk_[j_][2], pk_[j_][3]}; } while (0)
        LRU_LOADX(0); LRU_CONV(0);
        __syncthreads();
        if (dir == 1) __builtin_amdgcn_s_setprio(1);
#ifndef MK_LRU_SEC
#define MK_LRU_SEC 0
#endif
#define LSEC_B(k) if (MK_LRU_SEC == (k)) { lsec_t0 = __builtin_amdgcn_s_memrealtime(); }
#define LSEC_E(k) if (MK_LRU_SEC == (k)) { lsec_acc += __builtin_amdgcn_s_memrealtime() - lsec_t0; }
        unsigned long long lsec_t0 = 0, lsec_acc = 0;
        for (int s = 0; s <= 36; ++s) {
            const int buf = s & 1;
            LSEC_B(1)
            v4u ohf[2], ogt[2]; const bool ofirst = (s >= 1) ? lru_first(s - 1) : true;
            unsigned orow[2];
#pragma unroll
            for (int i = 0; i < 2; ++i) orow[i] = (unsigned)(bl * SB + 64 * lru_chunk(i, s >= 1 ? s - 1 : 0) + otok);
#define LRU_LOADO() do { if (s >= 1 && !ofirst) { _Pragma("unroll") for (int i = 0; i < 2; ++i) { \
                ohf[i] = __builtin_nontemporal_load((const v4u*)((const char*)HT + (orow[i] * (unsigned)DMODEL + (unsigned)(blk * 128 + half * 64 + og * 8)) * 2u)); \
                ogt[i] = __builtin_nontemporal_load((const v4u*)((const char*)P + (orow[i] * (unsigned)PW + (unsigned)(C_LG + blk * 128 + half * 64 + og * 8)) * 2u)); } } } while (0)
            if (s >= 36) LRU_LOADO();
            if (s + 1 < 36) LRU_LOADX(s + 1);
            LSEC_E(1) LSEC_B(2)
            if (s < 36) {
                const LAS unsigned char* U = lds + LRU_U0 + (buf * 2 + dir) * LRU_UB;
                LAS unsigned char* O = lds + LRU_O0 + (buf * 2 + dir) * LRU_OB;
                float Pa[4][4], Pb[4][4];
#pragma unroll
                for (int m = 0; m < 4; ++m) {
                    f32x4 acc0 = (f32x4){0.f, 0.f, 0.f, 0.f}, acc1 = (f32x4){0.f, 0.f, 0.f, 0.f};
#pragma unroll
                    for (int ks = 0; ks < 4; ++ks) { const bf16x8 Af = *(const LAS bf16x8*)(U + (16 * m + fr) * (LRU_UP * 2) + (ks * 32 + fq * 8) * 2);
                        acc0 = __builtin_amdgcn_mfma_f32_16x16x32_bf16(Af, Bf[0][ks], acc0, 0, 0, 0);
                        acc1 = __builtin_amdgcn_mfma_f32_16x16x32_bf16(Af, Bf[1][ks], acc1, 0, 0, 0); }
                    float A = 1.f, Bv = 0.f;
#pragma unroll
                    for (int j = 0; j < 4; ++j) { const int rho = 16 * m + 4 * fq + j;
                        const float u = bf2f(*(const LAS unsigned short*)(U + rho * (LRU_UP * 2) + chl * 2));
                        const float r = fast_rcp(1.f + __builtin_amdgcn_exp2f(__builtin_fmaf(acc0[j], -1.4426950408889634f, nba))), ig = fast_rcp(1.f + __builtin_amdgcn_exp2f(__builtin_fmaf(acc1[j], -1.4426950408889634f, nbx)));
                        const float a = __builtin_amdgcn_exp2f(lamc * r); const float b = __builtin_amdgcn_sqrtf(fmaxf(1.f - a * a, 0.f)) * (ig * u);
                        Bv = a * Bv + b; A *= a; Pa[m][j] = A; Pb[m][j] = Bv; }
                    asm volatile("" ::: "memory"); }
                LRU_LOADO();
                float EA[4], EB[4], TA[4], TB[4];
                { const bool odd = (fq & 1) != 0, hi = (fq >> 1) != 0;
#pragma unroll
                for (int m = 0; m < 4; ++m) { const float a = Pa[m][3], b = Pb[m][3];
                    const float pa = swap16_get(a, lane), pb = swap16_get(b, lane);
                    const float ptA = a * pa, ptB = odd ? (a * pb + b) : (pa * b + pb);
                    const float oA = swap32_get(ptA, lane), oB = swap32_get(ptB, lane);
                    const float t01A = hi ? oA : ptA, t01B = hi ? oB : ptB, t23A = hi ? ptA : oA, t23B = hi ? ptB : oB;
                    TA[m] = t01A * t23A; TB[m] = t23A * t01B + t23B;
                    const float e1A = odd ? pa : 1.f, e1B = odd ? pb : 0.f;
                    EA[m] = hi ? t01A * e1A : e1A; EB[m] = hi ? (e1A * t01B + e1B) : e1B; } }
                float CA = 1.f, CB = 0.f;
#pragma unroll
                for (int m = 0; m < 4; ++m) {
                    const float GA = EA[m] * CA, GB = EA[m] * CB + EB[m];
                    const float hg = GB + GA * hprev;
#pragma unroll
                    for (int j = 0; j < 4; j += 2) { const unsigned w2 = pk2(Pb[m][j] + Pa[m][j] * hg, Pb[m][j + 1] + Pa[m][j + 1] * hg);
                        const int rho = 16 * m + 4 * fq + j, tok0 = dir ? 63 - rho : rho, tok1 = dir ? tok0 - 1 : tok0 + 1;
                        *(LAS unsigned short*)(O + tok0 * LRU_OP + (nt * 16 + fr) * 2) = (unsigned short)w2; *(LAS unsigned short*)(O + tok1 * LRU_OP + (nt * 16 + fr) * 2) = (unsigned short)(w2 >> 16); }
                    CB = TA[m] * CB + TB[m]; CA = TA[m] * CA; }
                hprev = CB + CA * hprev;
            }
            LSEC_E(2) LSEC_B(3)
            if (s >= 1) {
#pragma unroll
                for (int i = 0; i < 2; ++i) { const v4u hv = *(const LAS v4u*)(lds + LRU_O0 + ((buf ^ 1) * 2 + i) * LRU_OB + otok * LRU_OP + og * 16);
                    if (ofirst) *(v4u*)((char*)HT + (orow[i] * (unsigned)DMODEL + (unsigned)(blk * 128 + half * 64 + og * 8)) * 2u) = hv;
                    else { float y[8];
#pragma unroll
                        for (int e = 0; e < 4; ++e) { const float h0 = bf2f(hv[e] & 0xffffu) + bf2f(ohf[i][e] & 0xffffu), h1 = bf2f(hv[e] >> 16) + bf2f(ohf[i][e] >> 16);
                            y[2 * e] = __builtin_amdgcn_fmed3f(h0 * bf2f(ogt[i][e] & 0xffffu) * M8_SA, -448.f, 448.f); y[2 * e + 1] = __builtin_amdgcn_fmed3f(h1 * bf2f(ogt[i][e] >> 16) * M8_SA, -448.f, 448.f); }
                        typedef unsigned u32x2_ __attribute__((ext_vector_type(2)));
                        *(u32x2_*)(M8 + (orow[i] * 2048u + (unsigned)(blk * 128 + half * 64 + og * 8))) = (u32x2_){pk4_fp8(y[0], y[1], y[2], y[3]), pk4_fp8(y[4], y[5], y[6], y[7])}; } }
            }
            LSEC_E(3) LSEC_B(4)
            if (s + 1 < 36) LRU_CONV(buf ^ 1);
            LSEC_E(4) LSEC_B(5)
            if (s == 2 || s == 20) VM_WAIT();
            asm volatile("s_waitcnt lgkmcnt(0)\n\ts_barrier" ::: "memory");
            LSEC_E(5)
        }
#undef LRU_LOADX
#undef LRU_LOADO
        __builtin_amdgcn_s_setprio(0);
        if (MK_LRU_SEC != 0) { const unsigned long long te_ = __builtin_amdgcn_s_memrealtime() + 3ull * lsec_acc; while (__builtin_amdgcn_s_memrealtime() < te_) __builtin_amdgcn_s_sleep(8); }
#undef LRU_CONV
    }
}

__device__ __forceinline__ void ph_attn(const Args& A_, Frame& F, int l, char* lds_generic) {
    PH_IDS
    using abf = attn_body::bf16;
    abf* P = (abf*)(F.ws + WS_P); unsigned char* M8 = F.ws + WS_M8;
    const int ndense = BC * 64 + (l == 0 ? BC * 16 : 0), nna = BC * 64;
    const int cd = (vcu < ndense) ? (ndense - vcu + F.G - 1) / F.G : 0, cn = (vcu < nna) ? (nna - vcu + F.G - 1) / F.G : 0;
    struct Desc { const abf *Q0, *Kh, *Vh; unsigned char* O8; int NT, R0w, nar0, h, mode; };
    auto desc = [&](int i, Desc& d) {
        if (i < cd) { const int v = vcu + i * F.G; d.mode = 0; d.R0w = 0; d.nar0 = 0; d.h = 0;
            if (v < BC * 64) { const int u = v;
                const int qb = ((u & 7) + 2 * (u >> 8)) & 7, rest = ((u >> 3) & 31) + 32 * (u >> 8), bl = rest >> 3, h = rest & 7;
                d.Q0 = P + (size_t)(bl * SB + CTXL + 256 * qb) * PW + C_GQ + h * 64; d.Kh = P + (size_t)(bl * SB) * PW + C_GK + (h >> 2) * 64; d.Vh = d.Kh + (C_GV - C_GK); d.NT = SB / 64;
                d.O8 = M8 + (size_t)(bl * SB + CTXL + 256 * qb) * 2048 + 1536 + h * 64; }
            else { const int u = v - BC * 64; const int kind = u / (BC * 8), idx = u % (BC * 8), bl = idx >> 3, h = idx & 7;
                if (kind == 0) { d.Q0 = P + (size_t)(bl * SB) * PW + C_GQ + h * 64; d.Kh = P + (size_t)(bl * SB) * PW + C_GK + (h >> 2) * 64; d.Vh = d.Kh + (C_GV - C_GK); d.O8 = M8 + (size_t)(bl * SB) * 2048 + 1536 + h * 64; }
                else { d.Q0 = P + (size_t)(bl * SB) * PW + C_NQ + h * 64; d.Kh = P + (size_t)(bl * SB) * PW + C_NK + h * 64; d.Vh = d.Kh + (C_NV - C_NK); d.O8 = M8 + (size_t)(bl * SB) * 2048 + 1024 + h * 64; }
                d.NT = CTXL / 64; } }
        else { const int u = vcu + (i - cd) * F.G; d.mode = 1;
            const int qb = ((u & 7) + 2 * (u >> 8)) & 7, rest = ((u >> 3) & 31) + 32 * (u >> 8), bl = rest >> 3, h = rest & 7;
            d.Q0 = P + (size_t)(bl * SB + CTXL + 256 * qb) * PW + C_NQ + h * 64; d.Kh = P + (size_t)(bl * SB) * PW + C_NK + h * 64; d.Vh = d.Kh + (C_NV - C_NK);
            d.NT = 4 + ((qb == 0 || qb == 7) ? 8 : 12); d.R0w = (qb == 0) ? 0 : 4 * qb - 4; d.nar0 = 4 * qb; d.h = h;
            d.O8 = M8 + (size_t)(bl * SB + CTXL + 256 * qb) * 2048 + 1024 + h * 64; } };
    int htab = -1;
    bool pre = false;
    for (int i = 0; i < cd + cn; ++i) {
        Desc cur; desc(i, cur);
        const bool hn = i + 1 < cd + cn; const abf* nQ0 = nullptr; const abf* nKh = nullptr;
        const abf* nVh = nullptr;
        if (hn) { Desc nx; desc(i + 1, nx); nQ0 = nx.Q0; nKh = nx.Kh; nVh = nx.Vh; }
        if (cur.mode == 0) attn_body::attn_unit<8, 0>(cur.Q0, cur.Kh, cur.Vh, cur.O8, cur.NT, 0, 0, nullptr, lds_generic, pre, nQ0, nKh, nVh);
        else {
            if (cur.h != htab) { __syncthreads(); attn_body::na_fill_table(A_.in[I_RPB] + (size_t)(l * 8 + cur.h) * 15 * 31, lds_generic); __syncthreads(); htab = cur.h; }
            attn_body::attn_unit<8, 1>(cur.Q0, cur.Kh, cur.Vh, cur.O8, cur.NT, cur.R0w, cur.nar0, nullptr, lds_generic, pre, nQ0, nKh, nVh); }
        pre = hn;
    }
}

struct TileMap {
    int nM, nN, nwg, G, c;
    __device__ __forceinline__ void init(int nM_, int nN_, int G_, int c_) { nM = nM_; nN = nN_; nwg = nM_ * nN_; G = G_; c = c_; }
    __device__ __forceinline__ bool get(int i, int& pm, int& pn) const { return getL((long)i * G + c, pm, pn); }
    __device__ __forceinline__ bool getL(long L, int& pm, int& pn) const {
        if (L >= nwg) return false;
        int wgid = (int)L; { const int q = nwg / 8, r = nwg % 8, xcd = wgid % 8, off = wgid / 8; wgid = (xcd < r ? xcd * (q + 1) : r * (q + 1) + (xcd - r) * q) + off; }
        const int nig = 8 * nN, gid = wgid / nig, fm = gid * 8, gsz = (nM - fm) < 8 ? (nM - fm) : 8;
        pm = fm + ((wgid % nig) % gsz); pn = (wgid % nig) / gsz; return true;
    }
};
struct SchedPlain {
    TileMap T; const char* A; const char* B; size_t astep, bstep; bool skipctx;
    __device__ __forceinline__ bool next(int i, pg8::Unit& u) const { int pm, pn; if (!T.get(i, pm, pn)) return false; if (skipctx) pm = (pm >> 3) * 9 + 1 + (pm & 7);
        u.pm = pm; u.pn = pn; u.A = A + (size_t)pm * astep; u.B = B + (size_t)pn * bstep; return true; }
    __device__ __forceinline__ void a_ready(const pg8::Unit&) const {}
    __device__ __forceinline__ void done(const pg8::Unit&) const {}
};
struct SchedG1 {
    TileMap T1, T2; const char* A; const char* B; bool last;
    __device__ __forceinline__ void init(bool last_, int G, int c) { last = last_; if (last_) { T1.init(BC * 8, NPROJ / 256, G, c); T2.init(BC, 9, G, c); } else { T1.init(MC / 256, NPROJ / 256, G, c); T2.init(0, 9, G, c); } }
    __device__ __forceinline__ bool next(int i, pg8::Unit& u) const { int pm, pn; const long L = (long)i * T1.G + T1.c;
        if (L < T1.nwg) { T1.getL(L, pm, pn); if (last) pm = (pm >> 3) * 9 + 1 + (pm & 7); }
        else { if (!T2.getL(L - T1.nwg, pm, pn)) return false; pm = pm * 9; pn = (pn < 4) ? pn : 8 + pn; }
        u.pm = pm; u.pn = pn; u.A = A + (size_t)pm * (256 * 1024); u.B = B + (size_t)pn * (256 * 1024); return true; }
    __device__ __forceinline__ void a_ready(const pg8::Unit&) const {}
    __device__ __forceinline__ void done(const pg8::Unit&) const {}
};
struct EpiG1 {
    static constexpr bool PERM = true, AFTER_DRAIN = false;
    bf16* O; unsigned char* G8;
    __device__ __forceinline__ void operator()(const pg8::f32x4 (&acc)[2][2][4][2], const pg8::Unit& u, int wr, int wc, int fr, int fq) const {
        int row0 = u.pm * 256 + wr * 64 + fr, col0 = u.pn * 256 + wc * 32 + 8 * fq; asm volatile("" : "+v"(row0), "+v"(col0));
        if (u.pn >= PW / 256) {
            const int gt = u.pn - PW / 256;
            unsigned char* tb = G8 + ((size_t)((gt >> 2) * (MC / 256) + u.pm) * 4 + (gt & 3)) * 65536 + ((wr * 4 + wc) * 8192 + (fq * 16 + fr) * 16);
#pragma unroll
            for (int ai = 0; ai < 2; ++ai)
#pragma unroll
                for (int m = 0; m < 4; ++m) {
#define G1_E4(v_) pk4_fp8(fminf(__builtin_amdgcn_exp2f((v_)[0] * -1.4426950408889634f), 448.f), fminf(__builtin_amdgcn_exp2f((v_)[1] * -1.4426950408889634f), 448.f), fminf(__builtin_amdgcn_exp2f((v_)[2] * -1.4426950408889634f), 448.f), fminf(__builtin_amdgcn_exp2f((v_)[3] * -1.4426950408889634f), 448.f))
                    __builtin_nontemporal_store((v4u){G1_E4(acc[ai][0][m][0]), G1_E4(acc[ai][0][m][1]), G1_E4(acc[ai][1][m][0]), G1_E4(acc[ai][1][m][1])}, (v4u*)(tb + (ai * 4 + m) * 1024)); }
#undef G1_E4
            return; }
        const bool gl = (u.pn >= C_LG / 256 && u.pn < C_NQ / 256);
#pragma unroll
        for (int ai = 0; ai < 2; ++ai)
#pragma unroll
            for (int m = 0; m < 4; ++m) { bf16* rowp = O + (size_t)(row0 + ai * 128 + m * 16) * PW + col0;
#pragma unroll
                for (int bj = 0; bj < 2; ++bj) { float o[8];
#pragma unroll
                    for (int e = 0; e < 8; ++e) { const float v = acc[ai][bj][m][e >> 2][e & 3]; o[e] = gl ? gelu_tanh(v) : v; }
                    *(v4u*)(rowp + bj * 128) = (v4u){pk2(o[0], o[1]), pk2(o[2], o[3]), pk2(o[4], o[5]), pk2(o[6], o[7])}; } }
    }
};
struct SchedMoe {
    TileMap T; const char* A; const char* B; size_t astep, bstep, estep; const int* gidx;
    __device__ __forceinline__ bool next(int i, pg8::Unit& u) const { int pm, pn; if (!T.get(i, pm, pn)) return false;
        const int e = (pm < NE * BC) ? pm / BC : (pm - NE * BC) / (BC / 8);
        u.pm = pm; u.pn = pn; u.A = A + (size_t)pm * astep; u.B = B + (size_t)e * estep + (size_t)pn * bstep; u.gidx = gidx ? gidx + (size_t)pm * 256 : nullptr; return true; }
    __device__ __forceinline__ void a_ready(const pg8::Unit&) const {}
    __device__ __forceinline__ void done(const pg8::Unit&) const {}
};
struct EpiMerge {
    static constexpr bool PERM = true, AFTER_DRAIN = false; static constexpr int HOOK_T0 = 8, HOOK_T1 = 12;
    const unsigned char* G8; unsigned char* O;
    typedef unsigned u32x2_ __attribute__((ext_vector_type(2)));
    static __device__ __forceinline__ void f8x8(const u32x2_ w, float (&o)[8]) {
        const auto a = __builtin_amdgcn_cvt_pk_f32_fp8((int)w[0], false), b = __builtin_amdgcn_cvt_pk_f32_fp8((int)w[0], true), c = __builtin_amdgcn_cvt_pk_f32_fp8((int)w[1], false), d = __builtin_amdgcn_cvt_pk_f32_fp8((int)w[1], true);
        o[0] = a[0]; o[1] = a[1]; o[2] = b[0]; o[3] = b[1]; o[4] = c[0]; o[5] = c[1]; o[6] = d[0]; o[7] = d[1]; }
    __device__ __forceinline__ void khook(pg8::f32x4 (&acc)[2][2][4][2], const pg8::Unit& u, int t, int wr, int wc, int fr, int fq) const {
        const int bn = (t == HOOK_T0) ? 0 : 1; const float kf = (t == HOOK_T0) ? (M8_SB / M8_SA) : 1.f;
        int loff = (wr * 4 + wc) * 8192 + (fq * 16 + fr) * 16; asm volatile("" : "+v"(loff));
        const unsigned char* tn = G8 + ((size_t)(bn * (MC / 256) + u.pm) * 4 + u.pn) * 65536 + loff; const unsigned char* td = tn + (size_t)(MC / 256) * 4 * 65536;
        v4u gn[2][4], gd[2][4];
#pragma unroll
        for (int ai = 0; ai < 2; ++ai)
#pragma unroll
            for (int m = 0; m < 4; ++m) { gn[ai][m] = __builtin_nontemporal_load((const v4u*)(tn + (ai * 4 + m) * 1024)); gd[ai][m] = __builtin_nontemporal_load((const v4u*)(td + (ai * 4 + m) * 1024)); }
#pragma unroll
        for (int ai = 0; ai < 2; ++ai) {
#pragma unroll
            for (int m = 0; m < 4; ++m)
#pragma unroll
                for (int bj = 0; bj < 2; ++bj)
                    { float ln[8], ld[8]; f8x8((u32x2_){gn[ai][m][2 * bj], gn[ai][m][2 * bj + 1]}, ln); f8x8((u32x2_){gd[ai][m][2 * bj], gd[ai][m][2 * bj + 1]}, ld);
#pragma unroll
                    for (int e = 0; e < 8; ++e) acc[ai][bj][m][e >> 2][e & 3] *= (kf + kf * ld[e]) * fast_rcp(1.f + ln[e]); }
            asm volatile("" ::: "memory"); }
    }
    __device__ __forceinline__ void operator()(const pg8::f32x4 (&acc)[2][2][4][2], const pg8::Unit& u, int wr, int wc, int fr, int fq) const {
        int row0 = u.pm * 256 + wr * 64 + fr, col0 = u.pn * 256 + wc * 32 + 8 * fq; asm volatile("" : "+v"(row0), "+v"(col0));
        int loff = (wr * 4 + wc) * 8192 + (fq * 16 + fr) * 16; asm volatile("" : "+v"(loff));
        const unsigned char* tc = G8 + ((size_t)(2 * (MC / 256) + u.pm) * 4 + u.pn) * 65536 + loff;
        v4u gc[2][4];
#pragma unroll
        for (int ai = 0; ai < 2; ++ai)
#pragma unroll
            for (int m = 0; m < 4; ++m) gc[ai][m] = __builtin_nontemporal_load((const v4u*)(tc + (ai * 4 + m) * 1024));
#pragma unroll
        for (int ai = 0; ai < 2; ++ai) {
#pragma unroll
            for (int m = 0; m < 4; ++m) { const size_t r = (size_t)(row0 + ai * 128 + m * 16);
#pragma unroll
                for (int bj = 0; bj < 2; ++bj) { float o[8], lc[8]; f8x8((u32x2_){gc[ai][m][2 * bj], gc[ai][m][2 * bj + 1]}, lc);
#pragma unroll
                    for (int e = 0; e < 8; ++e) o[e] = __builtin_amdgcn_fmed3f(acc[ai][bj][m][e >> 2][e & 3] * fast_rcp((M8_SB / MQ_S) + (M8_SB / MQ_S) * lc[e]), -448.f, 448.f);
                    *(u32x2_*)(O + r * DMODEL + col0 + bj * 128) = (u32x2_){pk4_fp8(o[0], o[1], o[2], o[3]), pk4_fp8(o[4], o[5], o[6], o[7])}; } }
            asm volatile("" ::: "memory"); }
    }
};
struct EpiSwiglu {
    static constexpr bool PERM = true, AFTER_DRAIN = false;
    unsigned char* O;
    __device__ __forceinline__ void operator()(const pg8::f32x4 (&acc)[2][2][4][2], const pg8::Unit& u, int wr, int wc, int fr, int fq) const {
        int row0 = u.pm * 256 + wr * 64 + fr, col0 = u.pn * 128 + wc * 32 + 8 * fq; asm volatile("" : "+v"(row0), "+v"(col0));
#pragma unroll
        for (int ai = 0; ai < 2; ++ai)
#pragma unroll
            for (int m = 0; m < 4; ++m) { float o[8];
#pragma unroll
                for (int e = 0; e < 8; ++e) { const float g = acc[ai][0][m][e >> 2][e & 3], up = acc[ai][1][m][e >> 2][e & 3]; o[e] = g * sigmoidf_(g) * up; }
                typedef unsigned u32x2_ __attribute__((ext_vector_type(2)));
                *(u32x2_*)(O + (size_t)(row0 + ai * 128 + m * 16) * DMODEL + col0) = (u32x2_){pk4_fp8(o[0], o[1], o[2], o[3]), pk4_fp8(o[4], o[5], o[6], o[7])}; }
    }
};

__device__ __forceinline__ void ph_norm2(const Args& A_, Frame& F, int l, int ch) {
    PH_IDS
    const int gw = vcu * 8 + wid, NGW = F.G * 8;
    LAS f32x4* WR = (LAS f32x4*)F.lds;
    __syncthreads();
    for (int i = tid; i < 4096; i += 512) { const int k = i >> 2, q = i & 3; const int slot = ((k >> 2) & 63) + 64 * ((k & 3) + 4 * (k >> 8));
        WR[q * 1024 + slot] = *(const f32x4*)(A_.in[I_WR] + (size_t)l * DMODEL * NE + k * NE + q * 4); }
    __syncthreads();
    const bf16* O1 = (const bf16*)(F.ws + WS_O1); bf16* H = (bf16*)(F.ws + WS_H);
    float* affen = (float*)(F.ws + WS_AFFEN); float* affne = (float*)(F.ws + WS_AFFNE);
    const int nrows = (l == 0) ? MC : BC * SEQ;
#define N2_ROW(idx) ((l == 0) ? (idx) : ((idx) / SEQ) * SB + CTXL + ((idx) % SEQ))
    unsigned long long on[2][4], xb[2][4]; f32x4 xn[2][4];
#define N2_FETCH(base) do { _Pragma("unroll") for (int rr = 0; rr < 2; ++rr) { const int i2_ = ((base) + rr * NGW < nrows) ? (base) + rr * NGW : (base); const int row_ = N2_ROW(i2_), bl_ = row_ / SB, s_ = row_ - bl_ * SB; \
            _Pragma("unroll") for (int j = 0; j < 4; ++j) { on[rr][j] = __builtin_nontemporal_load((const unsigned long long*)(O1 + (size_t)row_ * DMODEL) + lane + 64 * j); \
                if (l == 0) xn[rr][j] = __builtin_nontemporal_load((const f32x4*)res_in(A_, ch * BC + bl_, s_) + lane + 64 * j); else xb[rr][j] = __builtin_nontemporal_load((const unsigned long long*)res_xr(F, ch * BC + bl_, s_) + lane + 64 * j); } } } while (0)
    if (gw < nrows) N2_FETCH(gw);
#ifndef MK_N2_SEC
#define MK_N2_SEC 0
#endif
#define NSEC_B(k) if (MK_N2_SEC == (k)) { nsec_t0 = __builtin_amdgcn_s_memrealtime(); }
#define NSEC_E(k) if (MK_N2_SEC == (k)) { nsec_acc += __builtin_amdgcn_s_memrealtime() - nsec_t0; }
    unsigned long long nsec_t0 = 0, nsec_acc = 0;
    for (int idx = gw; idx < nrows; idx += 2 * NGW) {
        NSEC_B(1)
        int row[2], bl[2], s[2], b[2]; bool ok[2];
#pragma unroll
        for (int rr = 0; rr < 2; ++rr) { ok[rr] = idx + rr * NGW < nrows; row[rr] = N2_ROW(ok[rr] ? idx + rr * NGW : idx); bl[rr] = row[rr] / SB; s[rr] = row[rr] - bl[rr] * SB; b[rr] = ch * BC + bl[rr]; }
        f32x4 o[2][4], x[2][4];
#pragma unroll
        for (int rr = 0; rr < 2; ++rr)
#pragma unroll
            for (int j = 0; j < 4; ++j) { const unsigned long long w = on[rr][j];
                o[rr][j].x = bf2f((unsigned)w & 0xffffu); o[rr][j].y = bf2f(((unsigned)w >> 16)); o[rr][j].z = bf2f((unsigned)(w >> 32) & 0xffffu); o[rr][j].w = bf2f((unsigned)(w >> 48));
                if (l == 0) x[rr][j] = xn[rr][j]; else { const unsigned long long q = xb[rr][j]; x[rr][j].x = bf2f((unsigned)q & 0xffffu); x[rr][j].y = bf2f(((unsigned)q >> 16)); x[rr][j].z = bf2f((unsigned)(q >> 32) & 0xffffu); x[rr][j].w = bf2f((unsigned)(q >> 48)); } }
        if (idx + 2 * NGW < nrows) N2_FETCH(idx + 2 * NGW);
        NSEC_E(1) NSEC_B(2)
        const float* mr[2]; float rs1[2], rs2[2];
#pragma unroll
        for (int rr = 0; rr < 2; ++rr) { mr[rr] = mod_row(A_, F, l, b[rr], s[rr]); rs1[rr] = row_rstd(o[rr], lane); }
#pragma unroll
        for (int rr = 0; rr < 2; ++rr) {
#pragma unroll
            for (int j = 0; j < 4; ++j) { const f32x4 c1 = ((const f32x4*)(mr[rr] + 2 * DMODEL))[lane + 64 * j]; x[rr][j] = x[rr][j] + c1 * (o[rr][j] * rs1[rr]); }
            if (ok[rr]) row_store_bf16(res_xr(F, b[rr], s[rr]), lane, x[rr]); }
#pragma unroll
        for (int rr = 0; rr < 2; ++rr) rs2[rr] = row_rstd(x[rr], lane);
#pragma unroll
        for (int rr = 0; rr < 2; ++rr) {
#pragma unroll
            for (int j = 0; j < 4; ++j) { const f32x4 sh = ((const f32x4*)(mr[rr] + 3 * DMODEL))[lane + 64 * j], c2 = ((const f32x4*)(mr[rr] + 4 * DMODEL))[lane + 64 * j];
                x[rr][j] = (x[rr][j] * rs2[rr]) * c2 + sh; }
            if (ok[rr]) row_store_fp8((unsigned char*)H + (size_t)row[rr] * DMODEL, lane, x[rr]); }
        NSEC_E(2) NSEC_B(3)
        float v[2][16];
#pragma unroll
        for (int rr = 0; rr < 2; ++rr)
#pragma unroll
            for (int e = 0; e < 16; ++e) v[rr][e] = 0.f;
#pragma unroll
        for (int j = 0; j < 4; ++j)
#pragma unroll
            for (int i = 0; i < 4; ++i) { const int slot = lane + 64 * (i + 4 * j);
#pragma unroll
                for (int q = 0; q < 4; ++q) { const f32x4 w = WR[q * 1024 + slot];
#pragma unroll
                    for (int rr = 0; rr < 2; ++rr) { const float xv = x[rr][j][i]; v[rr][4 * q] += xv * w.x; v[rr][4 * q + 1] += xv * w.y; v[rr][4 * q + 2] += xv * w.z; v[rr][4 * q + 3] += xv * w.w; } }
                if (i & 1) asm volatile("" ::: "memory"); }
        NSEC_E(3) NSEC_B(4)
        const int e = ((lane >> 5) & 1) * 8 + ((lane >> 4) & 1) * 4 + ((lane >> 3) & 1) * 2 + ((lane >> 2) & 1);
#pragma unroll
        for (int rr = 0; rr < 2; ++rr) {
#pragma unroll
            for (int e2 = 0; e2 < 8; ++e2) { const bool up = (lane & 32) != 0; const float snd = up ? v[rr][e2] : v[rr][e2 + 8], kp = up ? v[rr][e2 + 8] : v[rr][e2]; v[rr][e2] = kp + swap32_get(snd, lane); }
#pragma unroll
            for (int e2 = 0; e2 < 4; ++e2) { const bool up = (lane & 16) != 0; const float snd = up ? v[rr][e2] : v[rr][e2 + 4], kp = up ? v[rr][e2 + 4] : v[rr][e2]; v[rr][e2] = kp + swap16_get(snd, lane); }
#pragma unroll
            for (int e2 = 0; e2 < 2; ++e2) { const bool up = (lane & 8) != 0; const float snd = up ? v[rr][e2] : v[rr][e2 + 2], kp = up ? v[rr][e2 + 2] : v[rr][e2]; v[rr][e2] = kp + shx(snd, 8, lane); }
            { const bool up = (lane & 4) != 0; const float snd = up ? v[rr][0] : v[rr][1], kp = up ? v[rr][1] : v[rr][0]; v[rr][0] = kp + shx(snd, 4, lane); } }
#pragma unroll
        for (int rr = 0; rr < 2; ++rr) {
            float lg = v[rr][0]; lg += DPPF(lg, 0x4E); lg += DPPF(lg, 0xB1);
            float mx = lg;
            mx = fmaxf(mx, DPPF(mx, 0x141)); mx = fmaxf(mx, DPPF(mx, 0x140)); mx = fmaxf(mx, swap16_get(mx, lane)); mx = fmaxf(mx, swap32_get(mx, lane));
            const float ex = __expf(lg - mx); float sm = ex;
            sm += DPPF(sm, 0x141); sm += DPPF(sm, 0x140); sm = swap32_sum(swap16_sum(sm));
            const float aff = ex / sm;
            if (ok[rr] && (lane & 3) == 0) { affen[(size_t)(bl[rr] * NE + e) * SB + s[rr]] = aff; affne[(size_t)row[rr] * NE + e] = aff; } }
        NSEC_E(4)
    }
#undef N2_FETCH
    if (MK_N2_SEC != 0) { const unsigned long long te_ = __builtin_amdgcn_s_memrealtime() + 3ull * nsec_acc; while (__builtin_amdgcn_s_memrealtime() < te_) __builtin_amdgcn_s_sleep(8); }
#undef N2_ROW
}

__device__ __forceinline__ unsigned topk_scan32(unsigned v, int lane) {
    unsigned s = v;
#pragma unroll
    for (int o = 1; o < 32; o <<= 1) { const unsigned t = (unsigned)__builtin_amdgcn_ds_bpermute(((lane - o) & 63) << 2, (int)s); if (lane >= o) s += t; }
    return s - v;
}
__device__ __forceinline__ void ph_topk(const Args& A_, Frame& F, int l) {
    PH_IDS
    LAS unsigned* HIST = (LAS unsigned*)F.lds;
    LAS unsigned* CW = HIST + 256;
    LAS unsigned* WT = HIST + 272;
    const float* affen = (const float*)(F.ws + WS_AFFEN); int* slot_of = (int*)(F.ws + WS_SLOT);
    int* rowidx = (int*)(F.ws + WS_ROWIDX);
    const int nitems = (l == 0) ? 2 * BC * NE : BC * NE;
    for (int item = blockIdx.x; item < nitems; item += F.G) {
        const int set = item / (BC * NE), ie = item % (BC * NE), bl = ie / NE, e = ie % NE;
        const int n = set ? CTXL : SEQ, cap = n / 8, seg0 = set ? 0 : CTXL;
        unsigned key[4]; bool valid[4];
#pragma unroll
        for (int j = 0; j < 4; ++j) { const int idx = tid + 512 * j; valid[j] = idx < n; key[j] = valid[j] ? __float_as_uint(affen[(size_t)(bl * NE + e) * SB + seg0 + idx]) : 0u; }
        unsigned prefix = 0u, need = (unsigned)cap;
#pragma unroll 1
        for (int pass = 0; pass < 4; ++pass) { const int shift = 24 - 8 * pass;
            __syncthreads();
            if (tid < 256) HIST[tid] = 0u;
            __syncthreads();
#pragma unroll
            for (int j = 0; j < 4; ++j) if (valid[j] && (pass == 0 || (key[j] >> (shift + 8)) == prefix)) atomicAdd((unsigned*)&HIST[(key[j] >> shift) & 255u], 1u);
            __syncthreads();
            if (wid == 0) {
                unsigned c[4];
#pragma unroll
                for (int b = 0; b < 4; ++b) c[b] = HIST[4 * lane + b];
                const unsigned s = (c[0] + c[1]) + (c[2] + c[3]); unsigned S = s;
#pragma unroll
                for (int o = 1; o < 64; o <<= 1) { const unsigned t = (unsigned)__builtin_amdgcn_ds_bpermute(((lane + o) & 63) << 2, (int)S); if (lane + o < 64) S += t; }
                unsigned cum = S - s;
#pragma unroll
                for (int b = 3; b >= 0; --b) { if (cum < need && cum + c[b] >= need) { CW[0] = (prefix << 8) | (unsigned)(4 * lane + b); CW[1] = need - cum; } cum += c[b]; }
            }
            __syncthreads();
            prefix = CW[0]; need = CW[1];
        }
        const unsigned T = prefix, need_eq = need;
        unsigned rk[4];
#pragma unroll
        for (int j = 0; j < 4; ++j) { const bool eq = valid[j] && key[j] == T; const unsigned long long bm = __builtin_amdgcn_ballot_w64(eq);
            rk[j] = __builtin_amdgcn_mbcnt_hi((unsigned)(bm >> 32), __builtin_amdgcn_mbcnt_lo((unsigned)bm, 0u)); if (lane == 0) WT[j * 8 + wid] = (unsigned)__builtin_popcountll(bm); }
        __syncthreads();
        if (wid == 0) { const unsigned v = (lane < 32) ? WT[lane] : 0u; const unsigned p = topk_scan32(v, lane); if (lane < 32) WT[lane] = p; }
        __syncthreads();
        bool sel[4];
#pragma unroll
        for (int j = 0; j < 4; ++j) { const unsigned r = rk[j] + WT[j * 8 + wid]; sel[j] = valid[j] && (key[j] > T || (key[j] == T && r < need_eq)); }
        __syncthreads();
#pragma unroll
        for (int j = 0; j < 4; ++j) { const unsigned long long bm = __builtin_amdgcn_ballot_w64(sel[j]);
            rk[j] = __builtin_amdgcn_mbcnt_hi((unsigned)(bm >> 32), __builtin_amdgcn_mbcnt_lo((unsigned)bm, 0u)); if (lane == 0) WT[j * 8 + wid] = (unsigned)__builtin_popcountll(bm); }
        __syncthreads();
        if (wid == 0) { const unsigned v = (lane < 32) ? WT[lane] : 0u; const unsigned p = topk_scan32(v, lane); if (lane < 32) WT[lane] = p; }
        __syncthreads();
        const int dst0 = set ? (NE * BC) * 256 + (e * BC + bl) * 32 : (e * BC + bl) * 256;
#pragma unroll
        for (int j = 0; j < 4; ++j) if (valid[j]) { const int p = (int)(rk[j] + WT[j * 8 + wid]); const int row = bl * SB + seg0 + tid + 512 * j;
            slot_of[(size_t)row * NE + e] = sel[j] ? dst0 + p : -1; if (sel[j]) rowidx[dst0 + p] = row; }
    }
}

__device__ __forceinline__ void ph_combine(const Args& A_, Frame& F, int l, int ch) {
    PH_IDS
    const int gw = vcu * 8 + wid, NGW = F.G * 8;
    const bf16* Y = (const bf16*)(F.ws + WS_HS); const float* affne = (const float*)(F.ws + WS_AFFNE); const int* slot_of = (const int*)(F.ws + WS_SLOT);
    const int nrows = (l == 0) ? MC : BC * SEQ;
#define CB_ROW(idx) ((l == 0) ? (idx) : ((idx) / SEQ) * SB + CTXL + ((idx) % SEQ))
    int sln = -1; float afn = 0.f; unsigned long long xn[4];
    if (gw < nrows) { const int row = CB_ROW(gw), bl = row / SB, s = row - bl * SB; sln = slot_of[(size_t)row * NE + (lane & 15)]; afn = affne[(size_t)row * NE + (lane & 15)];
#pragma unroll
        for (int j = 0; j < 4; ++j) xn[j] = __builtin_nontemporal_load((const unsigned long long*)res_xr(F, ch * BC + bl, s) + lane + 64 * j); }
    for (int idx = gw; idx < nrows; idx += NGW) {
        const int row = CB_ROW(idx), bl = row / SB, s = row - bl * SB, b = ch * BC + bl;
        const int sl = sln; const float af = afn; unsigned long long xq[4];
#pragma unroll
        for (int j = 0; j < 4; ++j) xq[j] = xn[j];
        if (idx + NGW < nrows) { const int row2 = CB_ROW(idx + NGW), bl2 = row2 / SB, s2 = row2 - bl2 * SB; sln = slot_of[(size_t)row2 * NE + (lane & 15)]; afn = affne[(size_t)row2 * NE + (lane & 15)];
#pragma unroll
            for (int j = 0; j < 4; ++j) xn[j] = __builtin_nontemporal_load((const unsigned long long*)res_xr(F, ch * BC + bl2, s2) + lane + 64 * j); }
        f32x4 acc[4];
#pragma unroll
        for (int j = 0; j < 4; ++j) acc[j] = (f32x4){0.f, 0.f, 0.f, 0.f};
        unsigned em = (unsigned)__builtin_amdgcn_ballot_w64(sl >= 0) & 0xffffu;
        while (em) {
            const int e0 = __builtin_ctz(em); em &= em - 1u; const bool two = em != 0u; const int e1 = two ? __builtin_ctz(em) : e0; em &= em - 1u;
            const int s0 = __builtin_amdgcn_readlane(sl, e0), s1 = __builtin_amdgcn_readlane(sl, e1);
            const float a0 = __builtin_bit_cast(float, __builtin_amdgcn_readlane(__builtin_bit_cast(int, af), e0)), a1 = two ? __builtin_bit_cast(float, __builtin_amdgcn_readlane(__builtin_bit_cast(int, af), e1)) : 0.f;
            unsigned long long y0[4], y1[4];
#pragma unroll
            for (int j = 0; j < 4; ++j) y0[j] = __builtin_nontemporal_load((const unsigned long long*)(Y + (size_t)s0 * DMODEL) + lane + 64 * j);
            if (two) {
#pragma unroll
                for (int j = 0; j < 4; ++j) y1[j] = __builtin_nontemporal_load((const unsigned long long*)(Y + (size_t)s1 * DMODEL) + lane + 64 * j); }
            else {
#pragma unroll
                for (int j = 0; j < 4; ++j) y1[j] = 0ull; }
#pragma unroll
            for (int j = 0; j < 4; ++j) { const unsigned long long w = y0[j], q = y1[j];
                acc[j].x += bf2f((unsigned)w & 0xffffu) * a0; acc[j].y += bf2f((unsigned)w >> 16) * a0; acc[j].z += bf2f((unsigned)(w >> 32) & 0xffffu) * a0; acc[j].w += bf2f((unsigned)(w >> 48)) * a0;
                acc[j].x += bf2f((unsigned)q & 0xffffu) * a1; acc[j].y += bf2f((unsigned)q >> 16) * a1; acc[j].z += bf2f((unsigned)(q >> 32) & 0xffffu) * a1; acc[j].w += bf2f((unsigned)(q >> 48)) * a1; }
        }
        bf16* xr = res_xr(F, b, s);
        f32x4 x[4];
#pragma unroll
        for (int j = 0; j < 4; ++j) { const unsigned long long w = xq[j]; x[j].x = bf2f((unsigned)w & 0xffffu); x[j].y = bf2f(((unsigned)w >> 16)); x[j].z = bf2f((unsigned)(w >> 32) & 0xffffu); x[j].w = bf2f((unsigned)(w >> 48)); }
        const float rs = row_rstd(acc, lane); const float* mr = mod_row(A_, F, l, b, s);
#pragma unroll
        for (int j = 0; j < 4; ++j) { const f32x4 c3 = ((const f32x4*)(mr + 5 * DMODEL))[lane + 64 * j]; x[j] = x[j] + c3 * (acc[j] * rs); }
        if (l == DEPTH - 1) { float* od = F.out + ((size_t)b * SEQ + (s - CTXL)) * DMODEL;
#pragma unroll
            for (int j = 0; j < 4; ++j) __builtin_nontemporal_store(x[j], (f32x4*)od + lane + 64 * j); }
        else { row_store_bf16(xr, lane, x);
            const float rs1 = row_rstd(x, lane); const float* mn = mod_row(A_, F, l + 1, b, s);
#pragma unroll
            for (int j = 0; j < 4; ++j) { const f32x4 sh = ((const f32x4*)mn)[lane + 64 * j], c0 = ((const f32x4*)(mn + DMODEL))[lane + 64 * j]; x[j] = (x[j] * rs1) * c0 + sh; }
            row_store_fp8((unsigned char*)(F.ws + WS_H) + (size_t)row * DMODEL, lane, x); }
    }
#undef CB_ROW
}
constexpr int NPH = 12, NPHASES = 1 + DEPTH * NCHUNK * NPH;
__global__ void __launch_bounds__(512, 2) mk_fwd(Args A_) {
    extern __shared__ __attribute__((aligned(16))) unsigned char lds[];
    Frame F0;
    F0.lds = (LAS unsigned char*)lds;
    F0.G = gridDim.x; { const int bx = blockIdx.x; F0.vcu = (F0.G % 8 == 0) ? (bx % 8) * (F0.G / 8) + bx / 8 : bx; }
    F0.out = A_.out; F0.ws = A_.ws;
    volatile LAS unsigned* MISC = (volatile LAS unsigned*)(F0.lds + MISC_OFF);
    for (int u = threadIdx.x; u < (LDS_BYTES - LDSCTL_OFF) / 4; u += 512) ((LAS unsigned*)(F0.lds + LDSCTL_OFF))[u] = 0u;
    __syncthreads();
    const int lo = A_.ph_lo, hi = A_.ph_hi;
    const bool fused = (hi - lo) > 1;
    XcdBarrier bar; bar.bar = (unsigned*)(F0.ws + WS_CTL) + CW_BAR; bar.x = 0; bar.st = nullptr;
    if (fused) bar = xcd_barrier_post((unsigned*)(F0.ws + WS_CTL) + CW_BAR, MISC + 8);
#ifndef MK_PHMASK
#define MK_PHMASK 0x1fff
#endif
#define PHON(j) (((MK_PHMASK) >> (j)) & 1)
#define IN(k) (lo <= (k) && (k) < hi)
#ifndef MK_BAR_SEC
#define MK_BAR_SEC 0
#endif
    unsigned long long bsec_acc = 0;
#define SEAM(k) do { if (IN(k) && IN((k) + 1)) { unsigned long long bt0_ = 0; const bool bon_ = (((MK_BAR_SEC) >> ((k) == 0 ? 12 : ((k) - 1) % NPH)) & 1) != 0; if (bon_) bt0_ = __builtin_amdgcn_s_memrealtime(); xcd_barrier(bar); if (bon_) bsec_acc += __builtin_amdgcn_s_memrealtime() - bt0_; } } while (0)
#ifndef MK_PROBE_MASK
#define MK_PROBE_MASK 0
#endif
#ifndef MK_PROBE_MULT
#define MK_PROBE_MULT 3
#endif
#define PBEG(j) unsigned long long t0_ = 0; if (((MK_PROBE_MASK) >> (j)) & 1) t0_ = __builtin_amdgcn_s_memrealtime();
#define PEND(j) if (((MK_PROBE_MASK) >> (j)) & 1) { const unsigned long long t1_ = __builtin_amdgcn_s_memrealtime(), te_ = t1_ + (unsigned long long)(MK_PROBE_MULT) * (t1_ - t0_); while (__builtin_amdgcn_s_memrealtime() < te_) __builtin_amdgcn_s_sleep(8); }

    if (PHON(12) && IN(0)) { PBEG(12) ph_prologue(A_, F0); SEAM(0); PEND(12) }

    for (int ch = 0; ch < NCHUNK; ++ch)
        for (int l = 0; l < DEPTH; ++l) {
            const int p0 = 1 + (ch * DEPTH + l) * NPH;
            Frame F = F0; asm volatile("" : "+s"(F.vcu), "+s"(F.G));
            { GAS unsigned char* wsg = (GAS unsigned char*)F0.ws; GAS float* og = (GAS float*)F0.out; asm volatile("" : "+s"(wsg), "+s"(og));
              F.ws = (unsigned char*)wsg; F.out = (float*)og; }
            unsigned char* wl = F.ws + WS_W + (size_t)l * LW;
            if (PHON(0) && IN(p0 + 0) && l == 0 && ch == 0) { PBEG(0) ph_norm1(A_, F, l, ch); SEAM(p0 + 0); PEND(0) }
            if (PHON(1) && IN(p0 + 1)) { PBEG(1)
                pg8::Gemm g{512, 512, 512}; SchedG1 S; S.init(l == DEPTH - 1, F.G, (int)blockIdx.x);
                S.A = (const char*)(F.ws + WS_H); S.B = (const char*)(wl + W_P);
                EpiG1 E{(bf16*)(F.ws + WS_P), F.ws + WS_G8};
                pg8::gemm_phase<EpiG1, SchedG1, true, true, false, true>(F.lds, g, S, E);
                SEAM(p0 + 1); PEND(1)
            }
            if (PHON(3) && IN(p0 + 3)) { PBEG(3) ph_prep(A_, F, l); ph_lru(A_, F, l); SEAM(p0 + 3); PEND(3) }
            if (PHON(4) && IN(p0 + 4)) { PBEG(4) ph_attn(A_, F, l, (char*)lds); SEAM(p0 + 4); PEND(4) }
            if (PHON(5) && IN(p0 + 5)) { PBEG(5)
                pg8::Gemm g{1024, 1024, 1024}; SchedPlain S; S.skipctx = (l != 0); S.T.init(S.skipctx ? BC * 8 : MC / 256, 4, F.G, (int)blockIdx.x);
                S.A = (const char*)(F.ws + WS_M8); S.B = (const char*)(wl + W_O); S.astep = (size_t)256 * 2048; S.bstep = (size_t)256 * 2048;
                EpiMerge E{(const unsigned char*)(F.ws + WS_G8), F.ws + WS_H};
                pg8::gemm_phase<EpiMerge, SchedPlain, true, true, true, true>(F.lds, g, S, E);
                SEAM(p0 + 5); PEND(5)
            }
            if (PHON(6) && IN(p0 + 6)) { PBEG(6)
                pg8::Gemm g{512, 512, 512, 0x7b7b7b7b}; SchedPlain S; S.skipctx = (l != 0); S.T.init(S.skipctx ? BC * 8 : MC / 256, 4, F.G, (int)blockIdx.x);
                S.A = (const char*)(F.ws + WS_H); S.B = (const char*)(wl + W_OUT); S.astep = (size_t)256 * 1024; S.bstep = (size_t)256 * 1024;
                pg8::EpiBf16<0> E{(pg8::bf16_t*)(F.ws + WS_O1), 1024, nullptr, 0, 0, 1.f};
                pg8::gemm_phase<pg8::EpiBf16<0>, SchedPlain, true, true, false, true>(F.lds, g, S, E);
                SEAM(p0 + 6); PEND(6)
            }
            if (PHON(7) && IN(p0 + 7)) { PBEG(7) ph_norm2(A_, F, l, ch); SEAM(p0 + 7); PEND(7) }
            if (PHON(8) && IN(p0 + 8)) { PBEG(8) ph_topk(A_, F, l); SEAM(p0 + 8); PEND(8) }
            if (PHON(9) && IN(p0 + 9)) { PBEG(9)
                pg8::Gemm g{512, 512, 512}; SchedMoe S; S.T.init(l == 0 ? NE * BC + NE * BC / 8 : NE * BC, 8, F.G, (int)blockIdx.x);
                S.A = (const char*)(F.ws + WS_H); S.B = (const char*)(wl + W_GU); S.astep = 0; S.bstep = (size_t)256 * 1024; S.estep = (size_t)2048 * 1024; S.gidx = (const int*)(F.ws + WS_ROWIDX);
                EpiSwiglu E{(unsigned char*)(F.ws + WS_ACT)};
                pg8::gemm_phase<EpiSwiglu, SchedMoe, true, true, false, true, true>(F.lds, g, S, E);
                SEAM(p0 + 9); PEND(9)
            }
            if (PHON(10) && IN(p0 + 10)) { PBEG(10)
                pg8::Gemm g{512, 512, 512}; SchedMoe S; S.T.init(l == 0 ? NE * BC + NE * BC / 8 : NE * BC, 4, F.G, (int)blockIdx.x);
                S.A = (const char*)(F.ws + WS_ACT); S.B = (const char*)(wl + W_D); S.astep = (size_t)256 * 1024; S.bstep = (size_t)256 * 1024; S.estep = (size_t)1024 * 1024; S.gidx = nullptr;
                pg8::EpiBf16<0> E{(pg8::bf16_t*)(F.ws + WS_HS), 1024, nullptr, 0, 0, 1.f};
                pg8::gemm_phase<pg8::EpiBf16<0>, SchedMoe, true, true, false, true>(F.lds, g, S, E);
                SEAM(p0 + 10); PEND(10)
            }
            if (PHON(11) && IN(p0 + 11)) { PBEG(11) ph_combine(A_, F, l, ch);
                if (l == DEPTH - 1 && ch + 1 < NCHUNK) ph_norm1(A_, F, 0, ch + 1);
                SEAM(p0 + 11); PEND(11) }
        }
    if (MK_BAR_SEC) { const unsigned long long te_ = __builtin_amdgcn_s_memrealtime() + 3ull * bsec_acc; while (__builtin_amdgcn_s_memrealtime() < te_) __builtin_amdgcn_s_sleep(8); }
#undef IN
#undef SEAM
}

#ifndef MK_N_LAUNCHES
#define MK_N_LAUNCHES 1
#endif
extern "C" void kernel_launch(void* const* d_in, const int* in_sizes, int n_in, void* d_out, int out_size, void* d_ws, size_t ws_size, hipStream_t stream) {
    static int grid = 0;
    if (grid == 0) {
        if (n_in != N_IN || in_sizes[0] != NB * SEQ * DMODEL || out_size != NB * SEQ * DMODEL || ws_size < WS_END) { fprintf(stderr, "kernel_launch: unexpected shapes / workspace (%d inputs, ws %zu, need %zu)\n", n_in, ws_size, (size_t)WS_END); grid = -1; return; }
        int dev = 0, cus = 0, per_cu = 0;
        if (hipGetDevice(&dev) != hipSuccess || hipDeviceGetAttribute(&cus, hipDeviceAttributeMultiprocessorCount, dev) != hipSuccess) { grid = -1; return; }
        if (hipFuncSetAttribute((const void*)mk_fwd, hipFuncAttributeMaxDynamicSharedMemorySize, LDS_BYTES) != hipSuccess) { fprintf(stderr, "kernel_launch: hipFuncSetAttribute failed\n"); grid = -1; return; }
        if (hipOccupancyMaxActiveBlocksPerMultiprocessor(&per_cu, (const void*)mk_fwd, 512, LDS_BYTES) != hipSuccess || per_cu < 1) { fprintf(stderr, "kernel_launch: occupancy query says %d blocks per CU\n", per_cu); (void)hipGetLastError(); grid = -1; return; }
        grid = cus;
        if (grid != 256) fprintf(stderr, "kernel_launch: %d CUs (built and tuned for 256)\n", grid);
    }
    if (grid < 0) return;
    if (hipMemsetAsync((char*)d_ws + WS_CTL, 0, CTL_ZERO_BYTES, stream) != hipSuccess) return;
    Args a{};
    for (int i = 0; i < N_IN; ++i) a.in[i] = (const float*)d_in[i];
    a.out = (float*)d_out; a.ws = (unsigned char*)d_ws;
#if MK_N_LAUNCHES == 1
    a.ph_lo = 0; a.ph_hi = NPHASES;
    hipLaunchKernelGGL(mk_fwd, dim3(grid), dim3(512), LDS_BYTES, stream, a);
#else
    for (int p = 0; p < NPHASES; ++p) { a.ph_lo = p; a.ph_hi = p + 1; hipLaunchKernelGGL(mk_fwd, dim3(grid), dim3(512), LDS_BYTES, stream, a); }
#endif
}
```

```cpp
#include <hip/hip_runtime.h>
#include <cstdio>
#include <cstdint>
namespace pg8 {
#define PG8_LAS __attribute__((address_space(3)))
typedef unsigned short bf16_t;
typedef short bf16x8 __attribute__((ext_vector_type(8)));
typedef float f32x4 __attribute__((ext_vector_type(4)));
typedef unsigned u32x4 __attribute__((ext_vector_type(4)));
constexpr int BM = 256, BK = 64, HALF = 128, HTB = HALF * BK * 2  , STAGE_BYTES = 8 * HTB, NXCD = 8, WGM = 8;

__host__ __device__ __forceinline__ int lds_byte(int r, int c) { const int st = (r >> 4) * 2 + (c >> 5), rr = r & 15, cc = c & 31, ob = rr * 64 + cc * 2; return st * 1024 + (ob ^ (((ob >> 9) & 1) << 5)); }
__host__ __device__ __forceinline__ void stage_rc(int b, int& R, int& C) { const int st = b / 1024, sb = b % 1024, swz = sb ^ (((sb >> 9) & 1) << 5); R = (st >> 1) * 16 + swz / 64; C = (st & 1) * 32 + (swz % 64) / 2; }
__host__ __device__ __forceinline__ int perm32(int rho) { const int n = rho >> 4, i = rho & 15; return 8 * (i >> 2) + 4 * n + (i & 3); }

struct Unit { int pm, pn; const char* A; const char* B; const int* gidx; };
struct Gemm { int lda, ldb, K; int sca = 0x7f7f7f7f, scw = 0x79797979; };

__device__ __forceinline__ unsigned cvt_pk_bf16(float lo, float hi) { unsigned r; asm volatile("v_cvt_pk_bf16_f32 %0, %1, %2" : "=v"(r) : "v"(lo), "v"(hi)); return r; }
typedef float f32x2 __attribute__((ext_vector_type(2)));
__device__ __forceinline__ f32x2 gelu_pk(f32x2 v) {
    const f32x2 av = __builtin_elementwise_abs(v), d = av * 0.2316418882f + 1.0f;
    f32x2 t; t.x = __builtin_amdgcn_rcpf(d.x); t.y = __builtin_amdgcn_rcpf(d.y);
    f32x2 q = t * 0.5307027145f + (-0.7265760135f); q = q * t + 0.7107068705f; q = q * t + (-0.142248368f); q = q * t + 0.127414796f; q = q * t;
    const f32x2 s = (v * v) * (-0.72134752044f);
    f32x2 e; e.x = __builtin_amdgcn_exp2f(s.x); e.y = __builtin_amdgcn_exp2f(s.y);
    const f32x2 m = v * (q * e), r = v - m;
    f32x2 o; o.x = v.x < 0.f ? m.x : r.x; o.y = v.y < 0.f ? m.y : r.y; return o;
}

template <int ACT  > struct EpiBf16 {
    static constexpr bool PERM = true, AFTER_DRAIN = false; static_assert(ACT == 0 || ACT == 1, "EpiBf16: ACT is 0 (none) or 1 (gelu_pk)");
    bf16_t* O; int ldc; const float* bias; int split_cols; size_t split_stride; float scale0;
    __device__ __forceinline__ void operator()(const f32x4 (&acc)[2][2][4][2], const Unit& u, int wr, int wc, int fr, int fq) const {
        int row0 = u.pm * BM + wr * 64 + fr; asm volatile("" : "+v"(row0));
        int colt = u.pn * BM; bf16_t* base = O;
        float sc = 1.f; if (split_cols) { const int t = colt / split_cols; base += (size_t)t * split_stride; colt -= t * split_cols; if (t == 0) sc = scale0; }
        const int col0 = colt + wc * 32 + 8 * fq, bcol0 = u.pn * BM + wc * 32 + 8 * fq;
        f32x4 bv[2][2];
#pragma unroll
        for (int bj = 0; bj < 2; ++bj)
#pragma unroll
            for (int n = 0; n < 2; ++n) bv[bj][n] = bias ? *(const f32x4*)(bias + bcol0 + bj * HALF + 4 * n) : (f32x4){0.f, 0.f, 0.f, 0.f};
#pragma unroll
        for (int ai = 0; ai < 2; ++ai)
#pragma unroll
            for (int m = 0; m < 4; ++m) { bf16_t* rowp = base + (size_t)(row0 + ai * HALF + m * 16) * ldc + col0;
#pragma unroll
                for (int bj = 0; bj < 2; ++bj) { f32x4 v0 = acc[ai][bj][m][0] + bv[bj][0], v1 = acc[ai][bj][m][1] + bv[bj][1];
                    if (ACT == 1) { f32x2 a = gelu_pk((f32x2){v0[0], v0[1]}), b = gelu_pk((f32x2){v0[2], v0[3]}), c = gelu_pk((f32x2){v1[0], v1[1]}), d = gelu_pk((f32x2){v1[2], v1[3]});
                        v0 = (f32x4){a.x, a.y, b.x, b.y}; v1 = (f32x4){c.x, c.y, d.x, d.y}; }
                    v0 = v0 * sc; v1 = v1 * sc; u32x4 w; w.x = cvt_pk_bf16(v0[0], v0[1]); w.y = cvt_pk_bf16(v0[2], v0[3]); w.z = cvt_pk_bf16(v1[0], v1[1]); w.w = cvt_pk_bf16(v1[2], v1[3]);
                    *(u32x4*)(rowp + bj * HALF) = w; } }
    }
};

typedef int v8i32 __attribute__((ext_vector_type(8))); typedef int v4i32 __attribute__((ext_vector_type(4)));
__device__ __forceinline__ v8i32 cat8(bf16x8 lo, bf16x8 hi) { return __builtin_shufflevector(__builtin_bit_cast(v4i32, lo), __builtin_bit_cast(v4i32, hi), 0, 1, 2, 3, 4, 5, 6, 7); }
template <class Epi, class Sched, bool ALIGN_EPI = false, bool SP2 = false, bool KHOOK = false, bool FP8 = false, bool GATHER = false>
__device__ __forceinline__ void gemm_phase(PG8_LAS unsigned char* lds, const Gemm g, const Sched& S, const Epi& E) {
    int tid_ = threadIdx.x; asm volatile("" : "+v"(tid_));
    const int tid = tid_, wid = __builtin_amdgcn_readfirstlane(tid >> 6), lane = tid & 63, wr = wid >> 2, wc = wid & 3, fr = lane & 15, fq = lane >> 4;
    const int K = g.K, nt = K / BK;
    unsigned voffA[2], voffB[2];
#pragma unroll
    for (int i = 0; i < 2; ++i) { int R, C; stage_rc(tid * 16 + i * 8192, R, C); const int Rb = Epi::PERM ? ((R & ~31) + perm32(R & 31)) : R;
        voffA[i] = (unsigned)(R * g.lda + C) * 2u; voffB[i] = (unsigned)(Rb * g.ldb + C) * 2u; }
    static_assert(!GATHER || SP2, "GATHER is written for the SP2 loop");
    unsigned vg[2][2], nvg[2][2];
#define PG8_GLOAD(dst, U) do { _Pragma("unroll") for (int h_ = 0; h_ < 2; ++h_) _Pragma("unroll") for (int i_ = 0; i_ < 2; ++i_) { int R_, C_; stage_rc(tid * 16 + i_ * 8192, R_, C_); \
        dst[h_][i_] = (unsigned)(U).gidx[h_ * HALF + R_] * (unsigned)(g.lda * 2) + (unsigned)(C_ * 2); } } while (0)
#define PG8_STAGEA(bufoff, kbase, half, nx) do { if constexpr (GATHER) { const bool un_ = (nx); unsigned vs_[2] = {un_ ? nvg[half][0] : vg[half][0], un_ ? nvg[half][1] : vg[half][1]}; PG8_STAGE(bufoff, kbase, vs_); } \
        else { PG8_STAGE(bufoff, (kbase) + ((half) ? hstepA : (size_t)0), voffA); } } while (0)
    const size_t kstep = (size_t)(BK * 2);
    const size_t hstepA = (size_t)HALF * g.lda * 2, hstepB = (size_t)HALF * g.ldb * 2;
    const unsigned ldsw = (unsigned)wid * 1024u;
    const int aoff = lds_byte(wr * 64 + fr, fq * 8), boff = lds_byte(wc * 32 + fr, fq * 8);
#define PG8_SA(b, h) (((b) * 2 + (h)) * HTB)
#define PG8_SB(b, h) ((4 + (b) * 2 + (h)) * HTB)
#define PG8_STAGE(bufoff, gbase, voff) do { _Pragma("unroll") for (int _i = 0; _i < 2; ++_i) \
        __builtin_amdgcn_global_load_lds((const unsigned*)((const char*)(gbase) + (voff)[_i]), (PG8_LAS unsigned*)(lds + (bufoff) + ldsw + _i * 8192), 16, 0, 0); } while (0)
#define PG8_LDA(dst, b, h) do { _Pragma("unroll") for (int m = 0; m < 4; ++m) dst[m] = cat8(*(const PG8_LAS bf16x8*)(lds + PG8_SA(b, h) + aoff + m * 2048), *(const PG8_LAS bf16x8*)(lds + PG8_SA(b, h) + aoff + m * 2048 + 1024)); } while (0)
#define PG8_LDB(dst, b, h) do { _Pragma("unroll") for (int n = 0; n < 2; ++n) dst[n] = cat8(*(const PG8_LAS bf16x8*)(lds + PG8_SB(b, h) + boff + n * 2048), *(const PG8_LAS bf16x8*)(lds + PG8_SB(b, h) + boff + n * 2048 + 1024)); } while (0)
#define PG8_LO(x) __builtin_bit_cast(bf16x8, __builtin_shufflevector((x), (x), 0, 1, 2, 3))
#define PG8_HI(x) __builtin_bit_cast(bf16x8, __builtin_shufflevector((x), (x), 4, 5, 6, 7))
#define PG8_MMA(ai, bj, At, Bt) do { __builtin_amdgcn_s_setprio(1); _Pragma("unroll") for (int m = 0; m < 4; ++m) _Pragma("unroll") for (int n = 0; n < 2; ++n) { \
        if constexpr (FP8) asm volatile("v_mfma_scale_f32_16x16x128_f8f6f4 %0, %1, %2, %0, %3, %4 op_sel_hi:[0,0,0]" : "+v"(acc[ai][bj][m][n]) : "v"(Bt[n]), "v"(At[m]), "v"(fp8_scw), "v"(fp8_sca));   \
        else { acc[ai][bj][m][n] = __builtin_amdgcn_mfma_f32_16x16x32_bf16(PG8_LO(Bt[n]), PG8_LO(At[m]), acc[ai][bj][m][n], 0, 0, 0); \
               acc[ai][bj][m][n] = __builtin_amdgcn_mfma_f32_16x16x32_bf16(PG8_HI(Bt[n]), PG8_HI(At[m]), acc[ai][bj][m][n], 0, 0, 0); } } __builtin_amdgcn_s_setprio(0); } while (0)
#define PG8_WAIT_V(n) asm volatile("s_waitcnt vmcnt(" #n ")" ::: "memory")
#define PG8_WAIT_L(n) asm volatile("s_waitcnt lgkmcnt(" #n ")" ::: "memory")
#define PG8_BAR __builtin_amdgcn_s_barrier()
#define PG8_SCHED __builtin_amdgcn_sched_barrier(0)
    const int fp8_scw = g.scw, fp8_sca = g.sca;
    unsigned long long gsec_acc = 0;
    Unit cur, nxt; int ui = 0;
    if (!S.next(0, cur)) return;
    f32x4 acc[2][2][4][2];
#pragma unroll
    for (int a = 0; a < 2; ++a)
#pragma unroll
        for (int b = 0; b < 2; ++b)
#pragma unroll
            for (int m = 0; m < 4; ++m)
#pragma unroll
                for (int n = 0; n < 2; ++n) acc[a][b][m][n] = (f32x4){0.f, 0.f, 0.f, 0.f};
    v8i32 At[4], B0[2], B1[2];
    const char* cA = cur.A; const char* cB = cur.B;
    S.a_ready(cur);
    if constexpr (GATHER) PG8_GLOAD(vg, cur);
    if constexpr (SP2) {
        PG8_STAGE(PG8_SB(0, 0), cB, voffB); PG8_STAGE(PG8_SB(0, 1), cB + hstepB, voffB); PG8_STAGEA(PG8_SA(0, 0), cA, 0, false); PG8_STAGEA(PG8_SA(0, 1), cA, 1, false);
        if (wr == 1) PG8_BAR;
        PG8_WAIT_V(2); PG8_BAR;
        PG8_STAGE(PG8_SB(1, 0), cB + kstep, voffB); PG8_STAGEA(PG8_SA(1, 0), cA + kstep, 0, false); PG8_STAGE(PG8_SB(1, 1), cB + hstepB + kstep, voffB);
        PG8_WAIT_V(6); PG8_BAR;
    } else {
        PG8_STAGE(PG8_SB(0, 0), cB, voffB); PG8_STAGE(PG8_SA(0, 0), cA, voffA); PG8_STAGE(PG8_SB(0, 1), cB + hstepB, voffB); PG8_STAGE(PG8_SA(0, 1), cA + hstepA, voffA);
        if (wr == 1) PG8_BAR;
        PG8_WAIT_V(4); PG8_BAR;
        PG8_STAGE(PG8_SB(1, 0), cB + kstep, voffB); PG8_STAGE(PG8_SA(1, 0), cA + kstep, voffA); PG8_STAGE(PG8_SB(1, 1), cB + hstepB + kstep, voffB);
        PG8_WAIT_V(6); PG8_BAR;
    }
    for (;;) {
        const bool has_next = S.next(ui + 1, nxt);
        const char* nA = has_next ? nxt.A : cA; const char* nB = has_next ? nxt.B : cB;
        if constexpr (GATHER) { if (has_next) PG8_GLOAD(nvg, nxt); }
#pragma unroll 1
        for (int t = 0; t < nt; t += 2) {
            const bool last = (t == nt - 2);
            if constexpr (KHOOK) { if (t == Epi::HOOK_T0 || t == Epi::HOOK_T1) { if constexpr (ALIGN_EPI) { if (wr == 0) PG8_BAR; }
                if constexpr (FP8) asm volatile("s_nop 15\n\ts_nop 15" ::: "memory"); E.khook(acc, cur, t, wr, wc, fr, fq); if constexpr (ALIGN_EPI) { if (wr == 1) PG8_BAR; } } }
            const char* a1 = cA + (size_t)(t + 1) * kstep;
            const char* a2 = last ? nA : cA + (size_t)(t + 2) * kstep; const char* b2 = last ? nB : cB + (size_t)(t + 2) * kstep;
            const char* a3 = a2 + kstep; const char* b3 = b2 + kstep;
            if (last && has_next) S.a_ready(nxt);
            if constexpr (SP2) {
            PG8_LDB(B0, 0, 0); PG8_LDB(B1, 0, 1); PG8_SCHED; PG8_LDA(At, 0, 0); PG8_STAGEA(PG8_SA(1, 1), a1, 1, false);
            PG8_WAIT_V(8); PG8_WAIT_L(0); PG8_BAR; PG8_MMA(0, 0, At, B0); PG8_MMA(0, 1, At, B1); PG8_BAR; PG8_SCHED;
            PG8_LDA(At, 0, 1); PG8_STAGE(PG8_SB(0, 0), b2, voffB); PG8_STAGE(PG8_SB(0, 1), b2 + hstepB, voffB); PG8_STAGEA(PG8_SA(0, 0), a2, 0, last && has_next);
            PG8_WAIT_V(8); PG8_WAIT_L(0); PG8_BAR; PG8_MMA(1, 0, At, B0); PG8_MMA(1, 1, At, B1); PG8_BAR; PG8_SCHED;
            PG8_LDB(B0, 1, 0); PG8_LDB(B1, 1, 1); PG8_SCHED; PG8_LDA(At, 1, 0); PG8_STAGEA(PG8_SA(0, 1), a2, 1, last && has_next);
            PG8_WAIT_V(8); PG8_WAIT_L(0); PG8_BAR; PG8_MMA(0, 0, At, B0); PG8_MMA(0, 1, At, B1); PG8_BAR; PG8_SCHED;
            PG8_LDA(At, 1, 1); PG8_STAGE(PG8_SB(1, 0), b3, voffB); PG8_STAGE(PG8_SB(1, 1), b3 + hstepB, voffB); PG8_STAGEA(PG8_SA(1, 0), a3, 0, last && has_next);
            PG8_WAIT_V(8); PG8_WAIT_L(0); PG8_BAR; PG8_MMA(1, 0, At, B0); PG8_MMA(1, 1, At, B1); PG8_BAR; PG8_SCHED;
            } else {
            PG8_LDB(B0, 0, 0); PG8_SCHED; PG8_LDA(At, 0, 0); PG8_STAGE(PG8_SA(1, 1), a1 + hstepA, voffA);
            PG8_WAIT_L(8); PG8_BAR; PG8_WAIT_L(0); PG8_MMA(0, 0, At, B0); PG8_BAR; PG8_SCHED;
            PG8_LDB(B1, 0, 1); PG8_STAGE(PG8_SB(0, 0), b2, voffB);
            PG8_BAR; PG8_WAIT_L(0); PG8_MMA(0, 1, At, B1); PG8_BAR;
            PG8_LDA(At, 0, 1); PG8_STAGE(PG8_SA(0, 0), a2, voffA);
            PG8_BAR; PG8_WAIT_L(0); PG8_MMA(1, 0, At, B0); PG8_BAR; PG8_SCHED;
            PG8_STAGE(PG8_SB(0, 1), b2 + hstepB, voffB);
            PG8_WAIT_V(6); PG8_BAR; PG8_MMA(1, 1, At, B1); PG8_BAR;
            PG8_LDB(B0, 1, 0); PG8_SCHED; PG8_LDA(At, 1, 0); PG8_STAGE(PG8_SA(0, 1), a2 + hstepA, voffA);
            PG8_WAIT_L(8); PG8_BAR; PG8_WAIT_L(0); PG8_MMA(0, 0, At, B0); PG8_BAR; PG8_SCHED;
            PG8_LDB(B1, 1, 1); PG8_STAGE(PG8_SB(1, 0), b3, voffB);
            PG8_BAR; PG8_WAIT_L(0); PG8_MMA(0, 1, At, B1); PG8_BAR;
            PG8_LDA(At, 1, 1); PG8_STAGE(PG8_SA(1, 0), a3, voffA);
            PG8_BAR; PG8_WAIT_L(0); PG8_MMA(1, 0, At, B0); PG8_BAR; PG8_SCHED;
            PG8_STAGE(PG8_SB(1, 1), b3 + hstepB, voffB);
            PG8_WAIT_V(6); PG8_BAR; PG8_MMA(1, 1, At, B1); PG8_BAR;
            }
        }
        if constexpr (FP8) asm volatile("s_nop 15\n\ts_nop 15" ::: "memory");
        if constexpr (ALIGN_EPI) { if (wr == 0) PG8_BAR; }
#ifndef MK_GEMM_SEC
#define MK_GEMM_SEC 0
#endif
        unsigned long long gsec_t0 = 0; if (MK_GEMM_SEC == 1) gsec_t0 = __builtin_amdgcn_s_memrealtime();
        if constexpr (!Epi::AFTER_DRAIN) { E(acc, cur, wr, wc, fr, fq); S.done(cur); }
        if (MK_GEMM_SEC == 1) gsec_acc += __builtin_amdgcn_s_memrealtime() - gsec_t0;
        if (!has_next) break;
#pragma unroll
        for (int a = 0; a < 2; ++a)
#pragma unroll
            for (int b = 0; b < 2; ++b)
#pragma unroll
                for (int m = 0; m < 4; ++m)
#pragma unroll
                    for (int n = 0; n < 2; ++n) acc[a][b][m][n] = (f32x4){0.f, 0.f, 0.f, 0.f};
        cur = nxt; cA = nA; cB = nB; ++ui;
        if constexpr (GATHER) { vg[0][0] = nvg[0][0]; vg[0][1] = nvg[0][1]; vg[1][0] = nvg[1][0]; vg[1][1] = nvg[1][1]; }
        if constexpr (ALIGN_EPI) { if (wr == 1) PG8_BAR; }
    }
    PG8_WAIT_V(0);
    if constexpr (!ALIGN_EPI) { if (wr == 0) PG8_BAR; }
    PG8_BAR;
    if constexpr (Epi::AFTER_DRAIN) { E.fused(acc, cur, wr, wc, fr, fq, lds, wid, lane); S.done(cur); }
    if (MK_GEMM_SEC != 0) { const unsigned long long te_ = __builtin_amdgcn_s_memrealtime() + 3ull * gsec_acc; while (__builtin_amdgcn_s_memrealtime() < te_) __builtin_amdgcn_s_sleep(8); }
#undef PG8_SA
#undef PG8_SB
#undef PG8_STAGE
#undef PG8_STAGEA
#undef PG8_GLOAD
#undef PG8_LDA
#undef PG8_LDB
#undef PG8_MMA
#undef PG8_LO
#undef PG8_HI
#undef PG8_WAIT_V
#undef PG8_WAIT_L
#undef PG8_BAR
#undef PG8_SCHED
}
}
#include <hip/hip_bf16.h>
#include <cmath>
namespace attn_body {
using bf16=__hip_bfloat16;
using bf16x8=__attribute__((ext_vector_type(8)))short;
using s16x4=__attribute__((ext_vector_type(4)))short;
using f32x16=__attribute__((ext_vector_type(16)))float;
using u32x4=__attribute__((ext_vector_type(4)))unsigned;
constexpr int D=64,DM=4352;
constexpr int NW=8,QBLK=32,QB=QBLK*NW,KVBLK=64;
constexpr int ATTN_PITCH=DM, ATTN_UNIT_ROWS=QB;
constexpr int ATTN_OPITCH=2048; constexpr float ATTN_OSCALE=32.f;
__device__ __forceinline__ int crow(int r,int hi){return (r&3)+8*(r>>2)+4*hi;}
#define SBAR() __builtin_amdgcn_sched_barrier(0)
constexpr int NSLOT=3, SLOTB=8192;
constexpr int LDS_K=0, LDS_V=NSLOT*SLOTB, LDS_WS=2*NSLOT*SLOTB, LDS_OST=LDS_WS+NW*64*4, LDS_BYTES=LDS_OST+NW*4096, LDS_NATAB=LDS_BYTES, NATAB_BYTES=15*128*4;
constexpr float C2=0.125f*1.4426950408889634f;
__device__ __forceinline__ void glds16(const void*gsrc,unsigned lds_dst){unsigned keep;
  asm volatile("s_mov_b32 %0, m0\n\ts_mov_b32 m0, %2\n\ts_nop 0\n\tglobal_load_lds_dwordx4 %1, off\n\ts_mov_b32 m0, %0":"=&s"(keep):"v"(gsrc),"s"(lds_dst):"memory");}
__device__ __forceinline__ void glds4(const void*gsrc,unsigned lds_dst){unsigned keep;
  asm volatile("s_mov_b32 %0, m0\n\ts_mov_b32 m0, %2\n\ts_nop 0\n\tglobal_load_lds_dword %1, off\n\ts_mov_b32 m0, %0":"=&s"(keep):"v"(gsrc),"s"(lds_dst):"memory");}
__device__ __forceinline__ float max3f(float a,float b,float c){float r;asm("v_max3_f32 %0, %1, %2, %3":"=v"(r):"v"(a),"v"(b),"v"(c));return r;}
__device__ __forceinline__ float max2f(float a,float b){float r;asm("v_max_f32_e32 %0, %1, %2":"=v"(r):"v"(a),"v"(b));return r;}
__device__ __forceinline__ float fadd_s(float a,float b){float r;asm("v_add_f32_e32 %0, %1, %2":"=v"(r):"v"(a),"v"(b));return r;}
__device__ __forceinline__ float fsub_s(float a,float b){float r;asm("v_sub_f32_e32 %0, %1, %2":"=v"(r):"v"(a),"v"(b));return r;}
typedef float f32x2_t __attribute__((ext_vector_type(2))); typedef __bf16 bf16x2_t __attribute__((ext_vector_type(2)));
__device__ __forceinline__ unsigned cvtpk_s(float lo,float hi){f32x2_t v={lo,hi};bf16x2_t b=__builtin_convertvector(v,bf16x2_t);return __builtin_bit_cast(unsigned,b);}
#define WAIT_BAR(N) asm volatile("s_waitcnt vmcnt(" #N ") lgkmcnt(0)\n\ts_barrier":::"memory")

__device__ __forceinline__ void qkt(f32x16&p0,f32x16&p1,const char*Kslot,const bf16x8*qr,const f32x16&negm,int r32,int hi){
  const char*kb=Kslot+hi*1024+r32*16;
  #pragma unroll
  for(int d0=0;d0<4;++d0){
    const bf16x8 b0=*reinterpret_cast<const bf16x8*>(kb+d0*2048);
    const bf16x8 b1=*reinterpret_cast<const bf16x8*>(kb+d0*2048+512);
    if(d0==0){p0=__builtin_amdgcn_mfma_f32_32x32x16_bf16(b0,qr[0],negm,0,0,0);p1=__builtin_amdgcn_mfma_f32_32x32x16_bf16(b1,qr[0],negm,0,0,0);}
    else{p0=__builtin_amdgcn_mfma_f32_32x32x16_bf16(b0,qr[d0],p0,0,0,0);p1=__builtin_amdgcn_mfma_f32_32x32x16_bf16(b1,qr[d0],p1,0,0,0);}}
}
typedef __attribute__((address_space(3))) const char* lds_cptr;
typedef short v4i16_t __attribute__((ext_vector_type(4)));
__device__ __forceinline__ void kload8(bf16x8*kf,lds_cptr kp){
  kf[0]=*(const __attribute__((address_space(3))) bf16x8*)(kp);      kf[1]=*(const __attribute__((address_space(3))) bf16x8*)(kp+512);
  kf[2]=*(const __attribute__((address_space(3))) bf16x8*)(kp+2048); kf[3]=*(const __attribute__((address_space(3))) bf16x8*)(kp+2560);
  kf[4]=*(const __attribute__((address_space(3))) bf16x8*)(kp+4096); kf[5]=*(const __attribute__((address_space(3))) bf16x8*)(kp+4608);
  kf[6]=*(const __attribute__((address_space(3))) bf16x8*)(kp+6144); kf[7]=*(const __attribute__((address_space(3))) bf16x8*)(kp+6656);
}
__device__ __forceinline__ void kload2(bf16x8*kf,lds_cptr kp,int j){ kf[2*j]=*(const __attribute__((address_space(3))) bf16x8*)(kp+j*2048); kf[2*j+1]=*(const __attribute__((address_space(3))) bf16x8*)(kp+j*2048+512); }
__device__ __forceinline__ s16x4 vtr(lds_cptr p){ return __builtin_bit_cast(s16x4,__builtin_amdgcn_ds_read_tr16_b64_v4i16((__attribute__((address_space(3))) v4i16_t*)p)); }
__device__ __forceinline__ float rowmax(const f32x16&p0,const f32x16&p1){
  float a=max3f(p0[0],p0[1],p1[0]),b=max3f(p0[2],p0[3],p1[1]);a=max3f(a,p1[2],p1[3]);
  #pragma unroll
  for(int r=4;r<16;r+=4){a=max3f(a,p0[r],p0[r+1]);b=max3f(b,p0[r+2],p0[r+3]);a=max3f(a,p1[r],p1[r+1]);b=max3f(b,p1[r+2],p1[r+3]);}
  const float m=max2f(a,b);
  auto rr=__builtin_amdgcn_permlane32_swap(__float_as_uint(m),__float_as_uint(m),false,false);
  return max2f(__uint_as_float(rr[0]),__uint_as_float(rr[1]));
}
__device__ __forceinline__ void pv(f32x16*o,int vb,bf16x8 pa0,bf16x8 pa1,bf16x8 pa2,bf16x8 pa3){
  #pragma unroll
  for(int d0=0;d0<2;++d0){s16x4 lo[4],hi[4];
    #pragma unroll
    for(int ks=0;ks<4;++ks){
      asm volatile("ds_read_b64_tr_b16 %0,%1 offset:%c2":"=&v"(lo[ks]):"v"(vb),"i"(d0*4096+ks*1024):"memory");
      asm volatile("ds_read_b64_tr_b16 %0,%1 offset:%c2":"=&v"(hi[ks]):"v"(vb),"i"(d0*4096+ks*1024+512):"memory");}
    asm volatile("s_waitcnt lgkmcnt(0)":::"memory");SBAR();
    #define PK(k) (bf16x8){lo[k][0],lo[k][1],lo[k][2],lo[k][3],hi[k][0],hi[k][1],hi[k][2],hi[k][3]}
    o[d0]=__builtin_amdgcn_mfma_f32_32x32x16_bf16(pa0,PK(0),o[d0],0,0,0);
    o[d0]=__builtin_amdgcn_mfma_f32_32x32x16_bf16(pa1,PK(1),o[d0],0,0,0);
    o[d0]=__builtin_amdgcn_mfma_f32_32x32x16_bf16(pa2,PK(2),o[d0],0,0,0);
    o[d0]=__builtin_amdgcn_mfma_f32_32x32x16_bf16(pa3,PK(3),o[d0],0,0,0);
    #undef PK
  }
}

#ifndef ATTN_STORE16
#define ATTN_STORE16(p,v) (*(u32x4*)(p)=(v))
#endif
__device__ __forceinline__ void na_fill_table(const float*rpbh,char*shm){
  int tid_=threadIdx.x; asm volatile("":"+v"(tid_));
  __attribute__((address_space(3))) float* tw=(__attribute__((address_space(3))) float*)((__attribute__((address_space(3))) char*)shm+LDS_NATAB);
  for(int i=tid_;i<15*128;i+=NW*64){ const int dr=i>>7, j=(i&127)-63; tw[i]=(j>=-15&&j<=15)?rpbh[dr*31+j+15]*1.4426950408889634f:0.f; }
}
template<int THRL,int MODE> __device__ __forceinline__ void attn_unit(const bf16*Q0,const bf16*__restrict__ Kh,const bf16*__restrict__ Vh,unsigned char*O0,const int NT,const int R0w,const int nar0,const float*rpbh,char*shm,
    const bool pre,const bf16*nQ0,const bf16*nKh,const bf16*nVh){
  int tid_=threadIdx.x; asm volatile("":"+v"(tid_));
  const int tid=tid_,lane=tid&63,r32=lane&31,hi=lane>>5; const int wid=__builtin_amdgcn_readfirstlane(tid>>6);
  const bf16*Qw=Q0+(long)wid*QBLK*DM;
  const unsigned lds0=(unsigned)(uintptr_t)shm;
  float*wsf=(float*)(shm+LDS_WS)+wid*64;
  const bf16*ksrc=Kh+(long)lane*DM+wid*8;
  const bf16*vsrc=Vh+(long)(16*(wid&3)+(lane>>2))*DM+(wid>>2)*32+(lane&3)*8;
  const unsigned kdst=lds0+LDS_K+wid*1024, vdst=lds0+LDS_V+wid*1024;
  #define DMA_K(t,slot) glds16(ksrc+(long)TILE(t)*KVBLK*DM,(unsigned)__builtin_amdgcn_readfirstlane(kdst+(slot)))
  #define DMA_V(t,slot) glds16(vsrc+(long)TILE(t)*KVBLK*DM,(unsigned)__builtin_amdgcn_readfirstlane(vdst+(slot)))
  const int vb0=(int)(lds0+LDS_V)+((lane>>4)&1)*32+(lane&3)*8+(4*hi+((lane&15)>>2))*64;
  const char*Kbase=shm+LDS_K; bf16x8 kf[8];
  const lds_cptr shm3=(lds_cptr)shm; const lds_cptr kp0=shm3+LDS_K+hi*1024+r32*16; const lds_cptr vp0=shm3+LDS_V+((lane>>4)&1)*32+(lane&3)*8+(4*hi+((lane&15)>>2))*64;
  #define TILE(t) ((t)+(((t)>=4)?R0w:0))
  const int nr=nar0+(wid>>1), nc=32*(wid&1)+r32; const int nrs=min(max(nr-4,0),24), ncs=min(max(nc-8,0),48);
  const __attribute__((address_space(3))) float* ntab=(const __attribute__((address_space(3))) float*)((lds_cptr)shm+LDS_NATAB)+63-nc+4*hi;
  (void)rpbh;
  if(!pre){DMA_K(0,0);DMA_V(0,0);DMA_K(1,SLOTB);}
  else{DMA_V(0,0);}
  bf16x8 qr[4];
  #pragma unroll
  for(int d0=0;d0<4;++d0)qr[d0]=*reinterpret_cast<const bf16x8*>(&Qw[(long)r32*DM+d0*16+hi*8]);
  float mhat=0.f,l_reg=0.f;f32x16 o[2];o[0]=f32x16{};o[1]=f32x16{};f32x16 negm=f32x16{}; if(MODE==0)asm volatile("":"+v"(negm));
  #define CMASK(P0,P1,t) do{ if(MODE==1){ if((t)<4){ _Pragma("unroll") for(int r=0;r<16;++r){P0[r]-=mhat;P1[r]-=mhat;} } else { const int kr_=R0w+(t)-4; \
      if((unsigned)(kr_-nrs)>=8u){ _Pragma("unroll") for(int r=0;r<16;++r){P0[r]=-INFINITY;P1[r]=-INFINITY;} } \
      else{ const __attribute__((address_space(3))) float* br_=ntab+(kr_-nr+7)*128; \
        _Pragma("unroll") for(int r=0;r<16;++r){ const int ko_=(r&3)+8*(r>>2); const int kc_=ko_+4*hi; \
          P0[r]=((unsigned)(kc_-ncs)<16u)?P0[r]+(br_[ko_]-mhat):-INFINITY; P1[r]=((unsigned)(kc_+32-ncs)<16u)?P1[r]+(br_[ko_+32]-mhat):-INFINITY; \
          if((r&3)==3){ asm volatile("":"+v"(P0),"+v"(P1)); SBAR(); } } } } } }while(0)
  bool resc=false;
  #define NEGMC (MODE==1?f32x16{}:negm)
  #define START(P0,P1) do{ const float rm=rowmax(P0,P1); resc=false; \
    { const float dl=rm; mhat=fadd_s(mhat,dl); \
      _Pragma("unroll") for(int r=0;r<16;++r){P0[r]=fsub_s(P0[r],dl);P1[r]=fsub_s(P1[r],dl);} \
      if(MODE==0){ _Pragma("unroll") for(int r=0;r<16;++r)negm[r]=-mhat; asm volatile("":"+v"(negm)); } } \
    _Pragma("unroll") for(int r=0;r<16;++r)P0[r]=__builtin_amdgcn_exp2f(P0[r]); }while(0)
  #define RESC() do{ if(resc){ asm volatile("s_waitcnt lgkmcnt(0)":::"memory"); \
      _Pragma("unroll") for(int d_=0;d_<2;++d_) _Pragma("unroll") for(int r=0;r<16;++r)o[d_][r]*=wsf[crow(r,hi)]; } }while(0)
  f32x16 pA0,pA1,pB0,pB1;
  int sl_prev=0,sl_cur=0,sl_next=SLOTB;
  #define ROT() do{sl_prev=sl_cur;sl_cur=sl_next;sl_next=(sl_next==(NSLOT-1)*SLOTB)?0:sl_next+SLOTB;}while(0)
  if(!pre){ DMA_K(2,2*SLOTB);
    WAIT_BAR(3); }
  else{ WAIT_BAR(5); }
  qkt(pA0,pA1,Kbase,qr,negm,r32,hi);asm volatile("s_nop 15\n\ts_nop 7":"+v"(pA0),"+v"(pA1));CMASK(pA0,pA1,0);
  START(pA0,pA1);
  _Pragma("unroll") for(int r=0;r<16;++r)pA1[r]=__builtin_amdgcn_exp2f(pA1[r]);
  WAIT_BAR(0);
  DMA_K(3,0);DMA_V(1,SLOTB);
  ROT();
  kload8(kf,kp0+sl_cur);
  WAIT_BAR(2);
  s16x4 vlo[8],vhi[8]; u32x4 pw0,pw1,pw2,pw3;
  #define PKW(P,B) cvtpk_s(P[B],P[B+1])
  #define PAF(k) __builtin_bit_cast(bf16x8,pw##k)
  #define VFR(i) (bf16x8){vlo[i][0],vlo[i][1],vlo[i][2],vlo[i][3],vhi[i][0],vhi[i][1],vhi[i][2],vhi[i][3]}
  #define PIN(x) asm volatile("":"+v"(x))
  #define MX3(a,b,c) __builtin_fmaxf(__builtin_fmaxf((a),(b)),(c))
  #define GAPA(MF,A0,A1,A2,A3,W0,W1,PW) do{ MF; sacc+=A0; sacc+=A1; sacc+=A2; sacc+=A3; PIN(sacc); W0; W1; PIN(PW); SBAR(); }while(0)
  #define EX(v) __builtin_amdgcn_exp2f(v)
  #define GAPB(MF,X,B) do{ MF; X[B]=EX(X[B]); X[B+1]=EX(X[B+1]); X[B+2]=EX(X[B+2]); X[B+3]=EX(X[B+3]); PIN(X); SBAR(); }while(0)
  #define VRD(i) do{ vlo[i]=vtr(vp_+(((i)>>2)*4096+((i)&3)*1024)); vhi[i]=vtr(vp_+(((i)>>2)*4096+((i)&3)*1024+512)); }while(0)
  #define KRD(G,j) do{ if(G){ kload2(kf,kp0+sl_next,j); SBAR(); } }while(0)
  #define STEP(C0,C1,P0,P1,t,GK,GV,GL) do{ SBAR(); \
    const lds_cptr vp_=vp0+sl_prev; \
    VRD(0); SBAR(); float sacc=(P0[0]+P0[1]); \
    GAPA(C0=__builtin_amdgcn_mfma_f32_32x32x16_bf16(kf[0],qr[0],NEGMC,0,0,0), P0[2],P0[3],P0[4],P0[5],     pw0[0]=PKW(P0,0), pw0[1]=PKW(P0,2), pw0); \
    VRD(4); SBAR(); GAPA(C1=__builtin_amdgcn_mfma_f32_32x32x16_bf16(kf[1],qr[0],NEGMC,0,0,0), P0[6],P0[7],P0[8],P0[9],     pw0[2]=PKW(P0,4), pw0[3]=PKW(P0,6), pw0); \
    VRD(1); SBAR(); GAPA(C0=__builtin_amdgcn_mfma_f32_32x32x16_bf16(kf[2],qr[1],C0,0,0,0),   P0[10],P0[11],P0[12],P0[13], pw1[0]=PKW(P0,8), pw1[1]=PKW(P0,10), pw1); \
    VRD(5); SBAR(); GAPA(C1=__builtin_amdgcn_mfma_f32_32x32x16_bf16(kf[3],qr[1],C1,0,0,0),   P0[14],P0[15],P1[0],P1[1],   pw1[2]=PKW(P0,12),pw1[3]=PKW(P0,14), pw1); \
    VRD(2); SBAR(); GAPA(C0=__builtin_amdgcn_mfma_f32_32x32x16_bf16(kf[4],qr[2],C0,0,0,0),   P1[2],P1[3],P1[4],P1[5],     pw2[0]=PKW(P1,0), pw2[1]=PKW(P1,2), pw2); \
    VRD(6); SBAR(); GAPA(C1=__builtin_amdgcn_mfma_f32_32x32x16_bf16(kf[5],qr[2],C1,0,0,0),   P1[6],P1[7],P1[8],P1[9],     pw2[2]=PKW(P1,4), pw2[3]=PKW(P1,6), pw2); \
    VRD(3); SBAR(); GAPA(C0=__builtin_amdgcn_mfma_f32_32x32x16_bf16(kf[6],qr[3],C0,0,0,0),   P1[10],P1[11],P1[12],P1[13], pw3[0]=PKW(P1,8), pw3[1]=PKW(P1,10), pw3); \
    VRD(7); SBAR(); GAPA(C1=__builtin_amdgcn_mfma_f32_32x32x16_bf16(kf[7],qr[3],C1,0,0,0),   P1[14],P1[15],0.f,0.f,       pw3[2]=PKW(P1,12),pw3[3]=PKW(P1,14), pw3); \
    l_reg+=sacc; \
    if(GK){DMA_K((t)+3,sl_cur);} if(GV){DMA_V((t)+1,sl_next);} \
    CMASK(C0,C1,t); \
    { float a=MX3(C0[0],C0[1],C1[0]),b=MX3(C0[2],C0[3],C1[1]); a=MX3(a,C1[2],C1[3]); \
      _Pragma("unroll") for(int r=4;r<16;r+=4){a=MX3(a,C0[r],C0[r+1]);b=MX3(b,C0[r+2],C0[r+3]);a=MX3(a,C1[r],C1[r+1]);b=MX3(b,C1[r+2],C1[r+3]);} \
      float rm=__builtin_fmaxf(a,b); { auto rr=__builtin_amdgcn_permlane32_swap(__float_as_uint(rm),__float_as_uint(rm),false,false); rm=__builtin_fmaxf(__uint_as_float(rr[0]),__uint_as_float(rr[1])); } \
      resc=false; \
      if(__builtin_expect(__any(rm>(float)THRL),0)){ const float dl=__builtin_fmaxf(rm,0.f); mhat+=dl; \
        _Pragma("unroll") for(int r=0;r<16;++r){C0[r]-=dl;C1[r]-=dl;} \
        if(MODE==0){ _Pragma("unroll") for(int r=0;r<16;++r)negm[r]=-mhat; asm volatile("":"+v"(negm)); } \
        const float f=__builtin_amdgcn_exp2f(-dl); l_reg*=f; if(hi==0)wsf[r32]=f; resc=true; } } \
    SBAR(); \
    GAPB(o[0]=__builtin_amdgcn_mfma_f32_32x32x16_bf16(PAF(0),VFR(0),o[0],0,0,0), C0,0); \
    GAPB(o[1]=__builtin_amdgcn_mfma_f32_32x32x16_bf16(PAF(0),VFR(4),o[1],0,0,0), C0,4); \
    KRD(GL,0); GAPB(o[0]=__builtin_amdgcn_mfma_f32_32x32x16_bf16(PAF(1),VFR(1),o[0],0,0,0), C0,8); \
    KRD(GL,1); GAPB(o[1]=__builtin_amdgcn_mfma_f32_32x32x16_bf16(PAF(1),VFR(5),o[1],0,0,0), C0,12); \
    KRD(GL,2); GAPB(o[0]=__builtin_amdgcn_mfma_f32_32x32x16_bf16(PAF(2),VFR(2),o[0],0,0,0), C1,0); \
    KRD(GL,3); GAPB(o[1]=__builtin_amdgcn_mfma_f32_32x32x16_bf16(PAF(2),VFR(6),o[1],0,0,0), C1,4); \
    GAPB(o[0]=__builtin_amdgcn_mfma_f32_32x32x16_bf16(PAF(3),VFR(3),o[0],0,0,0), C1,8); \
    GAPB(o[1]=__builtin_amdgcn_mfma_f32_32x32x16_bf16(PAF(3),VFR(7),o[1],0,0,0), C1,12); \
    }while(0)
  int t=1;
  for(;t+5<NT;t+=2){
    STEP(pB0,pB1,pA0,pA1,t,true,true,true);     WAIT_BAR(2); RESC(); ROT();
    STEP(pA0,pA1,pB0,pB1,t+1,true,true,true);   WAIT_BAR(2); RESC(); ROT();
  }
  #define ENDW(tt) do{ if((tt)+3<NT){WAIT_BAR(2);} else if((tt)+2<NT){WAIT_BAR(1);} else {WAIT_BAR(0);} }while(0)
  for(;t+1<NT;t+=2){
    STEP(pB0,pB1,pA0,pA1,t,(t+3<NT),(t+1<NT),(t+1<NT));       ENDW(t);   RESC(); ROT();
    STEP(pA0,pA1,pB0,pB1,t+1,(t+4<NT),(t+2<NT),(t+2<NT));     ENDW(t+1); RESC(); ROT();
  }
  if(nKh){
    const bf16*nks=nKh+(long)lane*DM+wid*8;
    glds16(nks,(unsigned)__builtin_amdgcn_readfirstlane(kdst)); glds16(nks+(long)KVBLK*DM,(unsigned)__builtin_amdgcn_readfirstlane(kdst+SLOTB)); glds16(nks+(long)2*KVBLK*DM,(unsigned)__builtin_amdgcn_readfirstlane(kdst+2*SLOTB));
  }
  STEP(pB0,pB1,pA0,pA1,NT-1,false,false,false); RESC();
  if(nKh){ const bf16*nQt=nQ0+(long)(wid*QBLK+r32)*DM+hi*32;
    glds4(nQt,(unsigned)__builtin_amdgcn_readfirstlane(lds0+LDS_OST+NW*2048+wid*256));
    if(wid<2) glds4(nVh+(long)(wid*64+lane)*DM,(unsigned)__builtin_amdgcn_readfirstlane(lds0+LDS_OST+NW*2048+NW*256+wid*256)); }
  { float sacc=pB0[0]+pB0[1]; _Pragma("unroll") for(int r=2;r<16;++r)sacc+=pB0[r]; _Pragma("unroll") for(int r=0;r<16;++r)sacc+=pB1[r]; l_reg+=sacc;
    pw0=(u32x4){PKW(pB0,0),PKW(pB0,2),PKW(pB0,4),PKW(pB0,6)};pw1=(u32x4){PKW(pB0,8),PKW(pB0,10),PKW(pB0,12),PKW(pB0,14)};pw2=(u32x4){PKW(pB1,0),PKW(pB1,2),PKW(pB1,4),PKW(pB1,6)};pw3=(u32x4){PKW(pB1,8),PKW(pB1,10),PKW(pB1,12),PKW(pB1,14)};
    SBAR(); pv(o,vb0+sl_cur,PAF(0),PAF(1),PAF(2),PAF(3)); }
  #undef PKW
  #undef PAF
  #undef VFR
  #undef PIN
  #undef MX3
  #undef GAPA
  #undef GAPB
  #undef EX
  #undef VRD
  #undef KRD
  #undef STEP
  #undef ENDW
  {auto rr=__builtin_amdgcn_permlane32_swap(__float_as_uint(l_reg),__float_as_uint(l_reg),false,false);l_reg=__uint_as_float(rr[0])+__uint_as_float(rr[1]);}
  if(hi==0)wsf[32+r32]=l_reg;asm volatile("s_waitcnt lgkmcnt(0)":::"memory");
  float rli[16];
  #pragma unroll
  for(int r=0;r<16;++r)rli[r]=__builtin_amdgcn_rcpf(wsf[32+crow(r,hi)]);
  unsigned char*Ow=O0+(long)wid*QBLK*ATTN_OPITCH;
  { unsigned char*stg=(unsigned char*)(shm+LDS_OST)+wid*2048;
    #pragma unroll
    for(int r=0;r<16;++r){const int orow=crow(r,hi); const float sc=rli[r]*ATTN_OSCALE;
      const unsigned w=(unsigned)__builtin_amdgcn_cvt_pk_fp8_f32(__builtin_amdgcn_fmed3f(o[0][r]*sc,-448.f,448.f),__builtin_amdgcn_fmed3f(o[1][r]*sc,-448.f,448.f),0,false);
      stg[orow*64+r32]=(unsigned char)w; stg[orow*64+32+r32]=(unsigned char)(w>>8);}
    asm volatile("s_waitcnt lgkmcnt(0)":::"memory");
    #pragma unroll
    for(int i=0;i<2;++i){const int row=i*16+(lane>>2),ch=lane&3; const u32x4 v=*(const u32x4*)(stg+row*64+ch*16); ATTN_STORE16(Ow+(long)row*ATTN_OPITCH+ch*16,v);} }
  asm volatile("s_waitcnt lgkmcnt(0)\n\ts_barrier":::"memory");
  #undef TILE
  #undef DMA_K
  #undef DMA_V
  #undef CMASK
  #undef NEGMC
  #undef START
  #undef RESC
  #undef ROT
}
constexpr int ATTN_LDS_BYTES=LDS_BYTES+NATAB_BYTES;
#undef SBAR
#undef WAIT_BAR
}
#define GAS __attribute__((address_space(1)))
#define LAS __attribute__((address_space(3)))
typedef unsigned short bf16;
typedef unsigned v4u __attribute__((ext_vector_type(4)));
typedef float f32x4 __attribute__((ext_vector_type(4)));
typedef short bf16x8 __attribute__((ext_vector_type(8)));
typedef GAS unsigned gu32;
typedef GAS unsigned long long gu64;
#define RLX_AGENT __ATOMIC_RELAXED, __HIP_MEMORY_SCOPE_AGENT
#define LDS_WAIT() asm volatile("s_waitcnt lgkmcnt(0)" ::: "memory")
#define VM_WAIT() asm volatile("s_waitcnt vmcnt(0)" ::: "memory")
__device__ __forceinline__ unsigned long long rt() { return __builtin_amdgcn_s_memrealtime(); }
__device__ __forceinline__ unsigned f2bf(float f) { unsigned u = __builtin_bit_cast(unsigned, f); return (u + 0x7fffu + ((u >> 16) & 1u)) >> 16; }
typedef float f32x2_pk __attribute__((ext_vector_type(2))); typedef __bf16 bf16x2_pk __attribute__((ext_vector_type(2)));
__device__ __forceinline__ unsigned pk2(float lo, float hi) { const f32x2_pk v = {lo, hi}; return __builtin_bit_cast(unsigned, __builtin_convertvector(v, bf16x2_pk)); }

#define XB_TMO      128
#define XB_XCNT(j)  (256  + 64 * (j))
#define XB_XSUB(j)  (1280 + 64 * (j))
#define XB_XGEN(j)  (2304 + 64 * (j))
#define XB_TOP      3328
#define XB_TOPGEN   3392
#define XCD_BAR_WORDS 3456
#define XB_SPIN_CAP (1u << 18)

__device__ __forceinline__ unsigned xb_ld(unsigned* p)              { return __hip_atomic_load(p, __ATOMIC_RELAXED, __HIP_MEMORY_SCOPE_AGENT); }
__device__ __forceinline__ unsigned xb_add(unsigned* p, unsigned v) { return __hip_atomic_fetch_add(p, v, __ATOMIC_RELAXED, __HIP_MEMORY_SCOPE_AGENT); }
__device__ __forceinline__ unsigned xb_xcc_id() { return (unsigned)__builtin_amdgcn_s_getreg((3 << 11) | 20) & 0xFu; }
#define XB_SPIN(cond, bar) do { unsigned _sp = 0; while (cond) { __builtin_amdgcn_s_sleep(1); \
    if ((++_sp & 255u) == 0u) { if (xb_ld(&(bar)[XB_TMO])) break; if (_sp > XB_SPIN_CAP) { atomicAdd(&(bar)[XB_TMO], 1u); break; } } } } while (0)

struct XcdBarrier {
    unsigned* bar; unsigned x;
    volatile LAS unsigned* st;
};

__device__ __forceinline__ XcdBarrier xcd_barrier_post(unsigned* bar, volatile LAS unsigned* st) {
    XcdBarrier b; b.bar = bar; b.x = xb_xcc_id(); b.st = st;
    if (threadIdx.x == 0) (void)xb_add(&bar[XB_XCNT(b.x)], 1u);
    return b;
}
__device__ __forceinline__ void xcd_barrier_complete(unsigned* bar, unsigned x, unsigned& nloc, unsigned& nx) {
    const unsigned G = gridDim.x * gridDim.y * gridDim.z;
    unsigned sum, cnt, mine, sp = 0u;
    for (;;) {
        sum = 0u; cnt = 0u; mine = 0u;
#pragma unroll
        for (unsigned j = 0; j < 16; ++j) { const unsigned c = xb_ld(&bar[XB_XCNT(j)]); sum += c; cnt += (c > 0u) ? 1u : 0u; mine = (j == x) ? c : mine; }
        if (sum == G) break;
        __builtin_amdgcn_s_sleep(1);
        if ((++sp & 255u) == 0u) { if (xb_ld(&bar[XB_TMO])) break; if (sp > XB_SPIN_CAP) { atomicAdd(&bar[XB_TMO], 1u); break; } }
    }
    nloc = mine > 0u ? mine : 1u; nx = cnt > 0u ? cnt : 1u;
}

__device__ __forceinline__ void xcd_barrier(const XcdBarrier& b) {
    asm volatile("s_waitcnt vmcnt(0)" ::: "memory");
    __syncthreads();
    if (threadIdx.x == 0) {
        unsigned* bar = b.bar;
        __builtin_amdgcn_s_waitcnt(0);
        unsigned nloc = b.st[0], nx = b.st[1];
        if (nloc == 0u) { xcd_barrier_complete(bar, b.x, nloc, nx); b.st[0] = nloc; b.st[1] = nx; }
        const unsigned old = xb_add(&bar[XB_XSUB(b.x)], 1u);
        const unsigned gen = old / nloc;
        if (old + 1u == (gen + 1u) * nloc) {
            __builtin_amdgcn_fence(__ATOMIC_RELEASE, "agent");
            asm volatile("s_waitcnt vmcnt(0)" ::: "memory");
            const unsigned og = xb_add(&bar[XB_TOP], 1u);
            const unsigned tg = og / nx;
            if (og + 1u == (tg + 1u) * nx) xb_add(&bar[XB_TOPGEN], 1u);
            else XB_SPIN(xb_ld(&bar[XB_TOPGEN]) == tg, bar);
            __builtin_amdgcn_fence(__ATOMIC_ACQUIRE, "agent");
            xb_add(&bar[XB_XGEN(b.x)], 1u);
            asm volatile("s_waitcnt vmcnt(0)" ::: "memory");
        } else {
            XB_SPIN(xb_ld(&bar[XB_XGEN(b.x)]) == gen, bar);
            __builtin_amdgcn_fence(__ATOMIC_ACQUIRE, "agent");
            asm volatile("s_waitcnt vmcnt(0)" ::: "memory");
        }
    }
    __syncthreads();
}
constexpr int DMODEL = 1024, NB = 32, SEQ = 2048, CTXL = 256, SB = SEQ + CTXL  , DEPTH = 2, NE = 16;
#ifndef MK_NCHUNK
#define MK_NCHUNK 2
#endif
constexpr int NCHUNK = MK_NCHUNK, BC = NB / NCHUNK, MC = BC * SB;
constexpr int PW = 4352, NPROJ = 7424, GW = NPROJ - PW;
constexpr int C_LX = 0, C_LG = 1024, C_NQ = 2048, C_GQ = 2560, C_NK = 3072, C_NV = 3584, C_GK = 4096, C_GV = 4224;
constexpr float EPS = 1e-6f;
constexpr float QSCALE = 0.125f * 1.4426950408889634f;
constexpr int NMOD = 6 * DMODEL;

enum { I_X = 0, I_C, I_CTX, I_CCTX, I_WMOD, I_BMOD, I_NORMG, I_WIN, I_CONVW, I_CONVB, I_LWA, I_LBA, I_LWX, I_LBX, I_LLAM, I_RPB, I_QNG, I_KNG, I_WOA, I_WOB, I_WOC, I_WOUT, I_WR, I_WG, I_WU, I_WD, N_IN };

struct Args { const float* in[N_IN]; float* out; unsigned char* ws; int ph_lo, ph_hi; };
constexpr size_t MiB = 1u << 20;
constexpr size_t WS_CTL = 0, CTL_ZERO_BYTES = 3 * MiB;
constexpr size_t CTL_MOD_OFF = 1 * MiB;
constexpr int CW_TMO = 0, CW_BAR = 4096;
constexpr size_t WS_W = 4 * MiB, LW = 64 * MiB;
constexpr size_t W_P = 0, W_O = 8 * MiB, W_OUT = 12 * MiB, W_LRU = 14 * MiB, W_GU = 16 * MiB, W_D = 48 * MiB;
constexpr size_t WS_XR = 132 * MiB;
constexpr size_t WS_H = 276 * MiB;
constexpr size_t WS_HT = 348 * MiB;
constexpr size_t WS_AFFEN = 420 * MiB, WS_AFFNE = 423 * MiB, WS_SLOT = 426 * MiB;
constexpr size_t WS_ROWIDX = WS_SLOT + 3 * MiB;
static_assert((size_t)MC * NE * 4 <= 3 * MiB && WS_ROWIDX + (size_t)(NE * BC * 288) * 4 <= 430 * MiB, "slot / row-list map");
constexpr size_t WS_P = 430 * MiB;
constexpr size_t WS_O1 = WS_P, WS_HS = WS_P + 72 * MiB, WS_ACT = WS_P + 216 * MiB;
constexpr size_t WS_G8 = WS_P + (size_t)MC * PW * 2;
constexpr size_t WS_M8 = WS_G8 + (size_t)MC * GW;
constexpr float M8_SA = 4.f, M8_SB = 32.f, MQ_S = 16.f;
constexpr size_t WS_END = WS_M8 + (size_t)MC * 2048;
static_assert(NCHUNK == 2, "the workspace map below is laid out for two chunks");
static_assert(WS_END <= 1024 * MiB && (size_t)MC * 1024 * 2 <= 72 * MiB && WS_ACT + 72 * MiB <= WS_G8 && WS_HS + 144 * MiB <= WS_ACT, "d_ws map");
static_assert(CTL_MOD_OFF + (size_t)DEPTH * 33 * NMOD * 4 <= CTL_ZERO_BYTES, "mod accumulators inside the memset region");

constexpr int RING_BYTES = 131072, LDSCTL_OFF = 135168  , MISC_OFF = LDSCTL_OFF + 320, LDS_BYTES = 147456;
static_assert(8 * 16640 <= LDSCTL_OFF && MISC_OFF + 128 <= LDS_BYTES, "LDS map");

__device__ __forceinline__ float bf2f(unsigned v) { return __uint_as_float(v << 16); }
__device__ __forceinline__ float shfl_idx(float v, int src) { return __builtin_bit_cast(float, __builtin_amdgcn_ds_bpermute(src << 2, __builtin_bit_cast(int, v))); }
__device__ __forceinline__ float shx(float v, int m, int lane) { return shfl_idx(v, lane ^ m); }
#define DPPF(v, CTRL) __builtin_bit_cast(float, __builtin_amdgcn_update_dpp(0, __builtin_bit_cast(int, (v)), (CTRL), 0xf, 0xf, false))
__device__ __forceinline__ float sum16(float v) {
    v += DPPF(v, 0xB1); v += DPPF(v, 0x4E); v += DPPF(v, 0x141); v += DPPF(v, 0x140); return v; }
__device__ __forceinline__ float swap16_sum(float v) { const auto r = __builtin_amdgcn_permlane16_swap(__float_as_uint(v), __float_as_uint(v), false, false); return __uint_as_float(r[0]) + __uint_as_float(r[1]); }
__device__ __forceinline__ float swap32_sum(float v) { const auto r = __builtin_amdgcn_permlane32_swap(__float_as_uint(v), __float_as_uint(v), false, false); return __uint_as_float(r[0]) + __uint_as_float(r[1]); }
__device__ __forceinline__ float swap16_get(float v, int lane) { const auto r = __builtin_amdgcn_permlane16_swap(__float_as_uint(v), __float_as_uint(v), false, false); return __uint_as_float((lane & 16) ? r[0] : r[1]); }
__device__ __forceinline__ float swap32_get(float v, int lane) { const auto r = __builtin_amdgcn_permlane32_swap(__float_as_uint(v), __float_as_uint(v), false, false); return __uint_as_float((lane & 32) ? r[0] : r[1]); }
__device__ __forceinline__ float wave_sum(float v, int lane) { (void)lane; return swap32_sum(swap16_sum(sum16(v))); }
__device__ __forceinline__ float half_sum(float v) { return swap16_sum(sum16(v)); }
#define PH_IDS int tid_ = threadIdx.x; asm volatile("" : "+v"(tid_)); const int tid = tid_, lane = tid & 63, wid = __builtin_amdgcn_readfirstlane(tid >> 6); \
    int vcu_ = F.vcu; asm volatile("" : "+s"(vcu_)); const int vcu = vcu_; (void)vcu; (void)wid; (void)lane;
__device__ __forceinline__ float fast_rcp(float x) { return __builtin_amdgcn_rcpf(x); }
__device__ __forceinline__ float sigmoidf_(float x) { return fast_rcp(1.f + __expf(-x)); }

struct Frame {
    LAS unsigned char* lds;
    int vcu, G;
    float* out; unsigned char* ws;
};

__device__ __forceinline__ void tr_item(const float* W, int ldw, bf16* WT, int ldt, int k0, int n0, int drow0, int dk0, float scale, LAS float* scr, int lane) {
    float t_[32];
#pragma unroll
    for (int i = 0; i < 32; ++i) { const int kk = 2 * i + (lane >> 5); t_[i] = W[(size_t)(k0 + kk) * ldw + n0 + (lane & 31)]; }
#pragma unroll
    for (int i = 0; i < 32; ++i) { const int kk = 2 * i + (lane >> 5); scr[kk * 33 + (lane & 31)] = t_[i] * scale; }
    LDS_WAIT(); asm volatile("" ::: "memory");
    const int c = lane & 7;
#pragma unroll
    for (int j = 0; j < 4; ++j) { const int n = (lane >> 3) + 8 * j; const LAS float* s = scr + (8 * c) * 33 + n;
        v4u o; o.x = pk2(s[0 * 33], s[1 * 33]); o.y = pk2(s[2 * 33], s[3 * 33]); o.z = pk2(s[4 * 33], s[5 * 33]); o.w = pk2(s[6 * 33], s[7 * 33]);
        *(GAS v4u*)(WT + (size_t)(drow0 + n) * ldt + dk0 + 8 * c) = o; }
    LDS_WAIT(); asm volatile("" ::: "memory");
}

__device__ __forceinline__ unsigned pk4_fp8(float a, float b, float c, float d) { int w = __builtin_amdgcn_cvt_pk_fp8_f32(a, b, 0, false); w = __builtin_amdgcn_cvt_pk_fp8_f32(c, d, w, true); return (unsigned)w; }
__device__ __forceinline__ void tr_item_fp8(const float* W, int ldw, unsigned char* WT, int ldt, int k0, int n0, int drow0, int dk0, float scale, LAS float* scr, int lane) {
    f32x4 t_[16];
#pragma unroll
    for (int i = 0; i < 16; ++i) t_[i] = __builtin_nontemporal_load((const f32x4*)(W + (size_t)(k0 + 4 * i + (lane >> 4)) * ldw + n0 + 4 * (lane & 15)));
#pragma unroll
    for (int i = 0; i < 16; ++i) { LAS float* d = scr + (4 * i + (lane >> 4)) * 65 + 4 * (lane & 15); d[0] = t_[i].x * scale; d[1] = t_[i].y * scale; d[2] = t_[i].z * scale; d[3] = t_[i].w * scale; }
    LDS_WAIT(); asm volatile("" ::: "memory");
    const LAS float* s = scr + lane;
    GAS v4u* dst = (GAS v4u*)(WT + (size_t)(drow0 + lane) * ldt + dk0);
#pragma unroll
    for (int q4 = 0; q4 < 4; ++q4) { unsigned o[4];
#pragma unroll
        for (int q = 0; q < 4; ++q) { const int k = 16 * q4 + 4 * q; o[q] = pk4_fp8(s[k * 65], s[(k + 1) * 65], s[(k + 2) * 65], s[(k + 3) * 65]); }
        dst[q4] = (v4u){o[0], o[1], o[2], o[3]}; }
    LDS_WAIT(); asm volatile("" ::: "memory");
}

constexpr int IT_WIN = 16 * 116, IT_WOA = 256, IT_WOB = 128, IT_WOC = 128, IT_WOUT = 256, IT_LRU = 256, IT_GU = 16 * 512, IT_D = 16 * 256;
constexpr int IT_LAYER = IT_WIN + IT_WOA + IT_WOB + IT_WOC + IT_WOUT + IT_LRU + IT_GU + IT_D;
__device__ __forceinline__ void ph_prologue(const Args& A_, Frame& F) {
    PH_IDS
    float* mod = (float*)(F.ws + CTL_MOD_OFF);
    const int q0 = vcu + F.G * wid, NADA = DEPTH * 96 * 3, nconv = F.G * 8 - NADA; const bool split = nconv >= F.G * 4;
    for (int q = q0; q < NADA; q += F.G * 8) {
        const int l = q / 288, rem = q % 288, g = rem / 3, r0 = (rem % 3) * 11;
        const float* W = A_.in[I_WMOD] + (size_t)l * DMODEL * NMOD + g * 64 + lane;
        float acc[11];
#pragma unroll
        for (int i = 0; i < 11; ++i) acc[i] = 0.f;
        float wA[32], wB[32], cn[11];
#define ADA_LOADW(dst, kb_, h_) do { const float* Wk_ = W + (size_t)((kb_) * 64 + 32 * (h_)) * NMOD; _Pragma("unroll") for (int kk = 0; kk < 32; ++kk) dst[kk] = Wk_[(size_t)kk * NMOD]; } while (0)
#define ADA_LOADC(kb_) do { _Pragma("unroll") for (int i = 0; i < 11; ++i) { const int r = r0 + i; cn[i] = (r < 32) ? A_.in[I_C][r * DMODEL + (kb_) * 64 + lane] : A_.in[I_CCTX][(kb_) * 64 + lane]; } } while (0)
#define ADA_FMA(src, h_) do { _Pragma("unroll") for (int kk = 0; kk < 32; ++kk) _Pragma("unroll") for (int i = 0; i < 11; ++i) \
            acc[i] += __builtin_bit_cast(float, __builtin_amdgcn_readlane(__builtin_bit_cast(int, sv[i]), 32 * (h_) + kk)) * src[kk]; } while (0)
        ADA_LOADC(0); ADA_LOADW(wA, 0, 0);
        for (int kb = 0; kb < 16; ++kb) {
            float sv[11];
#pragma unroll
            for (int i = 0; i < 11; ++i) sv[i] = cn[i] * sigmoidf_(cn[i]);
            if (kb + 1 < 16) ADA_LOADC(kb + 1);
            ADA_LOADW(wB, kb, 1);
            ADA_FMA(wA, 0);
            if (kb + 1 < 16) ADA_LOADW(wA, kb + 1, 0);
            ADA_FMA(wB, 1);
        }
#undef ADA_LOADW
#undef ADA_LOADC
#undef ADA_FMA
        const float bm = A_.in[I_BMOD][l * NMOD + g * 64 + lane];
        const int seg = (g * 64) >> 10, cc = ((g * 64) & 1023) + lane;
        const float ngv = (seg == 1) ? A_.in[I_NORMG][(l * 4 + 0) * DMODEL + cc] : (seg == 2) ? A_.in[I_NORMG][(l * 4 + 1) * DMODEL + cc] : (seg == 4) ? A_.in[I_NORMG][(l * 4 + 2) * DMODEL + cc] : (seg == 5) ? A_.in[I_NORMG][(l * 4 + 3) * DMODEL + cc] : 1.f;
        const float one = (seg == 1 || seg == 4) ? 1.f : 0.f;
#pragma unroll
        for (int i = 0; i < 11; ++i) mod[(size_t)(l * 33 + r0 + i) * NMOD + g * 64 + lane] = (acc[i] + bm + one) * ngv;
    }
    LAS float* scr = (LAS float*)(F.lds + wid * 16640);
    const int gw = split ? q0 - NADA : vcu * 8 + wid, NGW = split ? nconv : F.G * 8;
    for (int it = (gw >= 0 ? gw : DEPTH * IT_LAYER); it < DEPTH * IT_LAYER; it += NGW) {
        const int l = it / IT_LAYER; int r = it - l * IT_LAYER;
        unsigned char* wl = F.ws + WS_W + (size_t)l * LW;
        if (r < IT_WIN) { const int k0 = 64 * (r / 116), n0 = 64 * (r % 116);
            const int dr = (n0 < 2560) ? n0 : (n0 < 3584) ? n0 + 512 : (n0 < 4096) ? n0 - 1024 : n0;
            const float sc = (n0 >= 2048 && n0 < 2560) ? QSCALE : 1.f;
            tr_item_fp8(A_.in[I_WIN] + (size_t)l * DMODEL * NPROJ, NPROJ, wl + W_P, 1024, k0, n0, dr, k0, sc * 64.f, scr, lane); continue; } r -= IT_WIN;
        if (r < IT_WOA) { const int k0 = 64 * (r / 16), n0 = 64 * (r % 16); tr_item_fp8(A_.in[I_WOA] + (size_t)l * 1024 * 1024, 1024, wl + W_O, 2048, k0, n0, n0, k0, 64.f, scr, lane); continue; } r -= IT_WOA;
        if (r < IT_WOB) { const int k0 = 64 * (r / 16), n0 = 64 * (r % 16); tr_item_fp8(A_.in[I_WOB] + (size_t)l * 512 * 1024, 1024, wl + W_O, 2048, k0, n0, n0, 1024 + k0, 64.f, scr, lane); continue; } r -= IT_WOB;
        if (r < IT_WOC) { const int k0 = 64 * (r / 16), n0 = 64 * (r % 16); tr_item_fp8(A_.in[I_WOC] + (size_t)l * 512 * 1024, 1024, wl + W_O, 2048, k0, n0, n0, 1536 + k0, 64.f, scr, lane); continue; } r -= IT_WOC;
        if (r < IT_WOUT) { const int k0 = 64 * (r / 16), n0 = 64 * (r % 16); tr_item_fp8(A_.in[I_WOUT] + (size_t)l * 1024 * 1024, 1024, wl + W_OUT, 1024, k0, n0, n0, k0, 64.f, scr, lane); continue; } r -= IT_WOUT;
        if (r < IT_LRU) { const int mi = r >> 3, sub = r & 7, dir = mi >> 4, mat = (mi >> 3) & 1, blk = mi & 7, k0 = 64 * (sub >> 2), n0 = 32 * (sub & 3);
            const float* src = (mat ? A_.in[I_LWX] : A_.in[I_LWA]) + (size_t)((l * 2 + dir) * 8 + blk) * 128 * 128;
            tr_item(src, 128, (bf16*)(wl + W_LRU) + (size_t)((dir * 2 + mat) * 8 + blk) * 128 * 128, 128, k0, n0, n0, k0, 1.f, scr, lane); continue; } r -= IT_LRU;
        if (r < IT_GU) { const int e = r >> 9, rr = r & 511, mat = rr >> 8, q = rr & 255, k0 = 64 * (q / 16), n0 = 64 * (q % 16);
            const float* src = (mat ? A_.in[I_WU] : A_.in[I_WG]) + (size_t)(l * NE + e) * 1024 * 1024;
            tr_item_fp8(src, 1024, wl + W_GU + (size_t)e * 2048 * 1024, 1024, k0, n0, (n0 >> 7) * 256 + mat * 128 + (n0 & 127), k0, 64.f, scr, lane); continue; } r -= IT_GU;
        { const int e = r >> 8, q = r & 255, k0 = 64 * (q / 16), n0 = 64 * (q % 16);
            tr_item_fp8(A_.in[I_WD] + (size_t)(l * NE + e) * 1024 * 1024, 1024, wl + W_D + (size_t)e * 1024 * 1024, 1024, k0, n0, n0, k0, 64.f, scr, lane); }
    }
}

__device__ __forceinline__ void row_load(const float* p, int lane, f32x4 (&v)[4]) {
#pragma unroll
    for (int j = 0; j < 4; ++j) v[j] = ((const f32x4*)p)[lane + 64 * j];
}
__device__ __forceinline__ float row_rstd(const f32x4 (&v)[4], int lane) {
    float s = 0.f;
#pragma unroll
    for (int j = 0; j < 4; ++j) s += (v[j].x * v[j].x + v[j].y * v[j].y) + (v[j].z * v[j].z + v[j].w * v[j].w);
    return rsqrtf(wave_sum(s, lane) * (1.f / DMODEL) + EPS);
}
__device__ __forceinline__ void row_store_bf16(bf16* p, int lane, const f32x4 (&v)[4]) {
#pragma unroll
    for (int j = 0; j < 4; ++j) __builtin_nontemporal_store((unsigned long long)pk2(v[j].x, v[j].y) | ((unsigned long long)pk2(v[j].z, v[j].w) << 32), (unsigned long long*)p + lane + 64 * j);
}
__device__ __forceinline__ void row_store_fp8(unsigned char* p, int lane, const f32x4 (&v)[4]) {
#pragma unroll
    for (int j = 0; j < 4; ++j) ((unsigned*)p)[lane + 64 * j] = pk4_fp8(v[j].x, v[j].y, v[j].z, v[j].w);
}
__device__ __forceinline__ void row_load_bf16(const bf16* p, int lane, f32x4 (&v)[4]) {
#pragma unroll
    for (int j = 0; j < 4; ++j) { const unsigned long long w = ((const unsigned long long*)p)[lane + 64 * j];
        v[j].x = bf2f((unsigned)w & 0xffffu); v[j].y = bf2f(((unsigned)w >> 16)); v[j].z = bf2f((unsigned)(w >> 32) & 0xffffu); v[j].w = bf2f((unsigned)(w >> 48)); }
}
__device__ __forceinline__ const float* res_in(const Args& A_, int b, int s) {
    if (s < CTXL) return A_.in[I_CTX] + ((size_t)b * CTXL + s) * DMODEL;
    return A_.in[I_X] + ((size_t)b * SEQ + (s - CTXL)) * DMODEL;
}
__device__ __forceinline__ bf16* res_xr(const Frame& F, int b, int s) { return (bf16*)(F.ws + WS_XR) + ((size_t)b * SB + s) * DMODEL; }
__device__ __forceinline__ const float* mod_row(const Args& A_, const Frame& F, int l, int b, int s) { return (const float*)(F.ws + CTL_MOD_OFF) + (size_t)(l * 33 + (s < CTXL ? 32 : b)) * NMOD; }

__device__ __forceinline__ void ph_norm1(const Args& A_, Frame& F, int l, int ch) {
    PH_IDS
    const int gw = vcu * 8 + wid, NGW = F.G * 8;
    bf16* H = (bf16*)(F.ws + WS_H);
    f32x4 vn[4]; unsigned long long vb[4];
    if (gw < MC) { const int bl = gw / SB, s = gw - bl * SB, b = ch * BC + bl;
#pragma unroll
        for (int j = 0; j < 4; ++j) { if (l == 0) vn[j] = __builtin_nontemporal_load((const f32x4*)res_in(A_, b, s) + lane + 64 * j); else vb[j] = ((const unsigned long long*)res_xr(F, b, s))[lane + 64 * j]; } }
    for (int row = gw; row < MC; row += NGW) {
        const int bl = row / SB, s = row - bl * SB, b = ch * BC + bl;
        f32x4 v[4];
#pragma unroll
        for (int j = 0; j < 4; ++j) { if (l == 0) v[j] = vn[j]; else { const unsigned long long w = vb[j]; v[j].x = bf2f((unsigned)w & 0xffffu); v[j].y = bf2f(((unsigned)w >> 16)); v[j].z = bf2f((unsigned)(w >> 32) & 0xffffu); v[j].w = bf2f((unsigned)(w >> 48)); } }
        if (row + NGW < MC) { const int r2 = row + NGW, bl2 = r2 / SB, s2 = r2 - bl2 * SB, b2 = ch * BC + bl2;
#pragma unroll
            for (int j = 0; j < 4; ++j) { if (l == 0) vn[j] = __builtin_nontemporal_load((const f32x4*)res_in(A_, b2, s2) + lane + 64 * j); else vb[j] = ((const unsigned long long*)res_xr(F, b2, s2))[lane + 64 * j]; } }
        const float rstd = row_rstd(v, lane);
        const float* mr = mod_row(A_, F, l, b, s);
#pragma unroll
        for (int j = 0; j < 4; ++j) { const f32x4 sh = ((const f32x4*)mr)[lane + 64 * j], c0 = ((const f32x4*)(mr + DMODEL))[lane + 64 * j];
            v[j] = (v[j] * rstd) * c0 + sh; }
        row_store_fp8((unsigned char*)H + (size_t)row * DMODEL, lane, v);
    }
}

__device__ __forceinline__ void ph_prep(const Args& A_, Frame& F, int l) {
    PH_IDS
    const int gw = vcu * 8 + wid, NGW = F.G * 8;
    bf16* P = (bf16*)(F.ws + WS_P);
    const int l7 = lane & 7, kr = lane >> 4, d0 = (l7 & 3) * 8;
    const float sg = (l7 >= 4) ? 1.f : -1.f;
    float gq[8], gk[8], invf[8];
#pragma unroll
    for (int e = 0; e < 8; ++e) { gq[e] = A_.in[I_QNG][l * 64 + l7 * 8 + e] * QSCALE; gk[e] = A_.in[I_KNG][l * 64 + l7 * 8 + e];
        invf[e] = __builtin_amdgcn_exp2f(-(float)((d0 + e) & 15) * (13.287712379549449f / 16.f)) * 0.15915494309189535f; }
    constexpr int NR = 4;
    const int nrw = (MC - gw + NGW - 1) / NGW, ngr = (nrw + NR - 1) / NR;
    v4u qn[NR], kn;
#define PREP_FETCH(g) do { _Pragma("unroll") for (int r = 0; r < NR; ++r) { const int row_ = gw + ((g) * NR + r) * NGW; qn[r] = __builtin_nontemporal_load((const v4u*)(P + (size_t)(row_ < MC ? row_ : gw) * PW + C_GQ + lane * 8)); } \
        { const int row_ = gw + ((g) * NR + kr) * NGW; kn = __builtin_nontemporal_load((const v4u*)(P + (size_t)(row_ < MC ? row_ : gw) * PW + C_GK + (lane & 15) * 8)); } } while (0)
#define PREP_X4(v) DPPF(DPPF((v), 0x141), 0x1B)
#define PREP_DO(w, g_, lat_, t_, out) do { float x_[8]; _Pragma("unroll") for (int k = 0; k < 4; ++k) { x_[2 * k] = bf2f((w)[k] & 0xffffu); x_[2 * k + 1] = __uint_as_float((w)[k] & 0xffff0000u); } \
        float ss_ = 0.f; _Pragma("unroll") for (int e = 0; e < 8; ++e) ss_ += x_[e] * x_[e]; \
        ss_ += DPPF(ss_, 0xB1); ss_ += DPPF(ss_, 0x4E); ss_ += DPPF(ss_, 0x141); \
        const float rs_ = rsqrtf(ss_ * (1.f / 64.f) + EPS); const float pos_ = (float)((d0 < 16) ? ((t_) >> 6) : ((t_) & 63)); float o_[8]; \
        _Pragma("unroll") for (int e = 0; e < 8; ++e) { const float y_ = x_[e] * rs_ * g_[e]; const float yp_ = PREP_X4(y_); \
            const float fr_ = __builtin_amdgcn_fractf(pos_ * invf[e]); const float cs_ = (lat_) ? __builtin_amdgcn_cosf(fr_) : 1.f, sn_ = (lat_) ? __builtin_amdgcn_sinf(fr_) : 0.f; \
            o_[e] = y_ * cs_ + sg * (yp_ * sn_); } \
        out = (v4u){pk2(o_[0], o_[1]), pk2(o_[2], o_[3]), pk2(o_[4], o_[5]), pk2(o_[6], o_[7])}; } while (0)
    PREP_FETCH(0);
    for (int g = 0; g < ngr; ++g) {
        v4u qc[NR], kc = kn;
#pragma unroll
        for (int r = 0; r < NR; ++r) qc[r] = qn[r];
        if (g + 1 < ngr) PREP_FETCH(g + 1);
#pragma unroll
        for (int r = 0; r < NR; ++r) { const int row = gw + (g * NR + r) * NGW;
            if (row < MC) { const int s = row % SB; const bool lat = s >= CTXL; const int t = s - CTXL; v4u o; PREP_DO(qc[r], gq, lat, t, o);
                *(v4u*)(P + (size_t)row * PW + C_GQ + lane * 8) = o; } }
        { const int row = gw + (g * NR + kr) * NGW; const int rc = row < MC ? row : gw; const int s = rc % SB; const bool lat = s >= CTXL; const int t = s - CTXL; v4u o; PREP_DO(kc, gk, lat, t, o);
            if (row < MC) *(v4u*)(P + (size_t)row * PW + C_GK + (lane & 15) * 8) = o; }
    }
#undef PREP_FETCH
#undef PREP_X4
#undef PREP_DO
}
constexpr int LRU_UP = 136;
constexpr int LRU_UB = 64 * LRU_UP * 2, LRU_OP = 144, LRU_OB = 64 * LRU_OP;
constexpr int LRU_U0 = 0, LRU_O0 = 4 * LRU_UB, LRU_CW = LRU_O0 + 4 * LRU_OB;
static_assert(LRU_CW + 640 * 4 <= RING_BYTES, "LRU LDS map");
__device__ __forceinline__ float gelu_tanh(float g) { const float z = 0.7978845608028654f * (g + 0.044715f * g * g * g); return g * (1.f - fast_rcp(1.f + __expf(2.f * z))); }
__device__ __forceinline__ int lru_chunk(int dir, int s) { return dir == 0 ? s : (s < 4 ? 3 - s : 39 - s); }
__device__ __forceinline__ bool lru_first(int s) { return s < 4 ? (s <= 1) : (s <= 19); }
__device__ __forceinline__ void ph_lru(const Args& A_, Frame& F, int l) {
    PH_IDS
    const int fr = lane & 15, fq = lane >> 4, nt = wid & 3, dir = wid >> 2;
    bf16* P = (bf16*)(F.ws + WS_P); bf16* HT = (bf16*)(F.ws + WS_HT); unsigned char* M8 = F.ws + WS_M8;
    const bf16* WL = (const bf16*)(F.ws + WS_W + (size_t)l * LW + W_LRU);
    LAS unsigned char* lds = F.lds;
    LAS float* CW = (LAS float*)(lds + LRU_CW);
    for (int item = blockIdx.x; item < BC * 16; item += F.G) {
        const int bl = item >> 4, cb = item & 15, blk = cb >> 1, half = cb & 1;
        const int cdir = tid >> 8, ctg = (tid >> 4) & 15, cgrp = tid & 15, tb = cdir ? 58 - 4 * ctg : 4 * ctg - 2;
        __syncthreads();
        for (int i = tid; i < 640; i += 512) CW[i] = (i < 512) ? A_.in[I_CONVW][(size_t)(l * 4 + (i >> 7)) * 1024 + blk * 128 + (i & 127)] : A_.in[I_CONVB][l * 1024 + blk * 128 + (i - 512)];
        __syncthreads();
        const int otok = (tid >> 3) & 63, og = tid & 7;
        const int chl = half * 64 + nt * 16 + fr, chan = blk * 128 + chl;
        bf16x8 Bf[2][4];
#pragma unroll
        for (int mat = 0; mat < 2; ++mat)
#pragma unroll
            for (int ks = 0; ks < 4; ++ks) Bf[mat][ks] = *(const bf16x8*)(WL + ((size_t)((dir * 2 + mat) * 8 + blk) * 128 + chl) * 128 + ks * 32 + fq * 8);
        const float ba = A_.in[I_LBA][(l * 2 + dir) * 1024 + chan], bx = A_.in[I_LBX][(l * 2 + dir) * 1024 + chan];
        const float nba = -1.4426950408889634f * ba, nbx = -1.4426950408889634f * bx;
        const float lamc = -8.f * log1pf(__expf(-A_.in[I_LLAM][(l * 2 + dir) * 1024 + chan])) * 1.4426950408889634f;
        float hprev = 0.f;
        bf16x8 xr[7]; unsigned xok = 0u;
#define LRU_LOADX(st) do { const int tc_ = lru_chunk(cdir, (st)); const int seg0_ = (tc_ < 4) ? 0 : CTXL, segl_ = (tc_ < 4) ? CTXL : SEQ, tcl_ = (tc_ < 4) ? tc_ : tc_ - 4; \
            const char* xb_ = (const char*)(P + (size_t)(bl * SB + seg0_) * PW + C_LX + blk * 128);     \
            _Pragma("unroll") for (int i_ = 0; i_ < 7; ++i_) { const int st_ = 64 * tcl_ + tb + i_; const bool ok_ = (unsigned)st_ < (unsigned)segl_; \
                xr[i_] = *(const bf16x8*)(xb_ + ((unsigned)(ok_ ? st_ : 0) * (unsigned)PW + 8u * (unsigned)cgrp) * 2u); xok = ok_ ? (xok | (1u << i_)) : (xok & ~(1u << i_)); } } while (0)
#define LRU_CONV(bufi) do { LAS unsigned char* Uw0_ = lds + LRU_U0 + ((bufi) * 2 + cdir) * LRU_UB + (4 * ctg) * (LRU_UP * 2) + cgrp * 16; unsigned pk_[4][4]; \
            _Pragma("unroll") for (int c2_ = 0; c2_ < 4; ++c2_) { typedef float f2_ __attribute__((ext_vector_type(2))); \
                f2_ w_[5]; _Pragma("unroll") for (int k_ = 0; k_ < 5; ++k_) w_[k_] = *(const LAS f2_*)(CW + k_ * 128 + 8 * cgrp + 2 * c2_); \
                f2_ x_[7]; _Pragma("unroll") for (int i_ = 0; i_ < 7; ++i_) { const unsigned wd_ = __builtin_bit_cast(v4u, xr[i_])[c2_] & (0u - ((xok >> i_) & 1u)); x_[i_] = (f2_){bf2f(wd_ & 0xffffu), __uint_as_float(wd_ & 0xffff0000u)}; } \
                if (cdir == 0) { _Pragma("unroll") for (int j_ = 0; j_ < 4; ++j_) { f2_ a_ = w_[4]; \
                    _Pragma("unroll") for (int k_ = 0; k_ < 4; ++k_) a_ += w_[k_] * x_[j_ + k_]; \
                    pk_[j_][c2_] = pk2(a_.x, a_.y); } } \
                else { _Pragma("unroll") for (int j_ = 0; j_ < 4; ++j_) { f2_ a_ = w_[4]; \
                    _Pragma("unroll") for (int k_ = 0; k_ < 4; ++k_) a_ += w_[k_] * x_[3 - j_ + k_]; \
                    pk_[j_][c2_] = pk2(a_.x, a_.y); } } } \
            _Pragma("unroll") for (int j_ = 0; j_ < 4; ++j_) *(LAS v4u*)(Uw0_ + j_ * (LRU_UP * 2)) = (v4u){pk_[j_][0], pk_[j_][1], pk_[j_][2], pk_[j_][3]}; } while (0)
        LRU_LOADX(0); LRU_CONV(0);
        __syncthreads();
        if (dir == 1) __builtin_amdgcn_s_setprio(1);
#ifndef MK_LRU_SEC
#define MK_LRU_SEC 0
#endif
#define LSEC_B(k) if (MK_LRU_SEC == (k)) { lsec_t0 = __builtin_amdgcn_s_memrealtime(); }
#define LSEC_E(k) if (MK_LRU_SEC == (k)) { lsec_acc += __builtin_amdgcn_s_memrealtime() - lsec_t0; }
        unsigned long long lsec_t0 = 0, lsec_acc = 0;
        for (int s = 0; s <= 36; ++s) {
            const int buf = s & 1;
            LSEC_B(1)
            v4u ohf[2], ogt[2]; const bool ofirst = (s >= 1) ? lru_first(s - 1) : true;
            unsigned orow[2];
#pragma unroll
            for (int i = 0; i < 2; ++i) orow[i] = (unsigned)(bl * SB + 64 * lru_chunk(i, s >= 1 ? s - 1 : 0) + otok);
#define LRU_LOADO() do { if (s >= 1 && !ofirst) { _Pragma("unroll") for (int i = 0; i < 2; ++i) { \
                ohf[i] = __builtin_nontemporal_load((const v4u*)((const char*)HT + (orow[i] * (unsigned)DMODEL + (unsigned)(blk * 128 + half * 64 + og * 8)) * 2u)); \
                ogt[i] = __builtin_nontemporal_load((const v4u*)((const char*)P + (orow[i] * (unsigned)PW + (unsigned)(C_LG + blk * 128 + half * 64 + og * 8)) * 2u)); } } } while (0)
            if (s >= 36) LRU_LOADO();
            if (s + 1 < 36) LRU_LOADX(s + 1);
            LSEC_E(1) LSEC_B(2)
            if (s < 36) {
                const LAS unsigned char* U = lds + LRU_U0 + (buf * 2 + dir) * LRU_UB;
                LAS unsigned char* O = lds + LRU_O0 + (buf * 2 + dir) * LRU_OB;
                float Pa[4][4], Pb[4][4];
#pragma unroll
                for (int m = 0; m < 4; ++m) {
                    f32x4 acc0 = (f32x4){0.f, 0.f, 0.f, 0.f}, acc1 = (f32x4){0.f, 0.f, 0.f, 0.f};
#pragma unroll
                    for (int ks = 0; ks < 4; ++ks) { const bf16x8 Af = *(const LAS bf16x8*)(U + (16 * m + fr) * (LRU_UP * 2) + (ks * 32 + fq * 8) * 2);
                        acc0 = __builtin_amdgcn_mfma_f32_16x16x32_bf16(Af, Bf[0][ks], acc0, 0, 0, 0);
                        acc1 = __builtin_amdgcn_mfma_f32_16x16x32_bf16(Af, Bf[1][ks], acc1, 0, 0, 0); }
                    float A = 1.f, Bv = 0.f;
#pragma unroll
                    for (int j = 0; j < 4; ++j) { const int rho = 16 * m + 4 * fq + j;
                        const float u = bf2f(*(const LAS unsigned short*)(U + rho * (LRU_UP * 2) + chl * 2));
                        const float r = fast_rcp(1.f + __builtin_amdgcn_exp2f(__builtin_fmaf(acc0[j], -1.4426950408889634f, nba))), ig = fast_rcp(1.f + __builtin_amdgcn_exp2f(__builtin_fmaf(acc1[j], -1.4426950408889634f, nbx)));
                        const float a = __builtin_amdgcn_exp2f(lamc * r); const float b = __builtin_amdgcn_sqrtf(fmaxf(1.f - a * a, 0.f)) * (ig * u);
                        Bv = a * Bv + b; A *= a; Pa[m][j] = A; Pb[m][j] = Bv; }
                    asm volatile("" ::: "memory"); }
                LRU_LOADO();
                float EA[4], EB[4], TA[4], TB[4];
                { const bool odd = (fq & 1) != 0, hi = (fq >> 1) != 0;
#pragma unroll
                for (int m = 0; m < 4; ++m) { const float a = Pa[m][3], b = Pb[m][3];
                    const float pa = swap16_get(a, lane), pb = swap16_get(b, lane);
                    const float ptA = a * pa, ptB = odd ? (a * pb + b) : (pa * b + pb);
                    const float oA = swap32_get(ptA, lane), oB = swap32_get(ptB, lane);
                    const float t01A = hi ? oA : ptA, t01B = hi ? oB : ptB, t23A = hi ? ptA : oA, t23B = hi ? ptB : oB;
                    TA[m] = t01A * t23A; TB[m] = t23A * t01B + t23B;
                    const float e1A = odd ? pa : 1.f, e1B = odd ? pb : 0.f;
                    EA[m] = hi ? t01A * e1A : e1A; EB[m] = hi ? (e1A * t01B + e1B) : e1B; } }
                float CA = 1.f, CB = 0.f;
#pragma unroll
                for (int m = 0; m < 4; ++m) {
                    const float GA = EA[m] * CA, GB = EA[m] * CB + EB[m];
                    const float hg = GB + GA * hprev;
#pragma unroll
                    for (int j = 0; j < 4; j += 2) { const unsigned w2 = pk2(Pb[m][j] + Pa[m][j] * hg, Pb[m][j + 1] + Pa[m][j + 1] * hg);
                        const int rho = 16 * m + 4 * fq + j, tok0 = dir ? 63 - rho : rho, tok1 = dir ? tok0 - 1 : tok0 + 1;
                        *(LAS unsigned short*)(O + tok0 * LRU_OP + (nt * 16 + fr) * 2) = (unsigned short)w2; *(LAS unsigned short*)(O + tok1 * LRU_OP + (nt * 16 + fr) * 2) = (unsigned short)(w2 >> 16); }
                    CB = TA[m] * CB + TB[m]; CA = TA[m] * CA; }
                hprev = CB + CA * hprev;
            }
            LSEC_E(2) LSEC_B(3)
            if (s >= 1) {
#pragma unroll
                for (int i = 0; i < 2; ++i) { const v4u hv = *(const LAS v4u*)(lds + LRU_O0 + ((buf ^ 1) * 2 + i) * LRU_OB + otok * LRU_OP + og * 16);
                    if (ofirst) *(v4u*)((char*)HT + (orow[i] * (unsigned)DMODEL + (unsigned)(blk * 128 + half * 64 + og * 8)) * 2u) = hv;
                    else { float y[8];
#pragma unroll
                        for (int e = 0; e < 4; ++e) { const float h0 = bf2f(hv[e] & 0xffffu) + bf2f(ohf[i][e] & 0xffffu), h1 = bf2f(hv[e] >> 16) + bf2f(ohf[i][e] >> 16);
                            y[2 * e] = __builtin_amdgcn_fmed3f(h0 * bf2f(ogt[i][e] & 0xffffu) * M8_SA, -448.f, 448.f); y[2 * e + 1] = __builtin_amdgcn_fmed3f(h1 * bf2f(ogt[i][e] >> 16) * M8_SA, -448.f, 448.f); }
                        typedef unsigned u32x2_ __attribute__((ext_vector_type(2)));
                        *(u32x2_*)(M8 + (orow[i] * 2048u + (unsigned)(blk * 128 + half * 64 + og * 8))) = (u32x2_){pk4_fp8(y[0], y[1], y[2], y[3]), pk4_fp8(y[4], y[5], y[6], y[7])}; } }
            }
            LSEC_E(3) LSEC_B(4)
            if (s + 1 < 36) LRU_CONV(buf ^ 1);
            LSEC_E(4) LSEC_B(5)
            if (s == 2 || s == 20) VM_WAIT();
            asm volatile("s_waitcnt lgkmcnt(0)\n\ts_barrier" ::: "memory");
            LSEC_E(5)
        }
#undef LRU_LOADX
#undef LRU_LOADO
        __builtin_amdgcn_s_setprio(0);
        if (MK_LRU_SEC != 0) { const unsigned long long te_ = __builtin_amdgcn_s_memrealtime() + 3ull * lsec_acc; while (__builtin_amdgcn_s_memrealtime() < te_) __builtin_amdgcn_s_sleep(8); }
#undef LRU_CONV
    }
}

__device__ __forceinline__ void ph_attn(const Args& A_, Frame& F, int l, char* lds_generic) {
    PH_IDS
    using abf = attn_body::bf16;
    abf* P = (abf*)(F.ws + WS_P); unsigned char* M8 = F.ws + WS_M8;
    const int ndense = BC * 64 + (l == 0 ? BC * 16 : 0), nna = BC * 64;
    const int cd = (vcu < ndense) ? (ndense - vcu + F.G - 1) / F.G : 0, cn = (vcu < nna) ? (nna - vcu + F.G - 1) / F.G : 0;
    struct Desc { const abf *Q0, *Kh, *Vh; unsigned char* O8; int NT, R0w, nar0, h, mode; };
    auto desc = [&](int i, Desc& d) {
        if (i < cd) { const int v = vcu + i * F.G; d.mode = 0; d.R0w = 0; d.nar0 = 0; d.h = 0;
            if (v < BC * 64) { const int u = v;
                const int qb = ((u & 7) + 2 * (u >> 8)) & 7, rest = ((u >> 3) & 31) + 32 * (u >> 8), bl = rest >> 3, h = rest & 7;
                d.Q0 = P + (size_t)(bl * SB + CTXL + 256 * qb) * PW + C_GQ + h * 64; d.Kh = P + (size_t)(bl * SB) * PW + C_GK + (h >> 2) * 64; d.Vh = d.Kh + (C_GV - C_GK); d.NT = SB / 64;
                d.O8 = M8 + (size_t)(bl * SB + CTXL + 256 * qb) * 2048 + 1536 + h * 64; }
            else { const int u = v - BC * 64; const int kind = u / (BC * 8), idx = u % (BC * 8), bl = idx >> 3, h = idx & 7;
                if (kind == 0) { d.Q0 = P + (size_t)(bl * SB) * PW + C_GQ + h * 64; d.Kh = P + (size_t)(bl * SB) * PW + C_GK + (h >> 2) * 64; d.Vh = d.Kh + (C_GV - C_GK); d.O8 = M8 + (size_t)(bl * SB) * 2048 + 1536 + h * 64; }
                else { d.Q0 = P + (size_t)(bl * SB) * PW + C_NQ + h * 64; d.Kh = P + (size_t)(bl * SB) * PW + C_NK + h * 64; d.Vh = d.Kh + (C_NV - C_NK); d.O8 = M8 + (size_t)(bl * SB) * 2048 + 1024 + h * 64; }
                d.NT = CTXL / 64; } }
        else { const int u = vcu + (i - cd) * F.G; d.mode = 1;
            const int qb = ((u & 7) + 2 * (u >> 8)) & 7, rest = ((u >> 3) & 31) + 32 * (u >> 8), bl = rest >> 3, h = rest & 7;
            d.Q0 = P + (size_t)(bl * SB + CTXL + 256 * qb) * PW + C_NQ + h * 64; d.Kh = P + (size_t)(bl * SB) * PW + C_NK + h * 64; d.Vh = d.Kh + (C_NV - C_NK);
            d.NT = 4 + ((qb == 0 || qb == 7) ? 8 : 12); d.R0w = (qb == 0) ? 0 : 4 * qb - 4; d.nar0 = 4 * qb; d.h = h;
            d.O8 = M8 + (size_t)(bl * SB + CTXL + 256 * qb) * 2048 + 1024 + h * 64; } };
    int htab = -1;
    bool pre = false;
    for (int i = 0; i < cd + cn; ++i) {
        Desc cur; desc(i, cur);
        const bool hn = i + 1 < cd + cn; const abf* nQ0 = nullptr; const abf* nKh = nullptr;
        const abf* nVh = nullptr;
        if (hn) { Desc nx; desc(i + 1, nx); nQ0 = nx.Q0; nKh = nx.Kh; nVh = nx.Vh; }
        if (cur.mode == 0) attn_body::attn_unit<8, 0>(cur.Q0, cur.Kh, cur.Vh, cur.O8, cur.NT, 0, 0, nullptr, lds_generic, pre, nQ0, nKh, nVh);
        else {
            if (cur.h != htab) { __syncthreads(); attn_body::na_fill_table(A_.in[I_RPB] + (size_t)(l * 8 + cur.h) * 15 * 31, lds_generic); __syncthreads(); htab = cur.h; }
            attn_body::attn_unit<8, 1>(cur.Q0, cur.Kh, cur.Vh, cur.O8, cur.NT, cur.R0w, cur.nar0, nullptr, lds_generic, pre, nQ0, nKh, nVh); }
        pre = hn;
    }
}

struct TileMap {
    int nM, nN, nwg, G, c;
    __device__ __forceinline__ void init(int nM_, int nN_, int G_, int c_) { nM = nM_; nN = nN_; nwg = nM_ * nN_; G = G_; c = c_; }
    __device__ __forceinline__ bool get(int i, int& pm, int& pn) const { return getL((long)i * G + c, pm, pn); }
    __device__ __forceinline__ bool getL(long L, int& pm, int& pn) const {
        if (L >= nwg) return false;
        int wgid = (int)L; { const int q = nwg / 8, r = nwg % 8, xcd = wgid % 8, off = wgid / 8; wgid = (xcd < r ? xcd * (q + 1) : r * (q + 1) + (xcd - r) * q) + off; }
        const int nig = 8 * nN, gid = wgid / nig, fm = gid * 8, gsz = (nM - fm) < 8 ? (nM - fm) : 8;
        pm = fm + ((wgid % nig) % gsz); pn = (wgid % nig) / gsz; return true;
    }
};
struct SchedPlain {
    TileMap T; const char* A; const char* B; size_t astep, bstep; bool skipctx;
    __device__ __forceinline__ bool next(int i, pg8::Unit& u) const { int pm, pn; if (!T.get(i, pm, pn)) return false; if (skipctx) pm = (pm >> 3) * 9 + 1 + (pm & 7);
        u.pm = pm; u.pn = pn; u.A = A + (size_t)pm * astep; u.B = B + (size_t)pn * bstep; return true; }
    __device__ __forceinline__ void a_ready(const pg8::Unit&) const {}
    __device__ __forceinline__ void done(const pg8::Unit&) const {}
};
struct SchedG1 {
    TileMap T1, T2; const char* A; const char* B; bool last;
    __device__ __forceinline__ void init(bool last_, int G, int c) { last = last_; if (last_) { T1.init(BC * 8, NPROJ / 256, G, c); T2.init(BC, 9, G, c); } else { T1.init(MC / 256, NPROJ / 256, G, c); T2.init(0, 9, G, c); } }
    __device__ __forceinline__ bool next(int i, pg8::Unit& u) const { int pm, pn; const long L = (long)i * T1.G + T1.c;
        if (L < T1.nwg) { T1.getL(L, pm, pn); if (last) pm = (pm >> 3) * 9 + 1 + (pm & 7); }
        else { if (!T2.getL(L - T1.nwg, pm, pn)) return false; pm = pm * 9; pn = (pn < 4) ? pn : 8 + pn; }
        u.pm = pm; u.pn = pn; u.A = A + (size_t)pm * (256 * 1024); u.B = B + (size_t)pn * (256 * 1024); return true; }
    __device__ __forceinline__ void a_ready(const pg8::Unit&) const {}
    __device__ __forceinline__ void done(const pg8::Unit&) const {}
};
struct EpiG1 {
    static constexpr bool PERM = true, AFTER_DRAIN = false;
    bf16* O; unsigned char* G8;
    __device__ __forceinline__ void operator()(const pg8::f32x4 (&acc)[2][2][4][2], const pg8::Unit& u, int wr, int wc, int fr, int fq) const {
        int row0 = u.pm * 256 + wr * 64 + fr, col0 = u.pn * 256 + wc * 32 + 8 * fq; asm volatile("" : "+v"(row0), "+v"(col0));
        if (u.pn >= PW / 256) {
            const int gt = u.pn - PW / 256;
            unsigned char* tb = G8 + ((size_t)((gt >> 2) * (MC / 256) + u.pm) * 4 + (gt & 3)) * 65536 + ((wr * 4 + wc) * 8192 + (fq * 16 + fr) * 16);
#pragma unroll
            for (int ai = 0; ai < 2; ++ai)
#pragma unroll
                for (int m = 0; m < 4; ++m) {
#define G1_E4(v_) pk4_fp8(fminf(__builtin_amdgcn_exp2f((v_)[0] * -1.4426950408889634f), 448.f), fminf(__builtin_amdgcn_exp2f((v_)[1] * -1.4426950408889634f), 448.f), fminf(__builtin_amdgcn_exp2f((v_)[2] * -1.4426950408889634f), 448.f), fminf(__builtin_amdgcn_exp2f((v_)[3] * -1.4426950408889634f), 448.f))
                    __builtin_nontemporal_store((v4u){G1_E4(acc[ai][0][m][0]), G1_E4(acc[ai][0][m][1]), G1_E4(acc[ai][1][m][0]), G1_E4(acc[ai][1][m][1])}, (v4u*)(tb + (ai * 4 + m) * 1024)); }
#undef G1_E4
            return; }
        const bool gl = (u.pn >= C_LG / 256 && u.pn < C_NQ / 256);
#pragma unroll
        for (int ai = 0; ai < 2; ++ai)
#pragma unroll
            for (int m = 0; m < 4; ++m) { bf16* rowp = O + (size_t)(row0 + ai * 128 + m * 16) * PW + col0;
#pragma unroll
                for (int bj = 0; bj < 2; ++bj) { float o[8];
#pragma unroll
                    for (int e = 0; e < 8; ++e) { const float v = acc[ai][bj][m][e >> 2][e & 3]; o[e] = gl ? gelu_tanh(v) : v; }
                    *(v4u*)(rowp + bj * 128) = (v4u){pk2(o[0], o[1]), pk2(o[2], o[3]), pk2(o[4], o[5]), pk2(o[6], o[7])}; } }
    }
};
struct SchedMoe {
    TileMap T; const char* A; const char* B; size_t astep, bstep, estep; const int* gidx;
    __device__ __forceinline__ bool next(int i, pg8::Unit& u) const { int pm, pn; if (!T.get(i, pm, pn)) return false;
        const int e = (pm < NE * BC) ? pm / BC : (pm - NE * BC) / (BC / 8);
        u.pm = pm; u.pn = pn; u.A = A + (size_t)pm * astep; u.B = B + (size_t)e * estep + (size_t)pn * bstep; u.gidx = gidx ? gidx + (size_t)pm * 256 : nullptr; return true; }
    __device__ __forceinline__ void a_ready(const pg8::Unit&) const {}
    __device__ __forceinline__ void done(const pg8::Unit&) const {}
};
struct EpiMerge {
    static constexpr bool PERM = true, AFTER_DRAIN = false; static constexpr int HOOK_T0 = 8, HOOK_T1 = 12;
    const unsigned char* G8; unsigned char* O;
    typedef unsigned u32x2_ __attribute__((ext_vector_type(2)));
    static __device__ __forceinline__ void f8x8(const u32x2_ w, float (&o)[8]) {
        const auto a = __builtin_amdgcn_cvt_pk_f32_fp8((int)w[0], false), b = __builtin_amdgcn_cvt_pk_f32_fp8((int)w[0], true), c = __builtin_amdgcn_cvt_pk_f32_fp8((int)w[1], false), d = __builtin_amdgcn_cvt_pk_f32_fp8((int)w[1], true);
        o[0] = a[0]; o[1] = a[1]; o[2] = b[0]; o[3] = b[1]; o[4] = c[0]; o[5] = c[1]; o[6] = d[0]; o[7] = d[1]; }
    __device__ __forceinline__ void khook(pg8::f32x4 (&acc)[2][2][4][2], const pg8::Unit& u, int t, int wr, int wc, int fr, int fq) const {
        const int bn = (t == HOOK_T0) ? 0 : 1; const float kf = (t == HOOK_T0) ? (M8_SB / M8_SA) : 1.f;
        int loff = (wr * 4 + wc) * 8192 + (fq * 16 + fr) * 16; asm volatile("" : "+v"(loff));
        const unsigned char* tn = G8 + ((size_t)(bn * (MC / 256) + u.pm) * 4 + u.pn) * 65536 + loff; const unsigned char* td = tn + (size_t)(MC / 256) * 4 * 65536;
        v4u gn[2][4], gd[2][4];
#pragma unroll
        for (int ai = 0; ai < 2; ++ai)
#pragma unroll
            for (int m = 0; m < 4; ++m) { gn[ai][m] = __builtin_nontemporal_load((const v4u*)(tn + (ai * 4 + m) * 1024)); gd[ai][m] = __builtin_nontemporal_load((const v4u*)(td + (ai * 4 + m) * 1024)); }
#pragma unroll
        for (int ai = 0; ai < 2; ++ai) {
#pragma unroll
            for (int m = 0; m < 4; ++m)
#pragma unroll
                for (int bj = 0; bj < 2; ++bj)
                    { float ln[8], ld[8]; f8x8((u32x2_){gn[ai][m][2 * bj], gn[ai][m][2 * bj + 1]}, ln); f8x8((u32x2_){gd[ai][m][2 * bj], gd[ai][m][2 * bj + 1]}, ld);
#pragma unroll
                    for (int e = 0; e < 8; ++e) acc[ai][bj][m][e >> 2][e & 3] *= (kf + kf * ld[e]) * fast_rcp(1.f + ln[e]); }
            asm volatile("" ::: "memory"); }
    }
    __device__ __forceinline__ void operator()(const pg8::f32x4 (&acc)[2][2][4][2], const pg8::Unit& u, int wr, int wc, int fr, int fq) const {
        int row0 = u.pm * 256 + wr * 64 + fr, col0 = u.pn * 256 + wc * 32 + 8 * fq; asm volatile("" : "+v"(row0), "+v"(col0));
        int loff = (wr * 4 + wc) * 8192 + (fq * 16 + fr) * 16; asm volatile("" : "+v"(loff));
        const unsigned char* tc = G8 + ((size_t)(2 * (MC / 256) + u.pm) * 4 + u.pn) * 65536 + loff;
        v4u gc[2][4];
#pragma unroll
        for (int ai = 0; ai < 2; ++ai)
#pragma unroll
            for (int m = 0; m < 4; ++m) gc[ai][m] = __builtin_nontemporal_load((const v4u*)(tc + (ai * 4 + m) * 1024));
#pragma unroll
        for (int ai = 0; ai < 2; ++ai) {
#pragma unroll
            for (int m = 0; m < 4; ++m) { const size_t r = (size_t)(row0 + ai * 128 + m * 16);
#pragma unroll
                for (int bj = 0; bj < 2; ++bj) { float o[8], lc[8]; f8x8((u32x2_){gc[ai][m][2 * bj], gc[ai][m][2 * bj + 1]}, lc);
#pragma unroll
                    for (int e = 0; e < 8; ++e) o[e] = __builtin_amdgcn_fmed3f(acc[ai][bj][m][e >> 2][e & 3] * fast_rcp((M8_SB / MQ_S) + (M8_SB / MQ_S) * lc[e]), -448.f, 448.f);
                    *(u32x2_*)(O + r * DMODEL + col0 + bj * 128) = (u32x2_){pk4_fp8(o[0], o[1], o[2], o[3]), pk4_fp8(o[4], o[5], o[6], o[7])}; } }
            asm volatile("" ::: "memory"); }
    }
};
struct EpiSwiglu {
    static constexpr bool PERM = true, AFTER_DRAIN = false;
    unsigned char* O;
    __device__ __forceinline__ void operator()(const pg8::f32x4 (&acc)[2][2][4][2], const pg8::Unit& u, int wr, int wc, int fr, int fq) const {
        int row0 = u.pm * 256 + wr * 64 + fr, col0 = u.pn * 128 + wc * 32 + 8 * fq; asm volatile("" : "+v"(row0), "+v"(col0));
#pragma unroll
        for (int ai = 0; ai < 2; ++ai)
#pragma unroll
            for (int m = 0; m < 4; ++m) { float o[8];
#pragma unroll
                for (int e = 0; e < 8; ++e) { const float g = acc[ai][0][m][e >> 2][e & 3], up = acc[ai][1][m][e >> 2][e & 3]; o[e] = g * sigmoidf_(g) * up; }
                typedef unsigned u32x2_ __attribute__((ext_vector_type(2)));
                *(u32x2_*)(O + (size_t)(row0 + ai * 128 + m * 16) * DMODEL + col0) = (u32x2_){pk4_fp8(o[0], o[1], o[2], o[3]), pk4_fp8(o[4], o[5], o[6], o[7])}; }
    }
};

__device__ __forceinline__ void ph_norm2(const Args& A_, Frame& F, int l, int ch) {
    PH_IDS
    const int gw = vcu * 8 + wid, NGW = F.G * 8;
    LAS f32x4* WR = (LAS f32x4*)F.lds;
    __syncthreads();
    for (int i = tid; i < 4096; i += 512) { const int k = i >> 2, q = i & 3; const int slot = ((k >> 2) & 63) + 64 * ((k & 3) + 4 * (k >> 8));
        WR[q * 1024 + slot] = *(const f32x4*)(A_.in[I_WR] + (size_t)l * DMODEL * NE + k * NE + q * 4); }
    __syncthreads();
    const bf16* O1 = (const bf16*)(F.ws + WS_O1); bf16* H = (bf16*)(F.ws + WS_H);
    float* affen = (float*)(F.ws + WS_AFFEN); float* affne = (float*)(F.ws + WS_AFFNE);
    const int nrows = (l == 0) ? MC : BC * SEQ;
#define N2_ROW(idx) ((l == 0) ? (idx) : ((idx) / SEQ) * SB + CTXL + ((idx) % SEQ))
    unsigned long long on[2][4], xb[2][4]; f32x4 xn[2][4];
#define N2_FETCH(base) do { _Pragma("unroll") for (int rr = 0; rr < 2; ++rr) { const int i2_ = ((base) + rr * NGW < nrows) ? (base) + rr * NGW : (base); const int row_ = N2_ROW(i2_), bl_ = row_ / SB, s_ = row_ - bl_ * SB; \
            _Pragma("unroll") for (int j = 0; j < 4; ++j) { on[rr][j] = __builtin_nontemporal_load((const unsigned long long*)(O1 + (size_t)row_ * DMODEL) + lane + 64 * j); \
                if (l == 0) xn[rr][j] = __builtin_nontemporal_load((const f32x4*)res_in(A_, ch * BC + bl_, s_) + lane + 64 * j); else xb[rr][j] = __builtin_nontemporal_load((const unsigned long long*)res_xr(F, ch * BC + bl_, s_) + lane + 64 * j); } } } while (0)
    if (gw < nrows) N2_FETCH(gw);
#ifndef MK_N2_SEC
#define MK_N2_SEC 0
#endif
#define NSEC_B(k) if (MK_N2_SEC == (k)) { nsec_t0 = __builtin_amdgcn_s_memrealtime(); }
#define NSEC_E(k) if (MK_N2_SEC == (k)) { nsec_acc += __builtin_amdgcn_s_memrealtime() - nsec_t0; }
    unsigned long long nsec_t0 = 0, nsec_acc = 0;
    for (int idx = gw; idx < nrows; idx += 2 * NGW) {
        NSEC_B(1)
        int row[2], bl[2], s[2], b[2]; bool ok[2];
#pragma unroll
        for (int rr = 0; rr < 2; ++rr) { ok[rr] = idx + rr * NGW < nrows; row[rr] = N2_ROW(ok[rr] ? idx + rr * NGW : idx); bl[rr] = row[rr] / SB; s[rr] = row[rr] - bl[rr] * SB; b[rr] = ch * BC + bl[rr]; }
        f32x4 o[2][4], x[2][4];
#pragma unroll
        for (int rr = 0; rr < 2; ++rr)
#pragma unroll
            for (int j = 0; j < 4; ++j) { const unsigned long long w = on[rr][j];
                o[rr][j].x = bf2f((unsigned)w & 0xffffu); o[rr][j].y = bf2f(((unsigned)w >> 16)); o[rr][j].z = bf2f((unsigned)(w >> 32) & 0xffffu); o[rr][j].w = bf2f((unsigned)(w >> 48));
                if (l == 0) x[rr][j] = xn[rr][j]; else { const unsigned long long q = xb[rr][j]; x[rr][j].x = bf2f((unsigned)q & 0xffffu); x[rr][j].y = bf2f(((unsigned)q >> 16)); x[rr][j].z = bf2f((unsigned)(q >> 32) & 0xffffu); x[rr][j].w = bf2f((unsigned)(q >> 48)); } }
        if (idx + 2 * NGW < nrows) N2_FETCH(idx + 2 * NGW);
        NSEC_E(1) NSEC_B(2)
        const float* mr[2]; float rs1[2], rs2[2];
#pragma unroll
        for (int rr = 0; rr < 2; ++rr) { mr[rr] = mod_row(A_, F, l, b[rr], s[rr]); rs1[rr] = row_rstd(o[rr], lane); }
#pragma unroll
        for (int rr = 0; rr < 2; ++rr) {
#pragma unroll
            for (int j = 0; j < 4; ++j) { const f32x4 c1 = ((const f32x4*)(mr[rr] + 2 * DMODEL))[lane + 64 * j]; x[rr][j] = x[rr][j] + c1 * (o[rr][j] * rs1[rr]); }
            if (ok[rr]) row_store_bf16(res_xr(F, b[rr], s[rr]), lane, x[rr]); }
#pragma unroll
        for (int rr = 0; rr < 2; ++rr) rs2[rr] = row_rstd(x[rr], lane);
#pragma unroll
        for (int rr = 0; rr < 2; ++rr) {
#pragma unroll
            for (int j = 0; j < 4; ++j) { const f32x4 sh = ((const f32x4*)(mr[rr] + 3 * DMODEL))[lane + 64 * j], c2 = ((const f32x4*)(mr[rr] + 4 * DMODEL))[lane + 64 * j];
                x[rr][j] = (x[rr][j] * rs2[rr]) * c2 + sh; }
            if (ok[rr]) row_store_fp8((unsigned char*)H + (size_t)row[rr] * DMODEL, lane, x[rr]); }
        NSEC_E(2) NSEC_B(3)
        float v[2][16];
#pragma unroll
        for (int rr = 0; rr < 2; ++rr)
#pragma unroll
            for (int e = 0; e < 16; ++e) v[rr][e] = 0.f;
#pragma unroll
        for (int j = 0; j < 4; ++j)
#pragma unroll
            for (int i = 0; i < 4; ++i) { const int slot = lane + 64 * (i + 4 * j);
#pragma unroll
                for (int q = 0; q < 4; ++q) { const f32x4 w = WR[q * 1024 + slot];
#pragma unroll
                    for (int rr = 0; rr < 2; ++rr) { const float xv = x[rr][j][i]; v[rr][4 * q] += xv * w.x; v[rr][4 * q + 1] += xv * w.y; v[rr][4 * q + 2] += xv * w.z; v[rr][4 * q + 3] += xv * w.w; } }
                if (i & 1) asm volatile("" ::: "memory"); }
        NSEC_E(3) NSEC_B(4)
        const int e = ((lane >> 5) & 1) * 8 + ((lane >> 4) & 1) * 4 + ((lane >> 3) & 1) * 2 + ((lane >> 2) & 1);
#pragma unroll
        for (int rr = 0; rr < 2; ++rr) {
#pragma unroll
            for (int e2 = 0; e2 < 8; ++e2) { const bool up = (lane & 32) != 0; const float snd = up ? v[rr][e2] : v[rr][e2 + 8], kp = up ? v[rr][e2 + 8] : v[rr][e2]; v[rr][e2] = kp + swap32_get(snd, lane); }
#pragma unroll
            for (int e2 = 0; e2 < 4; ++e2) { const bool up = (lane & 16) != 0; const float snd = up ? v[rr][e2] : v[rr][e2 + 4], kp = up ? v[rr][e2 + 4] : v[rr][e2]; v[rr][e2] = kp + swap16_get(snd, lane); }
#pragma unroll
            for (int e2 = 0; e2 < 2; ++e2) { const bool up = (lane & 8) != 0; const float snd = up ? v[rr][e2] : v[rr][e2 + 2], kp = up ? v[rr][e2 + 2] : v[rr][e2]; v[rr][e2] = kp + shx(snd, 8, lane); }
            { const bool up = (lane & 4) != 0; const float snd = up ? v[rr][0] : v[rr][1], kp = up ? v[rr][1] : v[rr][0]; v[rr][0] = kp + shx(snd, 4, lane); } }
#pragma unroll
        for (int rr = 0; rr < 2; ++rr) {
            float lg = v[rr][0]; lg += DPPF(lg, 0x4E); lg += DPPF(lg, 0xB1);
            float mx = lg;
            mx = fmaxf(mx, DPPF(mx, 0x141)); mx = fmaxf(mx, DPPF(mx, 0x140)); mx = fmaxf(mx, swap16_get(mx, lane)); mx = fmaxf(mx, swap32_get(mx, lane));
            const float ex = __expf(lg - mx); float sm = ex;
            sm += DPPF(sm, 0x141); sm += DPPF(sm, 0x140); sm = swap32_sum(swap16_sum(sm));
            const float aff = ex / sm;
            if (ok[rr] && (lane & 3) == 0) { affen[(size_t)(bl[rr] * NE + e) * SB + s[rr]] = aff; affne[(size_t)row[rr] * NE + e] = aff; } }
        NSEC_E(4)
    }
#undef N2_FETCH
    if (MK_N2_SEC != 0) { const unsigned long long te_ = __builtin_amdgcn_s_memrealtime() + 3ull * nsec_acc; while (__builtin_amdgcn_s_memrealtime() < te_) __builtin_amdgcn_s_sleep(8); }
#undef N2_ROW
}

__device__ __forceinline__ unsigned topk_scan32(unsigned v, int lane) {
    unsigned s = v;
#pragma unroll
    for (int o = 1; o < 32; o <<= 1) { const unsigned t = (unsigned)__builtin_amdgcn_ds_bpermute(((lane - o) & 63) << 2, (int)s); if (lane >= o) s += t; }
    return s - v;
}
__device__ __forceinline__ void ph_topk(const Args& A_, Frame& F, int l) {
    PH_IDS
    LAS unsigned* HIST = (LAS unsigned*)F.lds;
    LAS unsigned* CW = HIST + 256;
    LAS unsigned* WT = HIST + 272;
    const float* affen = (const float*)(F.ws + WS_AFFEN); int* slot_of = (int*)(F.ws + WS_SLOT);
    int* rowidx = (int*)(F.ws + WS_ROWIDX);
    const int nitems = (l == 0) ? 2 * BC * NE : BC * NE;
    for (int item = blockIdx.x; item < nitems; item += F.G) {
        const int set = item / (BC * NE), ie = item % (BC * NE), bl = ie / NE, e = ie % NE;
        const int n = set ? CTXL : SEQ, cap = n / 8, seg0 = set ? 0 : CTXL;
        unsigned key[4]; bool valid[4];
#pragma unroll
        for (int j = 0; j < 4; ++j) { const int idx = tid + 512 * j; valid[j] = idx < n; key[j] = valid[j] ? __float_as_uint(affen[(size_t)(bl * NE + e) * SB + seg0 + idx]) : 0u; }
        unsigned prefix = 0u, need = (unsigned)cap;
#pragma unroll 1
        for (int pass = 0; pass < 4; ++pass) { const int shift = 24 - 8 * pass;
            __syncthreads();
            if (tid < 256) HIST[tid] = 0u;
            __syncthreads();
#pragma unroll
            for (int j = 0; j < 4; ++j) if (valid[j] && (pass == 0 || (key[j] >> (shift + 8)) == prefix)) atomicAdd((unsigned*)&HIST[(key[j] >> shift) & 255u], 1u);
            __syncthreads();
            if (wid == 0) {
                unsigned c[4];
#pragma unroll
                for (int b = 0; b < 4; ++b) c[b] = HIST[4 * lane + b];
                const unsigned s = (c[0] + c[1]) + (c[2] + c[3]); unsigned S = s;
#pragma unroll
                for (int o = 1; o < 64; o <<= 1) { const unsigned t = (unsigned)__builtin_amdgcn_ds_bpermute(((lane + o) & 63) << 2, (int)S); if (lane + o < 64) S += t; }
                unsigned cum = S - s;
#pragma unroll
                for (int b = 3; b >= 0; --b) { if (cum < need && cum + c[b] >= need) { CW[0] = (prefix << 8) | (unsigned)(4 * lane + b); CW[1] = need - cum; } cum += c[b]; }
            }
            __syncthreads();
            prefix = CW[0]; need = CW[1];
        }
        const unsigned T = prefix, need_eq = need;
        unsigned rk[4];
#pragma unroll
        for (int j = 0; j < 4; ++j) { const bool eq = valid[j] && key[j] == T; const unsigned long long bm = __builtin_amdgcn_ballot_w64(eq);
            rk[j] = __builtin_amdgcn_mbcnt_hi((unsigned)(bm >> 32), __builtin_amdgcn_mbcnt_lo((unsigned)bm, 0u)); if (lane == 0) WT[j * 8 + wid] = (unsigned)__builtin_popcountll(bm); }
        __syncthreads();
        if (wid == 0) { const unsigned v = (lane < 32) ? WT[lane] : 0u; const unsigned p = topk_scan32(v, lane); if (lane < 32) WT[lane] = p; }
        __syncthreads();
        bool sel[4];
#pragma unroll
        for (int j = 0; j < 4; ++j) { const unsigned r = rk[j] + WT[j * 8 + wid]; sel[j] = valid[j] && (key[j] > T || (key[j] == T && r < need_eq)); }
        __syncthreads();
#pragma unroll
        for (int j = 0; j < 4; ++j) { const unsigned long long bm = __builtin_amdgcn_ballot_w64(sel[j]);
            rk[j] = __builtin_amdgcn_mbcnt_hi((unsigned)(bm >> 32), __builtin_amdgcn_mbcnt_lo((unsigned)bm, 0u)); if (lane == 0) WT[j * 8 + wid] = (unsigned)__builtin_popcountll(bm); }
        __syncthreads();
        if (wid == 0) { const unsigned v = (lane < 32) ? WT[lane] : 0u; const unsigned p = topk_scan32(v, lane); if (lane < 32) WT[lane] = p; }
        __syncthreads();
        const int dst0 = set ? (NE * BC) * 256 + (e * BC + bl) * 32 : (e * BC + bl) * 256;
#pragma unroll
        for (int j = 0; j < 4; ++j) if (valid[j]) { const int p = (int)(rk[j] + WT[j * 8 + wid]); const int row = bl * SB + seg0 + tid + 512 * j;
            slot_of[(size_t)row * NE + e] = sel[j] ? dst0 + p : -1; if (sel[j]) rowidx[dst0 + p] = row; }
    }
}

__device__ __forceinline__ void ph_combine(const Args& A_, Frame& F, int l, int ch) {
    PH_IDS
    const int gw = vcu * 8 + wid, NGW = F.G * 8;
    const bf16* Y = (const bf16*)(F.ws + WS_HS); const float* affne = (const float*)(F.ws + WS_AFFNE); const int* slot_of = (const int*)(F.ws + WS_SLOT);
    const int nrows = (l == 0) ? MC : BC * SEQ;
#define CB_ROW(idx) ((l == 0) ? (idx) : ((idx) / SEQ) * SB + CTXL + ((idx) % SEQ))
    int sln = -1; float afn = 0.f; unsigned long long xn[4];
    if (gw < nrows) { const int row = CB_ROW(gw), bl = row / SB, s = row - bl * SB; sln = slot_of[(size_t)row * NE + (lane & 15)]; afn = affne[(size_t)row * NE + (lane & 15)];
#pragma unroll
        for (int j = 0; j < 4; ++j) xn[j] = __builtin_nontemporal_load((const unsigned long long*)res_xr(F, ch * BC + bl, s) + lane + 64 * j); }
    for (int idx = gw; idx < nrows; idx += NGW) {
        const int row = CB_ROW(idx), bl = row / SB, s = row - bl * SB, b = ch * BC + bl;
        const int sl = sln; const float af = afn; unsigned long long xq[4];
#pragma unroll
        for (int j = 0; j < 4; ++j) xq[j] = xn[j];
        if (idx + NGW < nrows) { const int row2 = CB_ROW(idx + NGW), bl2 = row2 / SB, s2 = row2 - bl2 * SB; sln = slot_of[(size_t)row2 * NE + (lane & 15)]; afn = affne[(size_t)row2 * NE + (lane & 15)];
#pragma unroll
            for (int j = 0; j < 4; ++j) xn[j] = __builtin_nontemporal_load((const unsigned long long*)res_xr(F, ch * BC + bl2, s2) + lane + 64 * j); }
        f32x4 acc[4];
#pragma unroll
        for (int j = 0; j < 4; ++j) acc[j] = (f32x4){0.f, 0.f, 0.f, 0.f};
        unsigned em = (unsigned)__builtin_amdgcn_ballot_w64(sl >= 0) & 0xffffu;
        while (em) {
            const int e0 = __builtin_ctz(em); em &= em - 1u; const bool two = em != 0u; const int e1 = two ? __builtin_ctz(em) : e0; em &= em - 1u;
            const int s0 = __builtin_amdgcn_readlane(sl, e0), s1 = __builtin_amdgcn_readlane(sl, e1);
            const float a0 = __builtin_bit_cast(float, __builtin_amdgcn_readlane(__builtin_bit_cast(int, af), e0)), a1 = two ? __builtin_bit_cast(float, __builtin_amdgcn_readlane(__builtin_bit_cast(int, af), e1)) : 0.f;
            unsigned long long y0[4], y1[4];
#pragma unroll
            for (int j = 0; j < 4; ++j) y0[j] = __builtin_nontemporal_load((const unsigned long long*)(Y + (size_t)s0 * DMODEL) + lane + 64 * j);
            if (two) {
#pragma unroll
                for (int j = 0; j < 4; ++j) y1[j] = __builtin_nontemporal_load((const unsigned long long*)(Y + (size_t)s1 * DMODEL) + lane + 64 * j); }
            else {
#pragma unroll
                for (int j = 0; j < 4; ++j) y1[j] = 0ull; }
#pragma unroll
            for (int j = 0; j < 4; ++j) { const unsigned long long w = y0[j], q = y1[j];
                acc[j].x += bf2f((unsigned)w & 0xffffu) * a0; acc[j].y += bf2f((unsigned)w >> 16) * a0; acc[j].z += bf2f((unsigned)(w >> 32) & 0xffffu) * a0; acc[j].w += bf2f((unsigned)(w >> 48)) * a0;
                acc[j].x += bf2f((unsigned)q & 0xffffu) * a1; acc[j].y += bf2f((unsigned)q >> 16) * a1; acc[j].z += bf2f((unsigned)(q >> 32) & 0xffffu) * a1; acc[j].w += bf2f((unsigned)(q >> 48)) * a1; }
        }
        bf16* xr = res_xr(F, b, s);
        f32x4 x[4];
#pragma unroll
        for (int j = 0; j < 4; ++j) { const unsigned long long w = xq[j]; x[j].x = bf2f((unsigned)w & 0xffffu); x[j].y = bf2f(((unsigned)w >> 16)); x[j].z = bf2f((unsigned)(w >> 32) & 0xffffu); x[j].w = bf2f((unsigned)(w >> 48)); }
        const float rs = row_rstd(acc, lane); const float* mr = mod_row(A_, F, l, b, s);
#pragma unroll
        for (int j = 0; j < 4; ++j) { const f32x4 c3 = ((const f32x4*)(mr + 5 * DMODEL))[lane + 64 * j]; x[j] = x[j] + c3 * (acc[j] * rs); }
        if (l == DEPTH - 1) { float* od = F.out + ((size_t)b * SEQ + (s - CTXL)) * DMODEL;
#pragma unroll
            for (int j = 0; j < 4; ++j) __builtin_nontemporal_store(x[j], (f32x4*)od + lane + 64 * j); }
        else { row_store_bf16(xr, lane, x);
            const float rs1 = row_rstd(x, lane); const float* mn = mod_row(A_, F, l + 1, b, s);
#pragma unroll
            for (int j = 0; j < 4; ++j) { const f32x4 sh = ((const f32x4*)mn)[lane + 64 * j], c0 = ((const f32x4*)(mn + DMODEL))[lane + 64 * j]; x[j] = (x[j] * rs1) * c0 + sh; }
            row_store_fp8((unsigned char*)(F.ws + WS_H) + (size_t)row * DMODEL, lane, x); }
    }
#undef CB_ROW
}
constexpr int NPH = 12, NPHASES = 1 + DEPTH * NCHUNK * NPH;
__global__ void __launch_bounds__(512, 2) mk_fwd(Args A_) {
    extern __shared__ __attribute__((aligned(16))) unsigned char lds[];
    Frame F0;
    F0.lds = (LAS unsigned char*)lds;
    F0.G = gridDim.x; { const int bx = blockIdx.x; F0.vcu = (F0.G % 8 == 0) ? (bx % 8) * (F0.G / 8) + bx / 8 : bx; }
    F0.out = A_.out; F0.ws = A_.ws;
    volatile LAS unsigned* MISC = (volatile LAS unsigned*)(F0.lds + MISC_OFF);
    for (int u = threadIdx.x; u < (LDS_BYTES - LDSCTL_OFF) / 4; u += 512) ((LAS unsigned*)(F0.lds + LDSCTL_OFF))[u] = 0u;
    __syncthreads();
    const int lo = A_.ph_lo, hi = A_.ph_hi;
    const bool fused = (hi - lo) > 1;
    XcdBarrier bar; bar.bar = (unsigned*)(F0.ws + WS_CTL) + CW_BAR; bar.x = 0; bar.st = nullptr;
    if (fused) bar = xcd_barrier_post((unsigned*)(F0.ws + WS_CTL) + CW_BAR, MISC + 8);
#ifndef MK_PHMASK
#define MK_PHMASK 0x1fff
#endif
#define PHON(j) (((MK_PHMASK) >> (j)) & 1)
#define IN(k) (lo <= (k) && (k) < hi)
#ifndef MK_BAR_SEC
#define MK_BAR_SEC 0
#endif
    unsigned long long bsec_acc = 0;
#define SEAM(k) do { if (IN(k) && IN((k) + 1)) { unsigned long long bt0_ = 0; const bool bon_ = (((MK_BAR_SEC) >> ((k) == 0 ? 12 : ((k) - 1) % NPH)) & 1) != 0; if (bon_) bt0_ = __builtin_amdgcn_s_memrealtime(); xcd_barrier(bar); if (bon_) bsec_acc += __builtin_amdgcn_s_memrealtime() - bt0_; } } while (0)
#ifndef MK_PROBE_MASK
#define MK_PROBE_MASK 0
#endif
#ifndef MK_PROBE_MULT
#define MK_PROBE_MULT 3
#endif
#define PBEG(j) unsigned long long t0_ = 0; if (((MK_PROBE_MASK) >> (j)) & 1) t0_ = __builtin_amdgcn_s_memrealtime();
#define PEND(j) if (((MK_PROBE_MASK) >> (j)) & 1) { const unsigned long long t1_ = __builtin_amdgcn_s_memrealtime(), te_ = t1_ + (unsigned long long)(MK_PROBE_MULT) * (t1_ - t0_); while (__builtin_amdgcn_s_memrealtime() < te_) __builtin_amdgcn_s_sleep(8); }

    if (PHON(12) && IN(0)) { PBEG(12) ph_prologue(A_, F0); SEAM(0); PEND(12) }

    for (int ch = 0; ch < NCHUNK; ++ch)
        for (int l = 0; l < DEPTH; ++l) {
            const int p0 = 1 + (ch * DEPTH + l) * NPH;
            Frame F = F0; asm volatile("" : "+s"(F.vcu), "+s"(F.G));
            { GAS unsigned char* wsg = (GAS unsigned char*)F0.ws; GAS float* og = (GAS float*)F0.out; asm volatile("" : "+s"(wsg), "+s"(og));
              F.ws = (unsigned char*)wsg; F.out = (float*)og; }
            unsigned char* wl = F.ws + WS_W + (size_t)l * LW;
            if (PHON(0) && IN(p0 + 0) && l == 0 && ch == 0) { PBEG(0) ph_norm1(A_, F, l, ch); SEAM(p0 + 0); PEND(0) }
            if (PHON(1) && IN(p0 + 1)) { PBEG(1)
                pg8::Gemm g{512, 512, 512}; SchedG1 S; S.init(l == DEPTH - 1, F.G, (int)blockIdx.x);
                S.A = (const char*)(F.ws + WS_H); S.B = (const char*)(wl + W_P);
                EpiG1 E{(bf16*)(F.ws + WS_P), F.ws + WS_G8};
                pg8::gemm_phase<EpiG1, SchedG1, true, true, false, true>(F.lds, g, S, E);
                SEAM(p0 + 1); PEND(1)
            }
            if (PHON(3) && IN(p0 + 3)) { PBEG(3) ph_prep(A_, F, l); ph_lru(A_, F, l); SEAM(p0 + 3); PEND(3) }
            if (PHON(4) && IN(p0 + 4)) { PBEG(4) ph_attn(A_, F, l, (char*)lds); SEAM(p0 + 4); PEND(4) }
            if (PHON(5) && IN(p0 + 5)) { PBEG(5)
                pg8::Gemm g{1024, 1024, 1024}; SchedPlain S; S.skipctx = (l != 0); S.T.init(S.skipctx ? BC * 8 : MC / 256, 4, F.G, (int)blockIdx.x);
                S.A = (const char*)(F.ws + WS_M8); S.B = (const char*)(wl + W_O); S.astep = (size_t)256 * 2048; S.bstep = (size_t)256 * 2048;
                EpiMerge E{(const unsigned char*)(F.ws + WS_G8), F.ws + WS_H};
                pg8::gemm_phase<EpiMerge, SchedPlain, true, true, true, true>(F.lds, g, S, E);
                SEAM(p0 + 5); PEND(5)
            }
            if (PHON(6) && IN(p0 + 6)) { PBEG(6)
                pg8::Gemm g{512, 512, 512, 0x7b7b7b7b}; SchedPlain S; S.skipctx = (l != 0); S.T.init(S.skipctx ? BC * 8 : MC / 256, 4, F.G, (int)blockIdx.x);
                S.A = (const char*)(F.ws + WS_H); S.B = (const char*)(wl + W_OUT); S.astep = (size_t)256 * 1024; S.bstep = (size_t)256 * 1024;
                pg8::EpiBf16<0> E{(pg8::bf16_t*)(F.ws + WS_O1), 1024, nullptr, 0, 0, 1.f};
                pg8::gemm_phase<pg8::EpiBf16<0>, SchedPlain, true, true, false, true>(F.lds, g, S, E);
                SEAM(p0 + 6); PEND(6)
            }
            if (PHON(7) && IN(p0 + 7)) { PBEG(7) ph_norm2(A_, F, l, ch); SEAM(p0 + 7); PEND(7) }
            if (PHON(8) && IN(p0 + 8)) { PBEG(8) ph_topk(A_, F, l); SEAM(p0 + 8); PEND(8) }
            if (PHON(9) && IN(p0 + 9)) { PBEG(9)
                pg8::Gemm g{512, 512, 512}; SchedMoe S; S.T.init(l == 0 ? NE * BC + NE * BC / 8 : NE * BC, 8, F.G, (int)blockIdx.x);
                S.A = (const char*)(F.ws + WS_H); S.B = (const char*)(wl + W_GU); S.astep = 0; S.bstep = (size_t)256 * 1024; S.estep = (size_t)2048 * 1024; S.gidx = (const int*)(F.ws + WS_ROWIDX);
                EpiSwiglu E{(unsigned char*)(F.ws + WS_ACT)};
                pg8::gemm_phase<EpiSwiglu, SchedMoe, true, true, false, true, true>(F.lds, g, S, E);
                SEAM(p0 + 9); PEND(9)
            }
            if (PHON(10) && IN(p0 + 10)) { PBEG(10)
                pg8::Gemm g{512, 512, 512}; SchedMoe S; S.T.init(l == 0 ? NE * BC + NE * BC / 8 : NE * BC, 4, F.G, (int)blockIdx.x);
                S.A = (const char*)(F.ws + WS_ACT); S.B = (const char*)(wl + W_D); S.astep = (size_t)256 * 1024; S.bstep = (size_t)256 * 1024; S.estep = (size_t)1024 * 1024; S.gidx = nullptr;
                pg8::EpiBf16<0> E{(pg8::bf16_t*)(F.ws + WS_HS), 1024, nullptr, 0, 0, 1.f};
                pg8::gemm_phase<pg8::EpiBf16<0>, SchedMoe, true, true, false, true>(F.lds, g, S, E);
                SEAM(p0 + 10); PEND(10)
            }
            if (PHON(11) && IN(p0 + 11)) { PBEG(11) ph_combine(A_, F, l, ch);
                if (l == DEPTH - 1 && ch + 1 < NCHUNK) ph_norm1(A_, F, 0, ch + 1);
                SEAM(p0 + 11); PEND(11) }
        }
    if (MK_BAR_SEC) { const unsigned long long te_ = __builtin_amdgcn_s_memrealtime() + 3ull * bsec_acc; while (__builtin_amdgcn_s_memrealtime() < te_) __builtin_amdgcn_s_sleep(8); }
#undef IN
#undef SEAM
}

#ifndef MK_N_LAUNCHES
#define MK_N_LAUNCHES 1
#endif
extern "C" void kernel_launch(void* const* d_in, const int* in_sizes, int n_in, void* d_out, int out_size, void* d_ws, size_t ws_size, hipStream_t stream) {
    static int grid = 0;
    if (grid == 0) {
        if (n_in != N_IN || in_sizes[0] != NB * SEQ * DMODEL || out_size != NB * SEQ * DMODEL || ws_size < WS_END) { fprintf(stderr, "kernel_launch: unexpected shapes / workspace (%d inputs, ws %zu, need %zu)\n", n_in, ws_size, (size_t)WS_END); grid = -1; return; }
        int dev = 0, cus = 0, per_cu = 0;
        if (hipGetDevice(&dev) != hipSuccess || hipDeviceGetAttribute(&cus, hipDeviceAttributeMultiprocessorCount, dev) != hipSuccess) { grid = -1; return; }
        if (hipFuncSetAttribute((const void*)mk_fwd, hipFuncAttributeMaxDynamicSharedMemorySize, LDS_BYTES) != hipSuccess) { fprintf(stderr, "kernel_launch: hipFuncSetAttribute failed\n"); grid = -1; return; }
        if (hipOccupancyMaxActiveBlocksPerMultiprocessor(&per_cu, (const void*)mk_fwd, 512, LDS_BYTES) != hipSuccess || per_cu < 1) { fprintf(stderr, "kernel_launch: occupancy query says %d blocks per CU\n", per_cu); (void)hipGetLastError(); grid = -1; return; }
        grid = cus;
        if (grid != 256) fprintf(stderr, "kernel_launch: %d CUs (built and tuned for 256)\n", grid);
    }
    if (grid < 0) return;
    if (hipMemsetAsync((char*)d_ws + WS_CTL, 0, CTL_ZERO_BYTES, stream) != hipSuccess) return;
    Args a{};
    for (int i = 0; i < N_IN; ++i) a.in[i] = (const float*)d_in[i];
    a.out = (float*)d_out; a.ws = (unsigned char*)d_ws;
#if MK_N_LAUNCHES == 1
    a.ph_lo = 0; a.ph_hi = NPHASES;
    hipLaunchKernelGGL(mk_fwd, dim3(grid), dim3(512), LDS_BYTES, stream, a);
#else
    for (int p = 0; p < NPHASES; ++p) { a.ph_lo = p; a.ph_hi = p + 1; hipLaunchKernelGGL(mk_fwd, dim3(grid), dim3(512), LDS_BYTES, stream, a); }
#endif
}
```
